# Optimizing an MI355X kernel written in HIP

```python
import jax, jax.numpy as jnp
from jax import lax
import numpy as np

D_MODEL = 1024
BATCH = 4
SEQ = 8192
DEPTH = 1

GLA_HEADS = 4
GLA_DK = 128
GLA_DV = 256
GLA_KEY_W = GLA_HEADS * GLA_DK
GLA_VAL_W = GLA_HEADS * GLA_DV
GLA_GATE_RANK = 16
GLA_TAU = 16.0
GLA_CHUNK = 64
SWA_HEADS = 16
SWA_KV_HEADS = 2
SWA_GROUP = SWA_HEADS // SWA_KV_HEADS
SWA_DH = 64
SWA_W = SWA_HEADS * SWA_DH
SWA_KV_W = SWA_KV_HEADS * SWA_DH
WINDOW = 128
N_GROUPS = 4
EXPERTS_PER_GROUP = 4
N_EXPERTS = N_GROUPS * EXPERTS_PER_GROUP
TOP_K = 2
D_EXPERT = 256
N_MOD = 6
EPS = 1e-6
IN_WIDTHS = (GLA_KEY_W, GLA_KEY_W, GLA_VAL_W, GLA_VAL_W, GLA_GATE_RANK,
             SWA_W, SWA_KV_W, SWA_KV_W, D_MODEL, D_MODEL)
IN_SPLITS = tuple(int(s) for s in np.cumsum(IN_WIDTHS)[:-1])
IN_TOTAL = int(sum(IN_WIDTHS))

kernel_name = "hybrid_gla_swa_sink_hmoe_adaln"


def rms_norm(x, g):
    x32 = x.astype(jnp.float32)
    y = x32 * lax.rsqrt(jnp.mean(x32 * x32, axis=-1, keepdims=True) + EPS)
    return (y * g.astype(jnp.float32)).astype(x.dtype)


def gla_mixer(q, k, v, r, z_gate, w_gk2, b_gk, gla_norm_g):
    B, S, _ = q.shape
    N = S // GLA_CHUNK
    dt = q.dtype
    f32 = jnp.float32
    shp = (B, N, GLA_CHUNK, GLA_HEADS)
    q = q.astype(f32).reshape(*shp, GLA_DK) * (GLA_DK ** -0.5)
    k = k.astype(f32).reshape(*shp, GLA_DK)
    v = v.astype(f32).reshape(*shp, GLA_DV)
    log_a = jax.nn.log_sigmoid((z_gate @ w_gk2 + b_gk).astype(f32)) / GLA_TAU
    log_a = log_a.reshape(*shp, GLA_DK)
    b = jnp.cumsum(log_a, axis=2)
    b_last = b[:, :, -1]
    q_dec = q * jnp.exp(b)
    k_inv = k * jnp.exp(-b)
    causal = jnp.tril(jnp.ones((GLA_CHUNK, GLA_CHUNK), dtype=bool))
    att = jnp.einsum('bnihk,bnjhk->bnhij', q_dec, k_inv)
    att = jnp.where(causal, att, 0.0)
    o_intra = jnp.einsum('bnhij,bnjhv->bnihv', att, v)
    k_to_end = k * jnp.exp(b_last[:, :, None] - b)
    upd = jnp.einsum('bnjhk,bnjhv->bnhkv', k_to_end, v)
    decay = jnp.exp(b_last)

    def step(state, inp):
        dec, u = inp
        return dec[..., None] * state + u, state

    s0 = jnp.zeros((B, GLA_HEADS, GLA_DK, GLA_DV), f32)
    _, s_prev = lax.scan(step, s0, (jnp.moveaxis(decay, 1, 0), jnp.moveaxis(upd, 1, 0)))
    s_prev = jnp.moveaxis(s_prev, 0, 1)
    o_inter = jnp.einsum('bnihk,bnhkv->bnihv', q_dec, s_prev)
    o = (o_intra + o_inter).reshape(B, S, GLA_HEADS, GLA_DV)
    o = o * lax.rsqrt(jnp.mean(o * o, axis=-1, keepdims=True) + EPS) * gla_norm_g.astype(f32)
    o = o.reshape(B, S, GLA_VAL_W) * jax.nn.silu(r.astype(f32))
    return o.astype(dt)


def swa_mixer(q, k, v, sink):
    B, S, _ = q.shape
    nb = S // WINDOW
    dt = q.dtype
    f32 = jnp.float32
    q = q.reshape(B, nb, WINDOW, SWA_KV_HEADS, SWA_GROUP, SWA_DH)
    k = k.reshape(B, nb, WINDOW, SWA_KV_HEADS, SWA_DH)
    v = v.reshape(B, nb, WINDOW, SWA_KV_HEADS, SWA_DH)

    def with_prev(t):
        prev = jnp.concatenate([jnp.zeros_like(t[:, :1]), t[:, :-1]], axis=1)
        return jnp.concatenate([prev, t], axis=2)

    kk, vv = with_prev(k), with_prev(v)
    s = jnp.einsum('bnqhgd,bnkhd->bnhgqk', q, kk).astype(f32) * (SWA_DH ** -0.5)
    qi = jnp.arange(WINDOW)[:, None] + WINDOW
    kj = jnp.arange(2 * WINDOW)[None, :]
    rel = qi - kj
    band = (rel >= 0) & (rel < WINDOW)
    blk = jnp.arange(nb)[:, None, None]
    valid = band[None] & ((blk > 0) | (kj[None] >= WINDOW))
    s = jnp.where(valid[None, :, None, None], s, -jnp.inf)
    sink_logit = jnp.broadcast_to(
        sink.astype(f32).reshape(1, 1, SWA_KV_HEADS, SWA_GROUP, 1, 1), s.shape[:-1] + (1,))
    p = jax.nn.softmax(jnp.concatenate([s, sink_logit], axis=-1), axis=-1)[..., :-1]
    o = jnp.einsum('bnhgqk,bnkhd->bnqhgd', p.astype(dt), vv)
    return o.reshape(B, S, SWA_W)


def mixer(h, w_in, w_gk2, b_gk, gla_norm_g, sink, w_o):
    proj = h @ w_in
    qa, ka, va, ra, za, qb, kb, vb, ga, gb = jnp.split(proj, IN_SPLITS, axis=-1)
    oa = gla_mixer(qa, ka, va, ra, za, w_gk2, b_gk, gla_norm_g)
    ob = swa_mixer(qb, kb, vb, sink)
    merged = jax.nn.sigmoid(ga) * oa + jax.nn.sigmoid(gb) * ob
    return merged @ w_o


def hier_moe(h, w_group, b_group, w_router, b_router, w_gate, w_up, w_down):
    B, S, D = h.shape
    f32 = jnp.float32
    t = h.reshape(B * S, D)
    g_logits = (t @ w_group + b_group).astype(f32)
    g_prob = jax.nn.softmax(g_logits, axis=-1)
    g_idx = jnp.argmax(g_logits, axis=-1)
    g_w = jnp.take_along_axis(g_prob, g_idx[:, None], axis=1)
    e_logits = (t @ w_router + b_router).astype(f32).reshape(-1, N_GROUPS, EXPERTS_PER_GROUP)
    e_in = jnp.take_along_axis(e_logits, g_idx[:, None, None], axis=1)[:, 0]
    top_v, top_i = lax.top_k(e_in, TOP_K)
    top_w = jax.nn.softmax(top_v, axis=-1) * g_w
    e_idx = g_idx[:, None] * EXPERTS_PER_GROUP + top_i
    combine = jnp.einsum('tk,tke->te', top_w, jax.nn.one_hot(e_idx, N_EXPERTS, dtype=f32))
    hid = jax.nn.silu(jnp.einsum('td,edf->tef', t, w_gate)) * jnp.einsum('td,edf->tef', t, w_up)
    hid = hid * combine.astype(hid.dtype)[:, :, None]
    y = jnp.einsum('tef,efd->td', hid, w_down)
    return y.reshape(B, S, D)


def setup_inputs(seed: int = 0) -> dict:
    key = jax.random.key(seed)
    ks = jax.random.split(key, 20)
    f32 = jnp.float32
    L = DEPTH

    def nrm(k, shape, scale):
        return jax.random.normal(k, shape, f32) * scale

    return {
        "x": nrm(ks[0], (BATCH, SEQ, D_MODEL), 1.0),
        "c": nrm(ks[1], (BATCH, D_MODEL), 1.0),
        "w_ada": nrm(ks[2], (L, D_MODEL, N_MOD * D_MODEL), D_MODEL ** -0.5),
        "b_ada": nrm(ks[3], (L, N_MOD * D_MODEL), 0.02),
        "norm1_g": 1.0 + nrm(ks[4], (L, D_MODEL), 0.02),
        "w_in": nrm(ks[5], (L, D_MODEL, IN_TOTAL), D_MODEL ** -0.5),
        "w_gk2": nrm(ks[6], (L, GLA_GATE_RANK, GLA_KEY_W), GLA_GATE_RANK ** -0.5),
        "b_gk": nrm(ks[7], (L, GLA_KEY_W), 0.1),
        "gla_norm_g": 1.0 + nrm(ks[8], (L, GLA_DV), 0.02),
        "sink": nrm(ks[9], (L, SWA_HEADS), 1.0),
        "w_o": nrm(ks[10], (L, D_MODEL, D_MODEL), D_MODEL ** -0.5),
        "norm2_g": 1.0 + nrm(ks[11], (L, D_MODEL), 0.02),
        "w_group": nrm(ks[12], (L, D_MODEL, N_GROUPS), D_MODEL ** -0.5),
        "b_group": nrm(ks[13], (L, N_GROUPS), 0.01),
        "w_router": nrm(ks[14], (L, D_MODEL, N_EXPERTS), D_MODEL ** -0.5),
        "b_router": nrm(ks[15], (L, N_EXPERTS), 0.01),
        "w_gate": nrm(ks[16], (L, N_EXPERTS, D_MODEL, D_EXPERT), D_MODEL ** -0.5),
        "w_up": nrm(ks[17], (L, N_EXPERTS, D_MODEL, D_EXPERT), D_MODEL ** -0.5),
        "w_down": nrm(ks[18], (L, N_EXPERTS, D_EXPERT, D_MODEL), D_EXPERT ** -0.5),
        "norm_f_g": 1.0 + nrm(ks[19], (D_MODEL,), 0.02),
    }


def reference(x, c, w_ada, b_ada, norm1_g, w_in, w_gk2, b_gk, gla_norm_g, sink, w_o, norm2_g,
              w_group, b_group, w_router, b_router, w_gate, w_up, w_down, norm_f_g):
    for l in range(DEPTH):
        mod = jax.nn.silu(c) @ w_ada[l] + b_ada[l]
        sh1, sc1, gt1, sh2, sc2, gt2 = jnp.split(mod[:, None, :], N_MOD, axis=-1)
        h = rms_norm(x, norm1_g[l]) * (1.0 + sc1) + sh1
        x = x + gt1 * mixer(h, w_in[l], w_gk2[l], b_gk[l], gla_norm_g[l], sink[l], w_o[l])
        h = rms_norm(x, norm2_g[l]) * (1.0 + sc2) + sh2
        x = x + gt2 * hier_moe(h, w_group[l], b_group[l], w_router[l], b_router[l],
                               w_gate[l], w_up[l], w_down[l])
    return rms_norm(x, norm_f_g)
```

```cpp
#include <hip/hip_runtime.h>
#include <stdint.h>

typedef unsigned short bf16;
typedef unsigned int u32;

constexpr int D = 1024, NB = 4, SEQ = 8192, T = NB * SEQ;
constexpr int NMOD = 6 * D;
constexpr int IN_TOTAL = 6416;
constexpr int PW = 6656;
constexpr int PC_QA = 0, PC_KA = 512, PC_VA = 1024, PC_RA = 2048, PC_QB = 3072, PC_KB = 4096, PC_VB = 4224, PC_GA = 4352, PC_GB = 5376, PC_Z = 6400;
constexpr float EPS = 1e-6f;
constexpr int PROWS = T + 1024;

constexpr size_t MiB = 1u << 20;
constexpr size_t WS_CTL = 0, WS_MOD = 1 * MiB, WS_ROUTE = 2 * MiB, WS_WIN = 8 * MiB, WS_WO = 21 * MiB, WS_WGU = 23 * MiB, WS_WD = 39 * MiB, WS_P = 48 * MiB;
constexpr size_t WS_END = WS_P + (size_t)PROWS * PW * 2;
static_assert(WS_END <= 512 * MiB, "ws map");

__device__ __forceinline__ float bf2f(bf16 v) { return __uint_as_float(((u32)v) << 16); }
__device__ __forceinline__ bf16 f2bf(float f) { u32 u = __float_as_uint(f); return (bf16)((u + 0x7fffu + ((u >> 16) & 1u)) >> 16); }
__device__ __forceinline__ float sigmoidf_(float x) { return 1.f / (1.f + __expf(-x)); }
__device__ __forceinline__ float siluf_(float x) { return x / (1.f + __expf(-x)); }
__device__ __forceinline__ float wave_sum(float v) {
#pragma unroll
    for (int o = 1; o < 64; o <<= 1) v += __shfl_xor(v, o);
    return v;
}

__global__ void __launch_bounds__(256) k_mod(const float* __restrict__ c, const float* __restrict__ w_ada, const float* __restrict__ b_ada, float* __restrict__ mod) {
    const int j = blockIdx.x * 256 + threadIdx.x;
    float acc[NB];
#pragma unroll
    for (int b = 0; b < NB; ++b) acc[b] = 0.f;
    for (int i = 0; i < D; ++i) {
        const float w = w_ada[(size_t)i * NMOD + j];
#pragma unroll
        for (int b = 0; b < NB; ++b) acc[b] += siluf_(c[b * D + i]) * w;
    }
#pragma unroll
    for (int b = 0; b < NB; ++b) mod[b * NMOD + j] = acc[b] + b_ada[j];
}

template <int MODE>
__device__ __forceinline__ int rowmap(int n) {
    if (MODE == 0) return n < 3072 ? n : (n < 3088 ? 6400 + (n - 3072) : n - 16);
    if (MODE == 1) return n;
    if (MODE == 2) return (n >> 7) * 256 + (n & 127);
    return (n >> 7) * 256 + 128 + (n & 127);
}
template <int MODE>
__global__ void __launch_bounds__(256) k_cvt_w(const float* __restrict__ W, int K, int N, bf16* __restrict__ Wt, size_t w_estride, size_t wt_estride) {
    __shared__ float tile[64][65];
    const int e = blockIdx.z;
    W += (size_t)e * w_estride; Wt += (size_t)e * wt_estride;
    const int k0 = blockIdx.y * 64, n0 = blockIdx.x * 64;
    const int tx = threadIdx.x & 63, ty = threadIdx.x >> 6;
    for (int r = ty; r < 64; r += 4) { const int n = n0 + tx; tile[r][tx] = (n < N) ? W[(size_t)(k0 + r) * N + n] : 0.f; }
    __syncthreads();
    for (int r = ty; r < 64; r += 4) { const int n = n0 + r; if (n < N) Wt[(size_t)rowmap<MODE>(n) * K + k0 + tx] = f2bf(tile[tx][r]); }
}
__global__ void __launch_bounds__(256) k_zero_rows(bf16* p, int n) { const int i = blockIdx.x * 256 + threadIdx.x; if (i < n) p[i] = 0; }

__global__ void __launch_bounds__(256) k_h1(const float* __restrict__ x, const float* __restrict__ g, const float* __restrict__ mod, int sh_off, int sc_off, bf16* __restrict__ H, int ldh) {
    const int row = blockIdx.x * 4 + (threadIdx.x >> 6), lane = threadIdx.x & 63, b = row / SEQ;
    const float4* xr = (const float4*)(x + (size_t)row * D);
    float4 v[4]; float s = 0.f;
#pragma unroll
    for (int j = 0; j < 4; ++j) { v[j] = xr[lane + 64 * j]; s += v[j].x * v[j].x + v[j].y * v[j].y + v[j].z * v[j].z + v[j].w * v[j].w; }
    const float rstd = rsqrtf(wave_sum(s) * (1.f / D) + EPS);
    const float* sh = mod + b * NMOD + sh_off; const float* sc = mod + b * NMOD + sc_off;
#pragma unroll
    for (int j = 0; j < 4; ++j) {
        const int c0 = (lane + 64 * j) * 4;
        const float4 gg = *(const float4*)(g + c0), s4 = *(const float4*)(sc + c0), h4 = *(const float4*)(sh + c0);
        bf16* o = H + (size_t)row * ldh + c0;
        o[0] = f2bf(v[j].x * rstd * gg.x * (1.f + s4.x) + h4.x);
        o[1] = f2bf(v[j].y * rstd * gg.y * (1.f + s4.y) + h4.y);
        o[2] = f2bf(v[j].z * rstd * gg.z * (1.f + s4.z) + h4.z);
        o[3] = f2bf(v[j].w * rstd * gg.w * (1.f + s4.w) + h4.w);
    }
}

struct EpiP { bf16* P; __device__ __forceinline__ void operator()(int m, int n, float v) const { P[(size_t)m * PW + n] = f2bf(v); } };
struct EpiX1 { const float* x; const float* mod; float* out;
    __device__ __forceinline__ void operator()(int m, int n, float v) const { const int b = m / SEQ; out[(size_t)m * D + n] = x[(size_t)m * D + n] + mod[b * NMOD + 2 * D + n] * v; } };
template <class Epi>
__global__ void __launch_bounds__(256) nv_gemm(const bf16* __restrict__ A, int lda, const bf16* __restrict__ Bt, int ldb, int K, Epi E) {
    __shared__ float As[16][68], Bs[16][68];
    const int tid = threadIdx.x, tx = tid & 15, ty = tid >> 4;
    const int m0 = blockIdx.y * 64, n0 = blockIdx.x * 64;
    float acc[4][4];
#pragma unroll
    for (int i = 0; i < 4; ++i)
#pragma unroll
        for (int j = 0; j < 4; ++j) acc[i][j] = 0.f;
    const int r = tid >> 2, kq = (tid & 3) * 4;
    for (int k0 = 0; k0 < K; k0 += 16) {
        const uint2 av = *(const uint2*)(A + (size_t)(m0 + r) * lda + k0 + kq);
        const uint2 bv = *(const uint2*)(Bt + (size_t)(n0 + r) * ldb + k0 + kq);
        As[kq + 0][r] = __uint_as_float(av.x << 16); As[kq + 1][r] = __uint_as_float(av.x & 0xffff0000u);
        As[kq + 2][r] = __uint_as_float(av.y << 16); As[kq + 3][r] = __uint_as_float(av.y & 0xffff0000u);
        Bs[kq + 0][r] = __uint_as_float(bv.x << 16); Bs[kq + 1][r] = __uint_as_float(bv.x & 0xffff0000u);
        Bs[kq + 2][r] = __uint_as_float(bv.y << 16); Bs[kq + 3][r] = __uint_as_float(bv.y & 0xffff0000u);
        __syncthreads();
#pragma unroll
        for (int kk = 0; kk < 16; ++kk) {
            const float4 a4 = *(const float4*)&As[kk][ty * 4], b4 = *(const float4*)&Bs[kk][tx * 4];
            const float a[4] = {a4.x, a4.y, a4.z, a4.w}, b[4] = {b4.x, b4.y, b4.z, b4.w};
#pragma unroll
            for (int i = 0; i < 4; ++i)
#pragma unroll
                for (int j = 0; j < 4; ++j) acc[i][j] += a[i] * b[j];
        }
        __syncthreads();
    }
#pragma unroll
    for (int i = 0; i < 4; ++i)
#pragma unroll
        for (int j = 0; j < 4; ++j) E(m0 + ty * 4 + i, n0 + tx * 4 + j, acc[i][j]);
}

__global__ void __launch_bounds__(256) nv_gla_gates(const bf16* __restrict__ P, const float* __restrict__ w_gk2, const float* __restrict__ b_gk, float* __restrict__ Ag) {
    const size_t idx = (size_t)blockIdx.x * 256 + threadIdx.x; const int t = (int)(idx >> 9), c = (int)(idx & 511);
    float xg = b_gk[c];
#pragma unroll
    for (int r = 0; r < 16; ++r) xg += bf2f(P[(size_t)t * PW + PC_Z + r]) * w_gk2[r * 512 + c];
    const float ls = fminf(xg, 0.f) - log1pf(__expf(-fabsf(xg)));
    Ag[idx] = __expf(ls * (1.f / 16.f));
}
__global__ void __launch_bounds__(256) nv_gla(const bf16* __restrict__ P, const float* __restrict__ Ag, const float* __restrict__ gng, bf16* __restrict__ OA) {
    __shared__ float sq[8][128], sk[8][128], sa[8][128], sred[8][4], srstd[8];
    const int b = blockIdx.x >> 2, h = blockIdx.x & 3, v = threadIdx.x, wave = v >> 6, lane = v & 63;
    float S[128];
#pragma unroll
    for (int k = 0; k < 128; ++k) S[k] = 0.f;
    const float gv = gng[v];
    const float qs = 0.08838834764831845f;
    for (int t0 = 0; t0 < SEQ; t0 += 8) {
        const size_t row0 = (size_t)b * SEQ + t0;
        __syncthreads();
        for (int i = v; i < 8 * 128; i += 256) {
            const int tt = i >> 7, k = i & 127; const size_t row = row0 + tt;
            sq[tt][k] = bf2f(P[row * PW + PC_QA + h * 128 + k]) * qs;
            sk[tt][k] = bf2f(P[row * PW + PC_KA + h * 128 + k]);
            sa[tt][k] = Ag[row * 512 + h * 128 + k];
        }
        __syncthreads();
        float o[8];
#pragma unroll
        for (int tt = 0; tt < 8; ++tt) {
            const float vt = bf2f(P[(row0 + tt) * PW + PC_VA + h * 256 + v]);
            float acc = 0.f;
#pragma unroll
            for (int k = 0; k < 128; ++k) { S[k] = sa[tt][k] * S[k] + sk[tt][k] * vt; acc += sq[tt][k] * S[k]; }
            o[tt] = acc;
            const float ss = wave_sum(acc * acc);
            if (lane == 0) sred[tt][wave] = ss;
        }
        __syncthreads();
        if (v < 8) srstd[v] = rsqrtf((sred[v][0] + sred[v][1] + sred[v][2] + sred[v][3]) * (1.f / 256.f) + EPS);
        __syncthreads();
#pragma unroll
        for (int tt = 0; tt < 8; ++tt) {
            const size_t row = row0 + tt;
            const float r = bf2f(P[row * PW + PC_RA + h * 256 + v]);
            OA[row * D + h * 256 + v] = f2bf(o[tt] * srstd[tt] * gv * siluf_(r));
        }
    }
}

__global__ void __launch_bounds__(256) nv_swa_merge(bf16* __restrict__ P, const bf16* __restrict__ OA, const float* __restrict__ sink) {
    const int head = blockIdx.y, kvh = head >> 3;
    const int row = blockIdx.x * 256 + threadIdx.x, b = row / SEQ, t = row - b * SEQ;
    float q[64], acc[64];
    const bf16* qp = P + (size_t)row * PW + PC_QB + head * 64;
#pragma unroll
    for (int d = 0; d < 64; ++d) { q[d] = bf2f(qp[d]) * 0.125f; acc[d] = 0.f; }
    float m = sink[head], l = 1.f;
    const int j0 = (t >= 127) ? t - 127 : 0;
    for (int j = j0; j <= t; ++j) {
        const size_t kr = (size_t)(b * SEQ + j) * PW;
        const uint4* kp = (const uint4*)(P + kr + PC_KB + kvh * 64);
        float s = 0.f;
#pragma unroll
        for (int c = 0; c < 8; ++c) { const uint4 kv = kp[c];
            s += q[c * 8 + 0] * __uint_as_float(kv.x << 16) + q[c * 8 + 1] * __uint_as_float(kv.x & 0xffff0000u) + q[c * 8 + 2] * __uint_as_float(kv.y << 16) + q[c * 8 + 3] * __uint_as_float(kv.y & 0xffff0000u)
               + q[c * 8 + 4] * __uint_as_float(kv.z << 16) + q[c * 8 + 5] * __uint_as_float(kv.z & 0xffff0000u) + q[c * 8 + 6] * __uint_as_float(kv.w << 16) + q[c * 8 + 7] * __uint_as_float(kv.w & 0xffff0000u); }
        const float mn = fmaxf(m, s), f = __expf(m - mn), p = __expf(s - mn);
        l = l * f + p; m = mn;
        const uint4* vp = (const uint4*)(P + kr + PC_VB + kvh * 64);
#pragma unroll
        for (int c = 0; c < 8; ++c) { const uint4 vv = vp[c];
            acc[c * 8 + 0] = acc[c * 8 + 0] * f + p * __uint_as_float(vv.x << 16); acc[c * 8 + 1] = acc[c * 8 + 1] * f + p * __uint_as_float(vv.x & 0xffff0000u);
            acc[c * 8 + 2] = acc[c * 8 + 2] * f + p * __uint_as_float(vv.y << 16); acc[c * 8 + 3] = acc[c * 8 + 3] * f + p * __uint_as_float(vv.y & 0xffff0000u);
            acc[c * 8 + 4] = acc[c * 8 + 4] * f + p * __uint_as_float(vv.z << 16); acc[c * 8 + 5] = acc[c * 8 + 5] * f + p * __uint_as_float(vv.z & 0xffff0000u);
            acc[c * 8 + 6] = acc[c * 8 + 6] * f + p * __uint_as_float(vv.w << 16); acc[c * 8 + 7] = acc[c * 8 + 7] * f + p * __uint_as_float(vv.w & 0xffff0000u); }
    }
    const float il = 1.f / l;
    const bf16* gap = P + (size_t)row * PW + PC_GA + head * 64; const bf16* gbp = P + (size_t)row * PW + PC_GB + head * 64;
    const bf16* oap = OA + (size_t)row * D + head * 64;
    bf16* mp = P + (size_t)row * PW + PC_QB + head * 64;
#pragma unroll
    for (int d = 0; d < 64; ++d) mp[d] = f2bf(sigmoidf_(bf2f(gap[d])) * bf2f(oap[d]) + sigmoidf_(bf2f(gbp[d])) * acc[d] * il);
}

__global__ void __launch_bounds__(256) k_h2_route(const float* __restrict__ x1, const float* __restrict__ g2, const float* __restrict__ mod, bf16* __restrict__ A1, int lda1,
                                                  const float* __restrict__ w_group, const float* __restrict__ b_group, const float* __restrict__ w_router, const float* __restrict__ b_router, int4* __restrict__ route) {
    const int row = blockIdx.x * 4 + (threadIdx.x >> 6), lane = threadIdx.x & 63, b = row / SEQ;
    const float4* xr = (const float4*)(x1 + (size_t)row * D);
    float4 v[4]; float s = 0.f;
#pragma unroll
    for (int j = 0; j < 4; ++j) { v[j] = xr[lane + 64 * j]; s += v[j].x * v[j].x + v[j].y * v[j].y + v[j].z * v[j].z + v[j].w * v[j].w; }
    const float rstd = rsqrtf(wave_sum(s) * (1.f / D) + EPS);
    const float* sh = mod + b * NMOD + 3 * D; const float* sc = mod + b * NMOD + 4 * D;
    float lg[20];
#pragma unroll
    for (int c = 0; c < 20; ++c) lg[c] = 0.f;
#pragma unroll
    for (int j = 0; j < 4; ++j) {
        const int c0 = (lane + 64 * j) * 4;
        const float4 gg = *(const float4*)(g2 + c0), s4 = *(const float4*)(sc + c0), h4 = *(const float4*)(sh + c0);
        float hv[4];
        hv[0] = v[j].x * rstd * gg.x * (1.f + s4.x) + h4.x; hv[1] = v[j].y * rstd * gg.y * (1.f + s4.y) + h4.y;
        hv[2] = v[j].z * rstd * gg.z * (1.f + s4.z) + h4.z; hv[3] = v[j].w * rstd * gg.w * (1.f + s4.w) + h4.w;
        bf16* o = A1 + (size_t)row * lda1 + c0;
#pragma unroll
        for (int i = 0; i < 4; ++i) {
            o[i] = f2bf(hv[i]);
            const float4 wg = *(const float4*)(w_group + (size_t)(c0 + i) * 4);
            lg[0] += hv[i] * wg.x; lg[1] += hv[i] * wg.y; lg[2] += hv[i] * wg.z; lg[3] += hv[i] * wg.w;
            const float4* wr = (const float4*)(w_router + (size_t)(c0 + i) * 16);
#pragma unroll
            for (int q = 0; q < 4; ++q) { const float4 w4 = wr[q]; lg[4 + q * 4 + 0] += hv[i] * w4.x; lg[4 + q * 4 + 1] += hv[i] * w4.y; lg[4 + q * 4 + 2] += hv[i] * w4.z; lg[4 + q * 4 + 3] += hv[i] * w4.w; }
        }
    }
#pragma unroll
    for (int c = 0; c < 20; ++c) lg[c] = wave_sum(lg[c]);
    if (lane == 0) {
        float gl[4]; int gi = 0; float gm;
#pragma unroll
        for (int c = 0; c < 4; ++c) gl[c] = lg[c] + b_group[c];
        gm = gl[0];
#pragma unroll
        for (int c = 1; c < 4; ++c) if (gl[c] > gm) { gm = gl[c]; gi = c; }
        float den = 0.f;
#pragma unroll
        for (int c = 0; c < 4; ++c) den += __expf(gl[c] - gm);
        const float gw = 1.f / den;
        float el[4];
#pragma unroll
        for (int c = 0; c < 4; ++c) {
            float vsel = lg[4 + c] + b_router[c];
#pragma unroll
            for (int g = 1; g < 4; ++g) { const float cand = lg[4 + g * 4 + c] + b_router[g * 4 + c]; vsel = (gi == g) ? cand : vsel; }
            el[c] = vsel;
        }
        int i0 = 0; float v0 = el[0];
#pragma unroll
        for (int c = 1; c < 4; ++c) if (el[c] > v0) { v0 = el[c]; i0 = c; }
        int i1 = -1; float v1 = -3.0e38f;
#pragma unroll
        for (int c = 0; c < 4; ++c) if (c != i0 && el[c] > v1) { v1 = el[c]; i1 = c; }
        const float p1 = __expf(v1 - v0), w0 = gw / (1.f + p1), w1 = gw * p1 / (1.f + p1);
        route[row] = make_int4(gi * 4 + i0, gi * 4 + i1, __float_as_int(w0), __float_as_int(w1));
    }
}

__global__ void __launch_bounds__(256) nv_moe(const bf16* __restrict__ A1, int lda1, const int4* __restrict__ route, const float* __restrict__ w_gate, const float* __restrict__ w_up, const float* __restrict__ w_down,
                                              const float* __restrict__ mod, float* __restrict__ out) {
    __shared__ float sh[D]; __shared__ float shid[2][256];
    const int row = blockIdx.x, f = threadIdx.x, b = row / SEQ;
    for (int i = f; i < D; i += 256) sh[i] = bf2f(A1[(size_t)row * lda1 + i]);
    const int4 rt = route[row];
    __syncthreads();
#pragma unroll
    for (int s = 0; s < 2; ++s) {
        const int e = s ? rt.y : rt.x; const float w = __int_as_float(s ? rt.w : rt.z);
        const float* wg = w_gate + (size_t)e * D * 256 + f; const float* wu = w_up + (size_t)e * D * 256 + f;
        float g = 0.f, u = 0.f;
        for (int d = 0; d < D; ++d) { g += sh[d] * wg[(size_t)d * 256]; u += sh[d] * wu[(size_t)d * 256]; }
        shid[s][f] = bf2f(f2bf(siluf_(g) * u * w));
    }
    __syncthreads();
    float y[4] = {0.f, 0.f, 0.f, 0.f};
#pragma unroll
    for (int s = 0; s < 2; ++s) {
        const int e = s ? rt.y : rt.x;
        const float* wd = w_down + (size_t)e * 256 * D;
        for (int ff = 0; ff < 256; ++ff) { const float hv = shid[s][ff];
#pragma unroll
            for (int j = 0; j < 4; ++j) y[j] += hv * wd[(size_t)ff * D + f + 256 * j]; }
    }
#pragma unroll
    for (int j = 0; j < 4; ++j) { const int n = f + 256 * j; const size_t o = (size_t)row * D + n; out[o] = out[o] + mod[b * NMOD + 5 * D + n] * y[j]; }
}

__global__ void __launch_bounds__(256) k_final(float* __restrict__ out, const float* __restrict__ g) {
    const int row = blockIdx.x * 4 + (threadIdx.x >> 6), lane = threadIdx.x & 63;
    float4* xr = (float4*)(out + (size_t)row * D);
    float4 v[4]; float s = 0.f;
#pragma unroll
    for (int j = 0; j < 4; ++j) { v[j] = xr[lane + 64 * j]; s += v[j].x * v[j].x + v[j].y * v[j].y + v[j].z * v[j].z + v[j].w * v[j].w; }
    const float rstd = rsqrtf(wave_sum(s) * (1.f / D) + EPS);
#pragma unroll
    for (int j = 0; j < 4; ++j) { const float4 gg = *(const float4*)(g + (lane + 64 * j) * 4);
        xr[lane + 64 * j] = make_float4(v[j].x * rstd * gg.x, v[j].y * rstd * gg.y, v[j].z * rstd * gg.z, v[j].w * rstd * gg.w); }
}

extern "C" void kernel_launch(void* const* d_in, const int* in_sizes, int n_in, void* d_out, int out_size, void* d_ws, size_t ws_size, hipStream_t stream) {
    const float* x = (const float*)d_in[0]; const float* c = (const float*)d_in[1]; const float* w_ada = (const float*)d_in[2]; const float* b_ada = (const float*)d_in[3];
    const float* norm1_g = (const float*)d_in[4]; const float* w_in = (const float*)d_in[5]; const float* w_gk2 = (const float*)d_in[6]; const float* b_gk = (const float*)d_in[7];
    const float* gla_norm_g = (const float*)d_in[8]; const float* sink = (const float*)d_in[9]; const float* w_o = (const float*)d_in[10]; const float* norm2_g = (const float*)d_in[11];
    const float* w_group = (const float*)d_in[12]; const float* b_group = (const float*)d_in[13]; const float* w_router = (const float*)d_in[14]; const float* b_router = (const float*)d_in[15];
    const float* w_gate = (const float*)d_in[16]; const float* w_up = (const float*)d_in[17]; const float* w_down = (const float*)d_in[18]; const float* norm_f_g = (const float*)d_in[19];
    unsigned char* ws = (unsigned char*)d_ws; float* out = (float*)d_out;
    float* mod = (float*)(ws + WS_MOD); int4* route = (int4*)(ws + WS_ROUTE);
    bf16* WIN = (bf16*)(ws + WS_WIN); bf16* WO = (bf16*)(ws + WS_WO); bf16* P = (bf16*)(ws + WS_P);
    bf16* H1 = (bf16*)d_out;
    float* Ag = (float*)d_out;
    bf16* OA = (bf16*)((unsigned char*)d_out + 64 * MiB);

    k_mod<<<NMOD / 256, 256, 0, stream>>>(c, w_ada, b_ada, mod);
    k_cvt_w<0><<<dim3((IN_TOTAL + 63) / 64, D / 64, 1), 256, 0, stream>>>(w_in, D, IN_TOTAL, WIN, 0, 0);
    k_zero_rows<<<(240 * D + 255) / 256, 256, 0, stream>>>(WIN + (size_t)6416 * D, 240 * D);
    k_cvt_w<1><<<dim3(D / 64, D / 64, 1), 256, 0, stream>>>(w_o, D, D, WO, 0, 0);
    k_h1<<<T / 4, 256, 0, stream>>>(x, norm1_g, mod, 0, D, H1, D);
    nv_gemm<EpiP><<<dim3(PW / 64, T / 64), 256, 0, stream>>>(H1, D, WIN, D, D, EpiP{P});
    nv_gla_gates<<<(T * 512) / 256, 256, 0, stream>>>(P, w_gk2, b_gk, Ag);
    nv_gla<<<16, 256, 0, stream>>>(P, Ag, gla_norm_g, OA);
    nv_swa_merge<<<dim3(T / 256, 16), 256, 0, stream>>>(P, OA, sink);
    nv_gemm<EpiX1><<<dim3(D / 64, T / 64), 256, 0, stream>>>(P + PC_QB, PW, WO, D, D, EpiX1{x, mod, out});
    k_h2_route<<<T / 4, 256, 0, stream>>>(out, norm2_g, mod, P + PC_GA, PW, w_group, b_group, w_router, b_router, route);
    nv_moe<<<T, 256, 0, stream>>>(P + PC_GA, PW, route, w_gate, w_up, w_down, mod, out);
    k_final<<<T / 4, 256, 0, stream>>>(out, norm_f_g);
}
```

```cpp
#include <hip/hip_runtime.h>
#include <stdint.h>
#include <cstdio>

constexpr int D = 1024, NB = 4, SEQ = 8192, T = NB * SEQ;
constexpr int NMOD = 6 * D;
constexpr int IN_TOTAL = 6416;
constexpr int PW = 6656;
constexpr int PC_RA = 0, PC_GA = 1024, PC_GB = 2048, PC_KA = 3072, PC_VA = 3584, PC_KB = 4608, PC_VB = 4736, PC_QA = 4864, PC_QB = 5376, PC_Z = 6400;
constexpr int PWB = 5120, PBOFF = 1536;
constexpr int PE_KA = PC_KA - PBOFF, PE_VA = PC_VA - PBOFF, PE_KB = PC_KB - PBOFF, PE_VB = PC_VB - PBOFF, PE_QA = PC_QA - PBOFF, PE_QB = PC_QB - PBOFF, PE_Z = PC_Z - PBOFF;
#ifndef NF8_TILES
#define NF8_TILES 12
#endif
constexpr int NF8 = NF8_TILES;
constexpr float EPS = 1e-6f;
constexpr int PROWS = T + 1024;

constexpr size_t MiB = 1u << 20;
constexpr size_t WS_CTL = 0, CTL_ZERO_BYTES = 65536;
constexpr size_t WS_MOD = 1 * MiB;
constexpr size_t WS_ROUTE = 2 * MiB;
constexpr size_t WS_SORT = 3 * MiB;
constexpr size_t WS_WIN = 8 * MiB, WS_WO = 21 * MiB, WS_WGU = 23 * MiB, WS_WIN8 = 31 * MiB, WS_WD = 39 * MiB;
constexpr size_t WS_P = 48 * MiB;
constexpr size_t WS_M = WS_P + (size_t)PROWS * PWB * 2;
constexpr size_t WS_END = WS_M + (size_t)T * D * 2;
static_assert(WS_END <= 512 * MiB, "ws map");
constexpr int CW_BAR = 4096;
#define GAS __attribute__((address_space(1)))
#define LAS __attribute__((address_space(3)))
typedef unsigned short bf16;
typedef unsigned v4u __attribute__((ext_vector_type(4)));
typedef float f32x4 __attribute__((ext_vector_type(4)));
typedef short bf16x8 __attribute__((ext_vector_type(8)));
typedef GAS unsigned gu32;
typedef GAS unsigned long long gu64;
#define RLX_AGENT __ATOMIC_RELAXED, __HIP_MEMORY_SCOPE_AGENT
#define LDS_WAIT() asm volatile("s_waitcnt lgkmcnt(0)" ::: "memory")
#define VM_WAIT() asm volatile("s_waitcnt vmcnt(0)" ::: "memory")
__device__ __forceinline__ unsigned long long rt() { return __builtin_amdgcn_s_memrealtime(); }
__device__ __forceinline__ unsigned f2bf(float f) { unsigned u = __builtin_bit_cast(unsigned, f); return (u + 0x7fffu + ((u >> 16) & 1u)) >> 16; }
__device__ __forceinline__ unsigned pk2(float lo, float hi) { return f2bf(lo) | (f2bf(hi) << 16); }

#define XB_TMO      128
#define XB_XCNT(j)  (256  + 64 * (j))
#define XB_XSUB(j)  (1280 + 64 * (j))
#define XB_XGEN(j)  (2304 + 64 * (j))
#define XB_TOP      3328
#define XB_TOPGEN   3392
#define XCD_BAR_WORDS 3456
#define XB_SPIN_CAP (1u << 18)

__device__ __forceinline__ unsigned xb_ld(unsigned* p)              { return __hip_atomic_load(p, __ATOMIC_RELAXED, __HIP_MEMORY_SCOPE_AGENT); }
__device__ __forceinline__ unsigned xb_add(unsigned* p, unsigned v) { return __hip_atomic_fetch_add(p, v, __ATOMIC_RELAXED, __HIP_MEMORY_SCOPE_AGENT); }
__device__ __forceinline__ unsigned xb_xcc_id() { return (unsigned)__builtin_amdgcn_s_getreg((3 << 11) | 20) & 0xFu; }
#define XB_SPIN(cond, bar) do { unsigned _sp = 0; while (cond) { __builtin_amdgcn_s_sleep(1); \
    if ((++_sp & 255u) == 0u) { if (xb_ld(&(bar)[XB_TMO])) break; if (_sp > XB_SPIN_CAP) { atomicAdd(&(bar)[XB_TMO], 1u); break; } } } } while (0)

struct XcdBarrier {
    unsigned* bar; unsigned x;
    volatile LAS unsigned* st;
};

__device__ __forceinline__ XcdBarrier xcd_barrier_post(unsigned* bar, volatile LAS unsigned* st) {
    XcdBarrier b; b.bar = bar; b.x = xb_xcc_id(); b.st = st;
    if (threadIdx.x == 0) (void)xb_add(&bar[XB_XCNT(b.x)], 1u);
    return b;
}
__device__ __forceinline__ void xcd_barrier_complete(unsigned* bar, unsigned x, unsigned& nloc, unsigned& nx) {
    const unsigned G = gridDim.x * gridDim.y * gridDim.z;
    unsigned sum, cnt, mine, sp = 0u;
    for (;;) {
        sum = 0u; cnt = 0u; mine = 0u;
#pragma unroll
        for (unsigned j = 0; j < 16; ++j) { const unsigned c = xb_ld(&bar[XB_XCNT(j)]); sum += c; cnt += (c > 0u) ? 1u : 0u; mine = (j == x) ? c : mine; }
        if (sum == G) break;
        __builtin_amdgcn_s_sleep(1);
        if ((++sp & 255u) == 0u) { if (xb_ld(&bar[XB_TMO])) break; if (sp > XB_SPIN_CAP) { atomicAdd(&bar[XB_TMO], 1u); break; } }
    }
    nloc = mine > 0u ? mine : 1u; nx = cnt > 0u ? cnt : 1u;
}

__device__ __forceinline__ void xcd_barrier(const XcdBarrier& b) {
    asm volatile("s_waitcnt vmcnt(0)" ::: "memory");
    __syncthreads();
    if (threadIdx.x == 0) {
        unsigned* bar = b.bar;
        __builtin_amdgcn_s_waitcnt(0);
        unsigned nloc = b.st[0], nx = b.st[1];
        if (nloc == 0u) { xcd_barrier_complete(bar, b.x, nloc, nx); b.st[0] = nloc; b.st[1] = nx; }
        const unsigned old = xb_add(&bar[XB_XSUB(b.x)], 1u);
        const unsigned gen = old / nloc;
        if (old + 1u == (gen + 1u) * nloc) {
            __builtin_amdgcn_fence(__ATOMIC_RELEASE, "agent");
            asm volatile("s_waitcnt vmcnt(0)" ::: "memory");
            const unsigned og = xb_add(&bar[XB_TOP], 1u);
            const unsigned tg = og / nx;
            if (og + 1u == (tg + 1u) * nx) xb_add(&bar[XB_TOPGEN], 1u);
            else XB_SPIN(xb_ld(&bar[XB_TOPGEN]) == tg, bar);
            __builtin_amdgcn_fence(__ATOMIC_ACQUIRE, "agent");
            xb_add(&bar[XB_XGEN(b.x)], 1u);
            asm volatile("s_waitcnt vmcnt(0)" ::: "memory");
        } else {
            XB_SPIN(xb_ld(&bar[XB_XGEN(b.x)]) == gen, bar);
            __builtin_amdgcn_fence(__ATOMIC_ACQUIRE, "agent");
            asm volatile("s_waitcnt vmcnt(0)" ::: "memory");
        }
    }
    __syncthreads();
}
namespace pg8 {
#define PG8_LAS __attribute__((address_space(3)))
typedef unsigned short bf16_t;
typedef short bf16x8 __attribute__((ext_vector_type(8)));
typedef float f32x4 __attribute__((ext_vector_type(4)));
typedef unsigned u32x4 __attribute__((ext_vector_type(4)));
constexpr int BM = 256, BK = 64, HALF = 128, HTB = HALF * BK * 2  , STAGE_BYTES = 8 * HTB, NXCD = 8, WGM = 4;

__host__ __device__ __forceinline__ int lds_byte(int r, int c) { const int st = (r >> 4) * 2 + (c >> 5), rr = r & 15, cc = c & 31, ob = rr * 64 + cc * 2; return st * 1024 + (ob ^ (((ob >> 9) & 1) << 5)); }
__host__ __device__ __forceinline__ void stage_rc(int b, int& R, int& C) { const int st = b / 1024, sb = b % 1024, swz = sb ^ (((sb >> 9) & 1) << 5); R = (st >> 1) * 16 + swz / 64; C = (st & 1) * 32 + (swz % 64) / 2; }
__host__ __device__ __forceinline__ int perm32(int rho) { const int n = rho >> 4, i = rho & 15; return 8 * (i >> 2) + 4 * n + (i & 3); }

struct Unit { int pm, pn; };
struct Gemm { const void* A; const void* Bt; int nt, ldaB, ldbB; int sa, sb; };
typedef int v8i __attribute__((ext_vector_type(8)));

struct StaticOrder {
    int nM, nN, nwg, G, c;
    __host__ __device__ void init(int M, int N, int G_, int c_) { nM = M / BM; nN = N / BM; nwg = nM * nN; G = G_; c = c_; }
    __host__ __device__ bool next(int i, Unit& u) const {
        const long L = (long)i * G + c; if (L >= nwg) return false;
        int wgid = (int)L; { const int q = nwg / NXCD, r = nwg % NXCD, xcd = wgid % NXCD, off = wgid / NXCD; wgid = (xcd < r ? xcd * (q + 1) : r * (q + 1) + (xcd - r) * q) + off; }
        const int nig = WGM * nN, gid = wgid / nig, fm = gid * WGM, gsz = (nM - fm) < WGM ? (nM - fm) : WGM;
        u.pm = fm + ((wgid % nig) % gsz); u.pn = (wgid % nig) / gsz; return true;
    }
    __device__ __forceinline__ int brow(const Unit& u) const { return u.pn * BM; }
    __device__ __forceinline__ const int* rowlist() const { return nullptr; }
};

__device__ __forceinline__ unsigned cvt_pk_bf16(float lo, float hi) { unsigned r; asm volatile("v_cvt_pk_bf16_f32 %0, %1, %2" : "=v"(r) : "v"(lo), "v"(hi)); return r; }

struct EpiBf16 {
    static constexpr bool PERM = true;
    bf16_t* O; int ldc;
    __device__ __forceinline__ void operator()(const f32x4 (&acc)[2][2][4][2], const Unit& u, int wr_, int wc_, int fr_, int fq_) const {
        int t_ = threadIdx.x; asm volatile("" : "+v"(t_));
        const int wid_ = __builtin_amdgcn_readfirstlane(t_ >> 6), wr = wid_ >> 2, wc = wid_ & 3, fr = t_ & 15, fq = (t_ & 63) >> 4; (void)wr_; (void)wc_; (void)fr_; (void)fq_;
        const int row0 = u.pm * BM + wr * 64 + fr; const int col0 = u.pn * BM + wc * 32 + 8 * fq;
#pragma unroll
        for (int ai = 0; ai < 2; ++ai)
#pragma unroll
            for (int m = 0; m < 4; ++m) { bf16_t* rowp = O + (size_t)(row0 + ai * HALF + m * 16) * ldc + col0;
#pragma unroll
                for (int bj = 0; bj < 2; ++bj) { const f32x4 v0 = acc[ai][bj][m][0], v1 = acc[ai][bj][m][1];
                    u32x4 w; w.x = cvt_pk_bf16(v0[0], v0[1]); w.y = cvt_pk_bf16(v0[2], v0[3]); w.z = cvt_pk_bf16(v1[0], v1[1]); w.w = cvt_pk_bf16(v1[2], v1[3]);
                    *(u32x4*)(rowp + bj * HALF) = w; } }
    }
};
struct EpiGate {
    static constexpr bool PERM = true;
    bf16_t* P; int ldp;
    __device__ __forceinline__ void operator()(const f32x4 (&acc)[2][2][4][2], const Unit& u, int wr_, int wc_, int fr_, int fq_) const {
        int t_ = threadIdx.x; asm volatile("" : "+v"(t_));
        const int wid_ = __builtin_amdgcn_readfirstlane(t_ >> 6), wr = wid_ >> 2, wc = wid_ & 3, fr = t_ & 15, fq = (t_ & 63) >> 4; (void)wr_; (void)wc_; (void)fr_; (void)fq_;
        const int row0 = u.pm * BM + wr * 64 + fr; const int col0 = u.pn * BM + wc * 32 + 8 * fq;
        const bool sig = u.pn >= 4;
#pragma unroll
        for (int ai = 0; ai < 2; ++ai)
#pragma unroll
            for (int m = 0; m < 4; ++m) { unsigned char* rowp = (unsigned char*)(P + (size_t)(row0 + ai * HALF + m * 16) * ldp) + col0;
#pragma unroll
                for (int bj = 0; bj < 2; ++bj) { const f32x4 v0 = acc[ai][bj][m][0], v1 = acc[ai][bj][m][1];
                    float e[8] = {v0[0], v0[1], v0[2], v0[3], v1[0], v1[1], v1[2], v1[3]};
#pragma unroll
                    for (int j = 0; j < 8; ++j) e[j] = __builtin_rintf(sig ? 255.f * __builtin_amdgcn_rcpf(1.f + __expf(-e[j])) : e[j] * 20.f + 128.f);
                    unsigned w0 = 0u, w1 = 0u;
                    w0 = __builtin_amdgcn_cvt_pk_u8_f32(e[0], 0, w0); w0 = __builtin_amdgcn_cvt_pk_u8_f32(e[1], 1, w0); w0 = __builtin_amdgcn_cvt_pk_u8_f32(e[2], 2, w0); w0 = __builtin_amdgcn_cvt_pk_u8_f32(e[3], 3, w0);
                    w1 = __builtin_amdgcn_cvt_pk_u8_f32(e[4], 0, w1); w1 = __builtin_amdgcn_cvt_pk_u8_f32(e[5], 1, w1); w1 = __builtin_amdgcn_cvt_pk_u8_f32(e[6], 2, w1); w1 = __builtin_amdgcn_cvt_pk_u8_f32(e[7], 3, w1);
                    typedef unsigned u32x2_ __attribute__((ext_vector_type(2)));
                    *(u32x2_*)(rowp + bj * HALF) = (u32x2_){w0, w1}; } }
    }
};
struct EpiX1 {
    static constexpr bool PERM = true;
    const float* x; const float* gt; bf16_t* xo;
    __device__ __forceinline__ void operator()(const f32x4 (&acc)[2][2][4][2], const Unit& u, int wr_, int wc_, int fr_, int fq_) const {
        int t_ = threadIdx.x; asm volatile("" : "+v"(t_));
        const int wid_ = __builtin_amdgcn_readfirstlane(t_ >> 6), wr = wid_ >> 2, wc = wid_ & 3, fr = t_ & 15, fq = (t_ & 63) >> 4; (void)wr_; (void)wc_; (void)fr_; (void)fq_;
        const int b = (u.pm * BM) / SEQ; const float* g = gt + (size_t)b * NMOD;
        const int col0 = u.pn * BM + wc * 32 + 8 * fq;
        f32x4 gv[2][2];
#pragma unroll
        for (int bj = 0; bj < 2; ++bj)
#pragma unroll
            for (int n = 0; n < 2; ++n) gv[bj][n] = *(const f32x4*)(g + col0 + bj * HALF + n * 4);
#pragma unroll
        for (int ai = 0; ai < 2; ++ai)
#pragma unroll
            for (int m = 0; m < 4; ++m) { const size_t row = (size_t)(u.pm * BM + ai * HALF + wr * 64 + m * 16 + fr);
#pragma unroll
                for (int bj = 0; bj < 2; ++bj) {
                    const f32x4 x0 = *(const f32x4*)(x + row * D + col0 + bj * HALF), x1 = *(const f32x4*)(x + row * D + col0 + bj * HALF + 4);
                    const f32x4 v0 = x0 + gv[bj][0] * acc[ai][bj][m][0], v1 = x1 + gv[bj][1] * acc[ai][bj][m][1];
                    u32x4 w; w.x = cvt_pk_bf16(v0[0], v0[1]); w.y = cvt_pk_bf16(v0[2], v0[3]); w.z = cvt_pk_bf16(v1[0], v1[1]); w.w = cvt_pk_bf16(v1[2], v1[3]);
                    *(u32x4*)(xo + row * 2048 + col0 + bj * HALF) = w; } }
    }
};

template <bool GATHER>
__device__ __forceinline__ void mk_voff(const int* rowlist, int ldaB, int pm, int tid, unsigned (&o)[2][2]) {
#pragma unroll
    for (int h = 0; h < 2; ++h)
#pragma unroll
        for (int i = 0; i < 2; ++i) {
            int R, C; stage_rc(tid * 16 + i * 8192, R, C);
            int row = pm * BM + h * HALF + R;
            if (GATHER) { row = rowlist[row]; row = row < 0 ? 0 : row; }
            o[h][i] = (unsigned)(row * ldaB + C * 2);
        }
}

template <class Epi, class Sched, bool GATHER, bool ALIGN_EPI, bool F8 = false, bool BSPLIT = false>
__device__ __forceinline__ void gemm_phase(PG8_LAS unsigned char* lds, const Gemm g, const Sched& S, const Epi& E) {
    int tid_ = threadIdx.x; asm volatile("" : "+v"(tid_));
    const int tid = tid_, wid = __builtin_amdgcn_readfirstlane(tid >> 6), lane = tid & 63, wr = wid >> 2, wc = wid & 3, fr = lane & 15, fq = lane >> 4;
    const int nt = g.nt, lda = g.ldaB, ldbB = g.ldbB;
    const int* rl = S.rowlist();
    unsigned voffB[2], voffA0[2];
#pragma unroll
    for (int i = 0; i < 2; ++i) { int R, C; stage_rc(tid * 16 + i * 8192, R, C); const int Rb = Epi::PERM ? ((R & ~31) + perm32(R & 31)) : R;
        voffB[i] = (unsigned)(Rb * ldbB + C * 2); voffA0[i] = (unsigned)(R * lda + C * 2); }
    PG8_LAS u32x4* const xslot = (PG8_LAS u32x4*)(lds + 132096 + tid * 16);
    const size_t kstep = (size_t)(BK * 2);
    const size_t hstepB = (size_t)HALF * ldbB;
    const unsigned ldsw = (unsigned)wid * 1024u;
    const int aoff = lds_byte(wr * 64 + fr, fq * 8), boff = lds_byte(wc * 32 + fr, fq * 8);
#define PG8_SA(b, h) (((b) * 2 + (h)) * HTB)
#define PG8_SB(b, h) ((4 + (b) * 2 + (h)) * HTB)
#define PG8_STAGE(bufoff, RS, soff, voff) do { _Pragma("unroll") for (int _i = 0; _i < 2; ++_i) \
        __builtin_amdgcn_raw_ptr_buffer_load_lds(RS, (PG8_LAS unsigned*)(lds + (bufoff) + ldsw + _i * 8192), 16, (int)(voff)[_i], (int)(soff), 0, 0); } while (0)
#define PG8_LD8(p) __builtin_bit_cast(v8i, __builtin_shufflevector(*(const PG8_LAS u32x4*)(p), *(const PG8_LAS u32x4*)((p) + 1024), 0, 1, 2, 3, 4, 5, 6, 7))
#define PG8_LDA(dst, b, h) do { _Pragma("unroll") for (int m = 0; m < 4; ++m) { if constexpr (F8) dst##8[m] = PG8_LD8(lds + PG8_SA(b, h) + aoff + m * 2048); else { _Pragma("unroll") for (int k = 0; k < 2; ++k) dst[m][k] = *(const PG8_LAS bf16x8*)(lds + PG8_SA(b, h) + aoff + m * 2048 + k * 1024); } } } while (0)
#define PG8_LDB(dst, b, h) do { _Pragma("unroll") for (int n = 0; n < 2; ++n) { if constexpr (F8) dst##8[n] = PG8_LD8(lds + PG8_SB(b, h) + boff + n * 2048); else { _Pragma("unroll") for (int k = 0; k < 2; ++k) dst[n][k] = *(const PG8_LAS bf16x8*)(lds + PG8_SB(b, h) + boff + n * 2048 + k * 1024); } } } while (0)
#define PG8_MMA(ai, bj, At, Bt) do { __builtin_amdgcn_s_setprio(1); _Pragma("unroll") for (int m = 0; m < 4; ++m) _Pragma("unroll") for (int n = 0; n < 2; ++n) { \
        if constexpr (F8) asm volatile("v_mfma_scale_f32_16x16x128_f8f6f4 %0, %1, %2, %0, %3, %4 op_sel_hi:[0,0,0]" : "+v"(acc[ai][bj][m][n]) : "v"(Bt##8[n]), "v"(At##8[m]), "v"(SCALE_B), "v"(SCALE_A)); \
        else { _Pragma("unroll") for (int k = 0; k < 2; ++k) acc[ai][bj][m][n] = __builtin_amdgcn_mfma_f32_16x16x32_bf16(Bt[n][k], At[m][k], acc[ai][bj][m][n], 0, 0, 0); } } \
        __builtin_amdgcn_s_setprio(0); } while (0)
#define PG8_WAIT_V(n) asm volatile("s_waitcnt vmcnt(" #n ")" ::: "memory")
#define PG8_WAIT_L(n) asm volatile("s_waitcnt lgkmcnt(" #n ")" ::: "memory")
#define PG8_BAR __builtin_amdgcn_s_barrier()
#define PG8_SCHED __builtin_amdgcn_sched_barrier(0)
    const int SCALE_A = g.sa, SCALE_B = g.sb;
    Unit cur, nxt; int ui = 0;
    if (!S.next(0, cur)) return;
    f32x4 acc[2][2][4][2];
#pragma unroll
    for (int a = 0; a < 2; ++a)
#pragma unroll
        for (int b = 0; b < 2; ++b)
#pragma unroll
            for (int m = 0; m < 4; ++m)
#pragma unroll
                for (int n = 0; n < 2; ++n) acc[a][b][m][n] = (f32x4){0.f, 0.f, 0.f, 0.f};
    bf16x8 At[4][2], B0[2][2], B1[2][2]; v8i At8[4], B08[2], B18[2];
    unsigned voffA[2][2];
    const unsigned hstepA = (unsigned)HALF * (unsigned)lda, tstepA = 2u * hstepA;
    const __amdgpu_buffer_rsrc_t rsA = __builtin_amdgcn_make_buffer_rsrc((void*)g.A, 0, 0x7fffffff, 0x00020000), rsB = __builtin_amdgcn_make_buffer_rsrc((void*)g.Bt, 0, 0x7fffffff, 0x00020000);
    unsigned cAo = 0u, nAo = 0u;
    if constexpr (GATHER) mk_voff<true>(rl, lda, cur.pm, tid, voffA);
    else cAo = (unsigned)cur.pm * tstepA;
#define PG8_STAGE_A(bufoff, soff, h, OFFS) do { if constexpr (GATHER) PG8_STAGE(bufoff, rsA, soff, (OFFS)[h]); else PG8_STAGE(bufoff, rsA, (soff) + (h) * hstepA, voffA0); } while (0)
    unsigned cBo = (unsigned)S.brow(cur) * (unsigned)ldbB;
    const unsigned kstepu = (unsigned)kstep, hstepBu = (unsigned)hstepB;
    int cK0 = 0, cK1 = 0, nK0 = 0, nK1 = 0;
    if constexpr (BSPLIT) S.kb(cur, cK0, cK1);
#define PG8_BOFF(base, k0, k1, j) ((base) + (BSPLIT ? (unsigned)(((j) < 2 ? (k0) : (k1)) + ((j) & 1) * 128) : (unsigned)(j) * kstepu))
    { const unsigned p0 = PG8_BOFF(cBo, cK0, cK1, 0), p1 = PG8_BOFF(cBo, cK0, cK1, 1);
    PG8_STAGE(PG8_SB(0, 0), rsB, p0, voffB); PG8_STAGE(PG8_SB(0, 1), rsB, p0 + hstepBu, voffB); PG8_STAGE_A(PG8_SA(0, 0), cAo, 0, voffA); PG8_STAGE_A(PG8_SA(0, 1), cAo, 1, voffA);
    if (wr == 1) PG8_BAR;
    PG8_WAIT_V(2); PG8_BAR;
    PG8_STAGE(PG8_SB(1, 0), rsB, p1, voffB); PG8_STAGE_A(PG8_SA(1, 0), cAo + kstepu, 0, voffA); PG8_STAGE(PG8_SB(1, 1), rsB, p1 + hstepBu, voffB); }
    PG8_WAIT_V(6); PG8_BAR;
    for (;;) {
        const bool has_next = S.next(ui + 1, nxt);
        if constexpr (GATHER) {
            unsigned vn[2][2];
            if (has_next) mk_voff<true>(rl, lda, nxt.pm, tid, vn);
            else {
#pragma unroll
                for (int h = 0; h < 2; ++h)
#pragma unroll
                    for (int i = 0; i < 2; ++i) vn[h][i] = voffA[h][i]; }
            *xslot = (u32x4){vn[0][0], vn[0][1], vn[1][0], vn[1][1]};
        } else nAo = has_next ? (unsigned)nxt.pm * tstepA : cAo;
        const unsigned nBo = has_next ? (unsigned)S.brow(nxt) * (unsigned)ldbB : cBo;
        if constexpr (BSPLIT) { if (has_next) S.kb(nxt, nK0, nK1); else { nK0 = cK0; nK1 = cK1; } }
#pragma nounroll
        for (int t = 0; t < nt; t += 2) {
            const bool last = (t == nt - 2);
            const unsigned a1 = cAo + (unsigned)(t + 1) * kstepu;
            const unsigned a2 = last ? nAo : cAo + (unsigned)(t + 2) * kstepu, b2 = last ? PG8_BOFF(nBo, nK0, nK1, 0) : PG8_BOFF(cBo, cK0, cK1, t + 2);
            const unsigned a3 = a2 + kstepu, b3 = last ? PG8_BOFF(nBo, nK0, nK1, 1) : PG8_BOFF(cBo, cK0, cK1, t + 3);
            unsigned sl[2][2];
            if constexpr (GATHER) {
                if (last) { const u32x4 vn = *xslot; sl[0][0] = vn.x; sl[0][1] = vn.y; sl[1][0] = vn.z; sl[1][1] = vn.w; }
                else {
#pragma unroll
                    for (int h = 0; h < 2; ++h)
#pragma unroll
                        for (int i = 0; i < 2; ++i) sl[h][i] = voffA[h][i]; } }
            PG8_LDB(B0, 0, 0); PG8_LDB(B1, 0, 1); PG8_SCHED; PG8_LDA(At, 0, 0); PG8_STAGE_A(PG8_SA(1, 1), a1, 1, voffA);
            PG8_WAIT_V(8); PG8_WAIT_L(0); PG8_BAR; PG8_MMA(0, 0, At, B0); PG8_MMA(0, 1, At, B1); PG8_BAR; PG8_SCHED;
            PG8_LDA(At, 0, 1); PG8_STAGE(PG8_SB(0, 0), rsB, b2, voffB); PG8_STAGE(PG8_SB(0, 1), rsB, b2 + hstepBu, voffB); PG8_STAGE_A(PG8_SA(0, 0), a2, 0, sl);
            PG8_WAIT_V(8); PG8_WAIT_L(0); PG8_BAR; PG8_MMA(1, 0, At, B0); PG8_MMA(1, 1, At, B1); PG8_BAR; PG8_SCHED;
            PG8_LDB(B0, 1, 0); PG8_LDB(B1, 1, 1); PG8_SCHED; PG8_LDA(At, 1, 0); PG8_STAGE_A(PG8_SA(0, 1), a2, 1, sl);
            PG8_WAIT_V(8); PG8_WAIT_L(0); PG8_BAR; PG8_MMA(0, 0, At, B0); PG8_MMA(0, 1, At, B1); PG8_BAR; PG8_SCHED;
            PG8_LDA(At, 1, 1); PG8_STAGE(PG8_SB(1, 0), rsB, b3, voffB); PG8_STAGE(PG8_SB(1, 1), rsB, b3 + hstepBu, voffB); PG8_STAGE_A(PG8_SA(1, 0), a3, 0, sl);
            PG8_WAIT_V(8); PG8_WAIT_L(0); PG8_BAR; PG8_MMA(1, 0, At, B0); PG8_MMA(1, 1, At, B1); PG8_BAR; PG8_SCHED;
        }
        if constexpr (ALIGN_EPI) { if (wr == 0) PG8_BAR; }
        if constexpr (F8) asm volatile("s_nop 15\n\ts_nop 7" ::: "memory");
        E(acc, cur, wr, wc, fr, fq);
        if (!has_next) break;
#pragma unroll
        for (int a = 0; a < 2; ++a)
#pragma unroll
            for (int b = 0; b < 2; ++b)
#pragma unroll
                for (int m = 0; m < 4; ++m)
#pragma unroll
                    for (int n = 0; n < 2; ++n) acc[a][b][m][n] = (f32x4){0.f, 0.f, 0.f, 0.f};
        cur = nxt; cBo = nBo; cAo = nAo; cK0 = nK0; cK1 = nK1; ++ui;
        if constexpr (GATHER) { const u32x4 vn = *xslot; voffA[0][0] = vn.x; voffA[0][1] = vn.y; voffA[1][0] = vn.z; voffA[1][1] = vn.w; }
        if constexpr (ALIGN_EPI) { if (wr == 1) PG8_BAR; }
    }
    PG8_WAIT_V(0);
    if constexpr (!ALIGN_EPI) { if (wr == 0) PG8_BAR; }
    PG8_BAR;
#undef PG8_SA
#undef PG8_SB
#undef PG8_STAGE
#undef PG8_STAGE_A
#undef PG8_BOFF
#undef PG8_LDA
#undef PG8_LDB
#undef PG8_MMA
#undef PG8_LD8
#undef PG8_WAIT_V
#undef PG8_WAIT_L
#undef PG8_BAR
#undef PG8_SCHED
}
}
constexpr int NWAVES = 8;
constexpr int RING_OFF = 0, RING_BYTES = 131072;
constexpr int LDSCTL_OFF = RING_BYTES, MISC_OFF = LDSCTL_OFF + 320;
constexpr int LDS_BYTES = 147456;
static_assert(MISC_OFF + 128 <= LDS_BYTES, "LDS map");

struct Frame {
    LAS unsigned char* lds;
    volatile LAS unsigned* MISC;
    gu32* ctl;
    int tid, lane, wave;
    int vcu, G;
};
struct Args { const float* in[20]; float* out; unsigned char* ws; int ph_lo, ph_hi, li, pad; };

typedef float f32x16 __attribute__((ext_vector_type(16)));
typedef unsigned u32x2 __attribute__((ext_vector_type(2)));
__device__ __forceinline__ float bfl(unsigned w) { return __uint_as_float(w << 16); }
__device__ __forceinline__ float bfh(unsigned w) { return __uint_as_float(w & 0xffff0000u); }
#define LDS_BARRIER() do { asm volatile("s_waitcnt lgkmcnt(0)" ::: "memory"); __builtin_amdgcn_s_barrier(); asm volatile("" ::: "memory"); } while (0)
constexpr int NBK = 24, MAXPOS = 40960, MAXTILES = MAXPOS / 256;
constexpr size_t SORT_CNT = 0;
constexpr size_t SORT_SEG = 32768;
constexpr size_t SORT_TILEB = 33024;
constexpr size_t SORT_ROWLIST = 65536;
constexpr size_t SORT_CW = 262144;
constexpr int RB_ROWS = 128, NRB = T / RB_ROWS;
__device__ __forceinline__ int pair_id(int lo, int hi) { return (lo == 0 ? 0 : (lo == 1 ? 3 : 5)) + hi - lo - 1; }
__device__ __forceinline__ void pair_lohi(int pid, int& lo, int& hi) { lo = pid < 3 ? 0 : (pid < 5 ? 1 : 2); hi = pid < 3 ? pid + 1 : (pid < 5 ? pid - 1 : 3); }

__device__ __forceinline__ float wsum64(float v) {
#pragma unroll
    for (int o = 1; o < 64; o <<= 1) v += __shfl_xor(v, o);
    return v;
}

constexpr int R8_PITCH = 2064, R8_TILE = 0, R8_WT = 32 * R8_PITCH, R8_RED = R8_WT + 20 * R8_PITCH, R8_CNT = R8_RED + 8 * 32 * 20 * 4, R8_END = R8_CNT + 128;
static_assert(R8_END <= RING_BYTES, "p8 lds");
__device__ __forceinline__ void p8_h2_route(Frame& F0, const Args& args, const float* mod, unsigned char* A1) {
    Frame F = F0; { int t__ = threadIdx.x; asm volatile("" : "+v"(t__)); F.tid = t__; F.lane = t__ & 63; F.wave = __builtin_amdgcn_readfirstlane(t__ >> 6); }
    const bf16* x1 = (const bf16*)args.out; const float* g2 = args.in[11]; const float* w_group = args.in[12]; const float* b_group = args.in[13]; const float* w_router = args.in[14]; const float* b_router = args.in[15];
    int4* route = (int4*)(args.ws + WS_ROUTE); int* cnt = (int*)(args.ws + WS_SORT + SORT_CNT);
    LAS unsigned char* tile = F.lds + RING_OFF + R8_TILE; LAS unsigned char* wt = F.lds + RING_OFF + R8_WT; LAS float* red = (LAS float*)(F.lds + RING_OFF + R8_RED); LAS int* lcnt = (LAS int*)(F.lds + RING_OFF + R8_CNT);
    const int lane = F.lane, w = F.wave, vl = lane & 31, hh = lane >> 5;
    for (int d = F.tid; d < D; d += NWAVES * 64) {
        const f32x4 wg = *(const f32x4*)(w_group + (size_t)d * 4);
        *(LAS unsigned short*)(wt + 0 * R8_PITCH + d * 2) = (unsigned short)f2bf(wg.x); *(LAS unsigned short*)(wt + 1 * R8_PITCH + d * 2) = (unsigned short)f2bf(wg.y);
        *(LAS unsigned short*)(wt + 2 * R8_PITCH + d * 2) = (unsigned short)f2bf(wg.z); *(LAS unsigned short*)(wt + 3 * R8_PITCH + d * 2) = (unsigned short)f2bf(wg.w);
#pragma unroll
        for (int q = 0; q < 4; ++q) { const f32x4 w4 = *(const f32x4*)(w_router + (size_t)d * 16 + q * 4);
            *(LAS unsigned short*)(wt + (4 + q * 4 + 0) * R8_PITCH + d * 2) = (unsigned short)f2bf(w4.x); *(LAS unsigned short*)(wt + (4 + q * 4 + 1) * R8_PITCH + d * 2) = (unsigned short)f2bf(w4.y);
            *(LAS unsigned short*)(wt + (4 + q * 4 + 2) * R8_PITCH + d * 2) = (unsigned short)f2bf(w4.z); *(LAS unsigned short*)(wt + (4 + q * 4 + 3) * R8_PITCH + d * 2) = (unsigned short)f2bf(w4.w); }
    }
    __syncthreads();
    for (int rb = blockIdx.x; rb < NRB; rb += F.G) {
        const int b = (rb * RB_ROWS) / SEQ; const float* sh = mod + b * NMOD + 3 * D; const float* sc = mod + b * NMOD + 4 * D;
        f32x4 scl[4], sft[4];
#pragma unroll
        for (int j = 0; j < 2; ++j)
#pragma unroll
            for (int q = 0; q < 2; ++q) { const int c0 = lane * 8 + 512 * j + 4 * q; scl[2 * j + q] = *(const f32x4*)(g2 + c0) * (*(const f32x4*)(sc + c0) + 1.f); sft[2 * j + q] = *(const f32x4*)(sh + c0); }
        if (F.tid < NBK) lcnt[F.tid] = 0;
        for (int bt = 0; bt < 4; ++bt) {
            const int rbase = rb * RB_ROWS + bt * 32;
            v4u xr[4][2];
#pragma unroll
            for (int i = 0; i < 4; ++i)
#pragma unroll
                for (int j = 0; j < 2; ++j) xr[i][j] = *(const GAS v4u*)(x1 + (size_t)(rbase + w * 4 + i) * 2048 + lane * 8 + 512 * j);
#pragma unroll
            for (int i = 0; i < 4; ++i) {
                const int row = rbase + w * 4 + i;
                f32x4 v[4]; float s = 0.f;
#pragma unroll
                for (int j = 0; j < 2; ++j) { v[2 * j] = (f32x4){bfl(xr[i][j].x), bfh(xr[i][j].x), bfl(xr[i][j].y), bfh(xr[i][j].y)}; v[2 * j + 1] = (f32x4){bfl(xr[i][j].z), bfh(xr[i][j].z), bfl(xr[i][j].w), bfh(xr[i][j].w)}; }

#pragma unroll
                for (int q = 0; q < 4; ++q) s += (v[q].x * v[q].x + v[q].y * v[q].y) + (v[q].z * v[q].z + v[q].w * v[q].w);
                const float rstd = rsqrtf(wsum64(s) * (1.f / D) + EPS);
#pragma unroll
                for (int j = 0; j < 2; ++j) { const f32x4 y0 = v[2 * j] * rstd * scl[2 * j] + sft[2 * j], y1 = v[2 * j + 1] * rstd * scl[2 * j + 1] + sft[2 * j + 1];
                    const v4u o = {pg8::cvt_pk_bf16(y0.x, y0.y), pg8::cvt_pk_bf16(y0.z, y0.w), pg8::cvt_pk_bf16(y1.x, y1.y), pg8::cvt_pk_bf16(y1.z, y1.w)};
                    { int q0 = __builtin_amdgcn_cvt_pk_fp8_f32(y0.x, y0.y, 0, false); q0 = __builtin_amdgcn_cvt_pk_fp8_f32(y0.z, y0.w, q0, true);
                      int q1 = __builtin_amdgcn_cvt_pk_fp8_f32(y1.x, y1.y, 0, false); q1 = __builtin_amdgcn_cvt_pk_fp8_f32(y1.z, y1.w, q1, true);
                      *(GAS u32x2*)(A1 + (size_t)row * D + lane * 8 + 512 * j) = (u32x2){(unsigned)q0, (unsigned)q1}; }
                    *(LAS v4u*)(tile + (w * 4 + i) * R8_PITCH + (lane * 8 + 512 * j) * 2) = o; }
            }
            __syncthreads();
            {
                f32x16 acc = {0.f, 0.f, 0.f, 0.f, 0.f, 0.f, 0.f, 0.f, 0.f, 0.f, 0.f, 0.f, 0.f, 0.f, 0.f, 0.f};
                const int cr = vl < 20 ? vl : 19;
#pragma unroll
                for (int kk = 0; kk < 8; ++kk) { const bf16x8 a = *(const LAS bf16x8*)(tile + vl * R8_PITCH + (128 * w + 16 * kk + 8 * hh) * 2), bb = *(const LAS bf16x8*)(wt + cr * R8_PITCH + (128 * w + 16 * kk + 8 * hh) * 2);
                    acc = __builtin_amdgcn_mfma_f32_32x32x16_bf16(a, bb, acc, 0, 0, 0); }
                if (vl < 20) {
#pragma unroll
                    for (int r = 0; r < 16; ++r) red[(w * 32 + (r & 3) + 8 * (r >> 2) + 4 * hh) * 20 + vl] = acc[r]; }
            }
            __syncthreads();
            if (F.tid < 32) {
                const int row = rbase + F.tid;
                float lg[20];
#pragma unroll
                for (int c = 0; c < 20; ++c) { float a = 0.f;
#pragma unroll
                    for (int ww = 0; ww < 8; ++ww) a += red[(ww * 32 + F.tid) * 20 + c];
                    lg[c] = a; }
                float bg[4], br[16];
#pragma unroll
                for (int c = 0; c < 4; ++c) bg[c] = b_group[c];
#pragma unroll
                for (int c = 0; c < 16; ++c) br[c] = b_router[c];
                float gl[4]; int gi = 0;
#pragma unroll
                for (int c = 0; c < 4; ++c) gl[c] = lg[c] + bg[c];
                float gm = gl[0];
#pragma unroll
                for (int c = 1; c < 4; ++c) if (gl[c] > gm) { gm = gl[c]; gi = c; }
                float den = 0.f;
#pragma unroll
                for (int c = 0; c < 4; ++c) den += __expf(gl[c] - gm);
                const float gw = 1.f / den;
                float el[4];
#pragma unroll
                for (int c = 0; c < 4; ++c) { float vsel = lg[4 + c] + br[c];
#pragma unroll
                    for (int g = 1; g < 4; ++g) { const float cand = lg[4 + g * 4 + c] + br[g * 4 + c]; vsel = (gi == g) ? cand : vsel; }
                    el[c] = vsel; }
                int i0 = 0; float v0 = el[0];
#pragma unroll
                for (int c = 1; c < 4; ++c) if (el[c] > v0) { v0 = el[c]; i0 = c; }
                int i1 = -1; float v1 = -3.0e38f;
#pragma unroll
                for (int c = 0; c < 4; ++c) if (c != i0 && el[c] > v1) { v1 = el[c]; i1 = c; }
                const float p1 = __expf(v1 - v0), w0 = gw / (1.f + p1), w1 = gw * p1 / (1.f + p1);
                route[row] = make_int4(gi * 4 + i0, gi * 4 + i1, __float_as_int(w0), __float_as_int(w1));
                const int lo = i0 < i1 ? i0 : i1, hi = i0 < i1 ? i1 : i0;
                atomicAdd((int*)(lcnt + gi * 6 + pair_id(lo, hi)), 1);
            }
        }
        if (F.tid < 32) { asm volatile("s_waitcnt lgkmcnt(0)" ::: "memory"); if (F.tid < NBK) cnt[rb * NBK + F.tid] = lcnt[F.tid]; }
    }
}

__device__ __forceinline__ void p9_sort(Frame& F0, const Args& args) {
    Frame F = F0; { int t__ = threadIdx.x; asm volatile("" : "+v"(t__)); F.tid = t__; F.lane = t__ & 63; F.wave = __builtin_amdgcn_readfirstlane(t__ >> 6); }
    const int4* route = (const int4*)(args.ws + WS_ROUTE); const int* cnt = (const int*)(args.ws + WS_SORT + SORT_CNT);
    int* seg = (int*)(args.ws + WS_SORT + SORT_SEG); int* tileb = (int*)(args.ws + WS_SORT + SORT_TILEB); int* rowlist = (int*)(args.ws + WS_SORT + SORT_ROWLIST); float* cw = (float*)(args.ws + WS_SORT + SORT_CW);
    LAS int* scn = (LAS int*)(F.lds + RING_OFF);
    LAS int* sst = (LAS int*)(F.lds + RING_OFF + 24576);
    LAS int* sw0 = (LAS int*)(F.lds + RING_OFF + 24576 + 256);
    LAS int* sbase = (LAS int*)(F.lds + RING_OFF + 24576 + 384);
    for (int i = F.tid; i < NRB * NBK; i += NWAVES * 64) scn[i] = cnt[i];
    __syncthreads();
    if (F.tid < NBK) { int s = 0; for (int r = 0; r < NRB; ++r) s += scn[r * NBK + F.tid]; sst[32 + F.tid] = s; }
    __syncthreads();
    if (F.tid == 0) { int p = 0; for (int k = 0; k < NBK; ++k) { sst[k] = p; p += (sst[32 + k] + 255) & ~255; } sst[NBK] = p; }
    __syncthreads();
    if (blockIdx.x == 0) {
        if (F.tid <= NBK) seg[F.tid] = sst[F.tid];
        if (F.tid == 32) seg[32] = sst[NBK] / 256;
        for (int t = F.tid; t < sst[NBK] / 256; t += NWAVES * 64) { int k = 0;
#pragma unroll 1
            for (int q = 1; q < NBK; ++q) k += (t * 256 >= sst[q]) ? 1 : 0;
            while (k > 0 && sst[32 + k] == 0) --k;
            tileb[t] = k; }
    }
    if (blockIdx.x < NBK) {
        const int k = blockIdx.x, p0 = sst[k] + sst[32 + k], p1 = sst[k + 1];
        for (int p = p0 + F.tid; p < p1; p += NWAVES * 64) { rowlist[p] = -1; cw[2 * p] = 0.f; cw[2 * p + 1] = 0.f; }
    }
    for (int rb = blockIdx.x; rb < NRB; rb += F.G) {
        if (F.tid < NBK) { int s = 0; for (int r = 0; r < rb; ++r) s += scn[r * NBK + F.tid]; sbase[F.tid] = sst[F.tid] + s; }
        const bool act = F.tid < RB_ROWS;
        const int row = rb * RB_ROWS + (act ? F.tid : 0);
        int4 rt = make_int4(0, 0, 0, 0); int bk = -1, lo = 0;
        if (act) { rt = route[row]; const int a = rt.x & 3, c = rt.y & 3; lo = a < c ? a : c; const int hi = a < c ? c : a; bk = (rt.x >> 2) * 6 + pair_id(lo, hi); }
        const unsigned long long lt = (1ull << F.lane) - 1ull;
        int rank = 0, mycount = 0;
#pragma unroll 1
        for (int q = 0; q < NBK; ++q) { const unsigned long long mk = __ballot(bk == q); if (bk == q) rank = __popcll(mk & lt); if (F.lane == q) mycount = __popcll(mk); }
        if (F.wave == 0 && F.lane < NBK) sw0[F.lane] = mycount;
        __syncthreads();
        if (act) {
            if (F.wave == 1) rank += sw0[bk];
            const int pos = sbase[bk] + rank;
            const float w0 = __int_as_float(rt.z), w1 = __int_as_float(rt.w);
            const bool first_is_lo = (rt.x & 3) == lo;
            rowlist[pos] = row; cw[2 * pos] = first_is_lo ? w0 : w1; cw[2 * pos + 1] = first_is_lo ? w1 : w0;
        }
        __syncthreads();
    }
}

struct PairOrder10 {
    pg8::StaticOrder so; const int* rl; const int* tileb;
    __device__ __forceinline__ bool next(int i, pg8::Unit& u) const { return so.next(i, u); }
    __device__ __forceinline__ int brow(const pg8::Unit& u) const { const int bk = __builtin_amdgcn_readfirstlane(tileb[u.pm]); int lo, hi; pair_lohi(bk % 6, lo, hi);
        return ((bk / 6) * 4 + ((u.pn >> 1) ? hi : lo)) * 512 + (u.pn & 1) * 256; }
    __device__ __forceinline__ const int* rowlist() const { return rl; }
};
struct PairOrder11 {
    const int* tileb; int nunits, G, c;
    __device__ __forceinline__ bool next(int i, pg8::Unit& u) const { const int L = i * G + c; if (L >= nunits) return false; u.pm = L >> 2; u.pn = L & 3; return true; }
    __device__ __forceinline__ int brow(const pg8::Unit& u) const { const int bk = __builtin_amdgcn_readfirstlane(tileb[u.pm]); return (bk / 6) * 1024 + u.pn * 256; }
    __device__ __forceinline__ void kb(const pg8::Unit& u, int& k0, int& k1) const { const int bk = __builtin_amdgcn_readfirstlane(tileb[u.pm]); int lo, hi; pair_lohi(bk % 6, lo, hi); k0 = lo * 256; k1 = hi * 256; }
    __device__ __forceinline__ const int* rowlist() const { return nullptr; }
};
struct EpiHid {
    static constexpr bool PERM = true;
    unsigned char* H; const float* cw;
    __device__ __forceinline__ void operator()(const pg8::f32x4 (&acc)[2][2][4][2], const pg8::Unit& u, int wr_, int wc_, int fr_, int fq_) const {
        int t_ = threadIdx.x; asm volatile("" : "+v"(t_));
        const int wid_ = __builtin_amdgcn_readfirstlane(t_ >> 6), wr = wid_ >> 2, wc = wid_ & 3, fr = t_ & 15, fq = (t_ & 63) >> 4; (void)wr_; (void)wc_; (void)fr_; (void)fq_;
        const int sl = u.pn >> 1; const int col0 = sl * 256 + (u.pn & 1) * 128 + wc * 32 + 8 * fq;
#pragma unroll
        for (int ai = 0; ai < 2; ++ai)
#pragma unroll
            for (int m = 0; m < 4; ++m) { const int pos = u.pm * 256 + ai * 128 + wr * 64 + m * 16 + fr; const float w = cw[(size_t)pos * 2 + sl] * 16.f;
                const pg8::f32x4 g0 = acc[ai][0][m][0], g1 = acc[ai][0][m][1], u0 = acc[ai][1][m][0], u1 = acc[ai][1][m][1];
                float h[8];
#pragma unroll
                for (int j = 0; j < 4; ++j) { h[j] = g0[j] * __builtin_amdgcn_rcpf(1.f + __expf(-g0[j])) * u0[j] * w; h[4 + j] = g1[j] * __builtin_amdgcn_rcpf(1.f + __expf(-g1[j])) * u1[j] * w; }
                int q0 = __builtin_amdgcn_cvt_pk_fp8_f32(h[0], h[1], 0, false); q0 = __builtin_amdgcn_cvt_pk_fp8_f32(h[2], h[3], q0, true);
                int q1 = __builtin_amdgcn_cvt_pk_fp8_f32(h[4], h[5], 0, false); q1 = __builtin_amdgcn_cvt_pk_fp8_f32(h[6], h[7], q1, true);
                *(u32x2*)(H + (size_t)pos * 512 + col0) = (u32x2){(unsigned)q0, (unsigned)q1}; }
    }
};
constexpr size_t WS_XBUF = 5 * MiB, XBUF_BYTES = (size_t)MAXPOS * 4 * 8;
struct EpiFinal {
    static constexpr bool PERM = true;
    const int* rl; const float* gt; const pg8::bf16_t* x1; float* out; const float* gf; unsigned long long* xbuf; LAS unsigned char* xl;
    __device__ __forceinline__ void operator()(const pg8::f32x4 (&acc)[2][2][4][2], const pg8::Unit& u, int wr_, int wc_, int fr_, int fq_) const {
        int t_ = threadIdx.x; asm volatile("" : "+v"(t_));
        const int wid_ = __builtin_amdgcn_readfirstlane(t_ >> 6), wr = wid_ >> 2, wc = wid_ & 3, fr = t_ & 15, fq = (t_ & 63) >> 4; (void)wr_; (void)wc_; (void)fr_; (void)fq_;
        LAS float* Pl = (LAS float*)xl; LAS float* Sl = (LAS float*)(xl + 4096);
        const int col0 = u.pn * 256 + wc * 32 + 8 * fq;
        pg8::f32x4 v[2][2][4][2]; int tok[2][4];
#pragma unroll
        for (int ai = 0; ai < 2; ++ai) {
#pragma unroll
            for (int m = 0; m < 4; ++m) tok[ai][m] = rl[u.pm * 256 + ai * 128 + wr * 64 + m * 16 + fr];
#pragma unroll
            for (int m = 0; m < 4; ++m) { const int t = tok[ai][m]; float s = 0.f;
                if (t >= 0) { const float* g = gt + (size_t)(t / SEQ) * NMOD + col0; const pg8::bf16_t* o = x1 + (size_t)t * 2048 + col0;
#pragma unroll
                    for (int bj = 0; bj < 2; ++bj) { const pg8::f32x4 g0 = *(const pg8::f32x4*)(g + bj * 128), g1 = *(const pg8::f32x4*)(g + bj * 128 + 4); const pg8::u32x4 xv = *(const pg8::u32x4*)(o + bj * 128);
                        const pg8::f32x4 a0 = acc[ai][bj][m][0], a1 = acc[ai][bj][m][1];
                        const pg8::f32x4 y0 = {bfl(xv.x) + g0[0] * a0[0], bfh(xv.x) + g0[1] * a0[1], bfl(xv.y) + g0[2] * a0[2], bfh(xv.y) + g0[3] * a0[3]};
                        const pg8::f32x4 y1 = {bfl(xv.z) + g1[0] * a1[0], bfh(xv.z) + g1[1] * a1[1], bfl(xv.w) + g1[2] * a1[2], bfh(xv.w) + g1[3] * a1[3]};
                        v[ai][bj][m][0] = y0; v[ai][bj][m][1] = y1;
                        s += (y0[0] * y0[0] + y0[1] * y0[1]) + (y0[2] * y0[2] + y0[3] * y0[3]) + (y1[0] * y1[0] + y1[1] * y1[1]) + (y1[2] * y1[2] + y1[3] * y1[3]); } }
                else {
#pragma unroll
                    for (int bj = 0; bj < 2; ++bj) { v[ai][bj][m][0] = (pg8::f32x4){0.f, 0.f, 0.f, 0.f}; v[ai][bj][m][1] = (pg8::f32x4){0.f, 0.f, 0.f, 0.f}; } }
                s += __shfl_xor(s, 16); s += __shfl_xor(s, 32);
                if (fq == 0) Pl[(ai * 128 + wr * 64 + m * 16 + fr) * 4 + wc] = s; }
        }
        asm volatile("s_waitcnt lgkmcnt(0)" ::: "memory"); __builtin_amdgcn_s_barrier(); asm volatile("" ::: "memory");
        if (t_ < 256) {
            const float ps = (Pl[t_ * 4 + 0] + Pl[t_ * 4 + 1]) + (Pl[t_ * 4 + 2] + Pl[t_ * 4 + 3]);
            unsigned long long* slot = xbuf + (size_t)(u.pm * 256 + t_) * 4;
            __hip_atomic_store(slot + u.pn, (1ull << 32) | (unsigned long long)__float_as_uint(ps), __ATOMIC_RELAXED, __HIP_MEMORY_SCOPE_AGENT);
            float tot = 0.f;
            for (unsigned sp = 0; sp < (1u << 16); ++sp) {
                const unsigned long long g0 = __hip_atomic_load(slot + 0, __ATOMIC_RELAXED, __HIP_MEMORY_SCOPE_AGENT), g1 = __hip_atomic_load(slot + 1, __ATOMIC_RELAXED, __HIP_MEMORY_SCOPE_AGENT),
                                         g2 = __hip_atomic_load(slot + 2, __ATOMIC_RELAXED, __HIP_MEMORY_SCOPE_AGENT), g3 = __hip_atomic_load(slot + 3, __ATOMIC_RELAXED, __HIP_MEMORY_SCOPE_AGENT);
                tot = (__uint_as_float((unsigned)g0) + __uint_as_float((unsigned)g1)) + (__uint_as_float((unsigned)g2) + __uint_as_float((unsigned)g3));
                if (((g0 >> 32) & (g1 >> 32) & (g2 >> 32) & (g3 >> 32)) == 1ull) break;
                __builtin_amdgcn_s_sleep(2);
            }
            Sl[t_] = rsqrtf(tot * (1.f / D) + EPS);
        }
        asm volatile("s_waitcnt vmcnt(0) lgkmcnt(0)" ::: "memory"); __builtin_amdgcn_s_barrier(); asm volatile("" ::: "memory");
#pragma unroll
        for (int ai = 0; ai < 2; ++ai)
#pragma unroll
            for (int m = 0; m < 4; ++m) { const int t = tok[ai][m];
                if (t >= 0) { const float rstd = Sl[ai * 128 + wr * 64 + m * 16 + fr]; float* o = out + (size_t)t * D + col0;
#pragma unroll
                    for (int bj = 0; bj < 2; ++bj) { const pg8::f32x4 f0 = *(const pg8::f32x4*)(gf + col0 + bj * 128), f1 = *(const pg8::f32x4*)(gf + col0 + bj * 128 + 4);
                        *(pg8::f32x4*)(o + bj * 128) = v[ai][bj][m][0] * rstd * f0; *(pg8::f32x4*)(o + bj * 128 + 4) = v[ai][bj][m][1] * rstd * f1; } } }
        asm volatile("s_waitcnt lgkmcnt(0)" ::: "memory"); __builtin_amdgcn_s_barrier(); asm volatile("" ::: "memory");
    }
};
constexpr int SWA_KP = 144, SWA_VP = 520, SWA_OP = 144;
constexpr int SWA_KS = 0, SWA_VT = 256 * SWA_KP, SWA_OS = SWA_VT + 64 * SWA_VP, SWA_LDS = SWA_OS + 8 * 32 * SWA_OP;
static_assert(SWA_LDS <= RING_BYTES, "swa lds");
__device__ __forceinline__ float fast_sigmoid(float x) { return __builtin_amdgcn_rcpf(1.f + __expf(-x)); }

__device__ __forceinline__ void p6_swa_merge(Frame& F0, bf16* P, bf16* Mg, const bf16* OA, const float* sink) {
    Frame F = F0; { int t__ = threadIdx.x; asm volatile("" : "+v"(t__)); F.tid = t__; F.lane = t__ & 63; F.wave = __builtin_amdgcn_readfirstlane(t__ >> 6); }
    const int lane = F.lane, w = F.wave, q = lane & 31, h = lane >> 5, tid = F.tid;
    LAS unsigned char* Ks = F.lds + RING_OFF + SWA_KS;
    LAS unsigned char* Vt = F.lds + RING_OFF + SWA_VT;
    LAS unsigned char* Os = F.lds + RING_OFF + SWA_OS + w * (32 * SWA_OP);
    constexpr float L2E = 1.4426950408889634f, CS = 0.125f * L2E;
    for (int unit = blockIdx.x; unit < NB * 64 * 2; unit += F.G) {
        const int hk = unit & 1, qb = (unit >> 1) & 63, b = unit >> 7;
        const int t0 = qb * 128; const size_t rowbase = (size_t)b * SEQ;
        LDS_BARRIER();
        {
        {
            const int pc = tid & 7;
            v4u kv[4], vv[4];
#pragma unroll
            for (int i = 0; i < 4; ++i) { const int kr = (tid >> 3) + 64 * i; int tp = t0 - 128 + kr; tp = tp < 0 ? 0 : tp;
                const bf16* src = P + (rowbase + tp) * PWB;
                kv[i] = *(const v4u*)(src + PE_KB + hk * 64 + pc * 8); vv[i] = *(const v4u*)(src + PE_VB + hk * 64 + pc * 8); }
#pragma unroll
            for (int i = 0; i < 4; ++i) { const int kr = (tid >> 3) + 64 * i;
                *(LAS v4u*)(Ks + kr * SWA_KP + pc * 16) = kv[i];
                const unsigned wds[4] = {vv[i].x, vv[i].y, vv[i].z, vv[i].w};
#pragma unroll
                for (int e = 0; e < 4; ++e) { const int d = pc * 8 + e * 2;
                    *(LAS unsigned short*)(Vt + d * SWA_VP + kr * 2) = (unsigned short)(wds[e] & 0xffffu);
                    *(LAS unsigned short*)(Vt + (d + 1) * SWA_VP + kr * 2) = (unsigned short)(wds[e] >> 16); }
            }
        }
        }
        LDS_BARRIER();
        const int head = hk * 8 + w; const float snk = sink[head] * L2E;
        bf16x8 qf_n[4];
        { const bf16* qp = P + (rowbase + t0 + q) * PWB + PE_QB + head * 64 + 8 * h;
#pragma unroll
          for (int kk = 0; kk < 4; ++kk) qf_n[kk] = *(const bf16x8*)(qp + 16 * kk); }
        for (int sb = 0; sb < 4; ++sb) {
            const int q0 = t0 + 32 * sb;
            bf16x8 qf[4];
#pragma unroll
            for (int kk = 0; kk < 4; ++kk) qf[kk] = qf_n[kk];
            const int mq = lane >> 3, mp8 = lane & 7; const size_t mrow = rowbase + q0 + mq; const int mcol = head * 64 + 8 * mp8;
            u32x2 gav[4], gbv[4]; v4u oav[4];
#pragma unroll
            for (int i = 0; i < 4; ++i) { const size_t r = mrow + 8 * i;
                gav[i] = *(const u32x2*)((const unsigned char*)(P + r * PWB) + PC_GA + mcol); gbv[i] = *(const u32x2*)((const unsigned char*)(P + r * PWB) + PC_GB + mcol); oav[i] = *(const v4u*)(OA + r * D + mcol); }
            if (sb < 3) { const bf16* qp = P + (rowbase + q0 + 32 + q) * PWB + PE_QB + head * 64 + 8 * h;
#pragma unroll
                for (int kk = 0; kk < 4; ++kk) qf_n[kk] = *(const bf16x8*)(qp + 16 * kk); }
            f32x16 O0, O1; float inv;
            {
            f32x16 S[5];
#pragma unroll
            for (int kt = 0; kt < 5; ++kt) {
                f32x16 acc = {0.f, 0.f, 0.f, 0.f, 0.f, 0.f, 0.f, 0.f, 0.f, 0.f, 0.f, 0.f, 0.f, 0.f, 0.f, 0.f};
#pragma unroll
                for (int kk = 0; kk < 4; ++kk) { const bf16x8 a = *(const LAS bf16x8*)(Ks + (32 * (sb + kt) + q) * SWA_KP + (16 * kk + 8 * h) * 2);
                    acc = __builtin_amdgcn_mfma_f32_32x32x16_bf16(a, qf[kk], acc, 0, 0, 0); }
                S[kt] = acc;
            }
            float mx = snk;
#pragma unroll
            for (int kt = 0; kt < 5; ++kt)
#pragma unroll
                for (int r = 0; r < 16; ++r) { const int kin = (r & 3) + 8 * (r >> 2) + 4 * h;
                    bool ok = (q0 - 128 + 32 * kt + kin) >= 0;
                    if (kt == 0) ok = ok && (kin > q);
                    if (kt == 4) ok = ok && (kin <= q);
                    const float v = ok ? S[kt][r] * CS : -1.0e30f; S[kt][r] = v; mx = fmaxf(mx, v); }
            mx = fmaxf(mx, __shfl_xor(mx, 32));
            float sum = 0.f;
#pragma unroll
            for (int kt = 0; kt < 5; ++kt)
#pragma unroll
                for (int r = 0; r < 16; ++r) { const float p = __builtin_amdgcn_exp2f(S[kt][r] - mx); S[kt][r] = p; sum += p; }
            sum += __shfl_xor(sum, 32); sum += __builtin_amdgcn_exp2f(snk - mx);
            inv = 1.f / sum;
            O0 = (f32x16){0.f, 0.f, 0.f, 0.f, 0.f, 0.f, 0.f, 0.f, 0.f, 0.f, 0.f, 0.f, 0.f, 0.f, 0.f, 0.f}; O1 = O0;
#pragma unroll
            for (int kt = 0; kt < 5; ++kt)
#pragma unroll
                for (int s = 0; s < 2; ++s) {
                    v4u pw; pw.x = pg8::cvt_pk_bf16(S[kt][8 * s + 0], S[kt][8 * s + 1]); pw.y = pg8::cvt_pk_bf16(S[kt][8 * s + 2], S[kt][8 * s + 3]);
                    pw.z = pg8::cvt_pk_bf16(S[kt][8 * s + 4], S[kt][8 * s + 5]); pw.w = pg8::cvt_pk_bf16(S[kt][8 * s + 6], S[kt][8 * s + 7]);
                    const bf16x8 pf = __builtin_bit_cast(bf16x8, pw);
                    const int kidx = 32 * (sb + kt) + 16 * s + 4 * h;
                    const u32x2 a0l = *(const LAS u32x2*)(Vt + q * SWA_VP + kidx * 2), a0h = *(const LAS u32x2*)(Vt + q * SWA_VP + (kidx + 8) * 2);
                    const u32x2 a1l = *(const LAS u32x2*)(Vt + (q + 32) * SWA_VP + kidx * 2), a1h = *(const LAS u32x2*)(Vt + (q + 32) * SWA_VP + (kidx + 8) * 2);
                    const v4u a0 = {a0l.x, a0l.y, a0h.x, a0h.y}, a1 = {a1l.x, a1l.y, a1h.x, a1h.y};
                    O0 = __builtin_amdgcn_mfma_f32_32x32x16_bf16(__builtin_bit_cast(bf16x8, a0), pf, O0, 0, 0, 0);
                    O1 = __builtin_amdgcn_mfma_f32_32x32x16_bf16(__builtin_bit_cast(bf16x8, a1), pf, O1, 0, 0, 0);
                }
            asm volatile("" : "+v"(O0), "+v"(O1));
            }
#pragma unroll
            for (int g4 = 0; g4 < 4; ++g4) {
                u32x2 o0, o1;
                o0.x = pg8::cvt_pk_bf16(O0[4 * g4 + 0] * inv, O0[4 * g4 + 1] * inv); o0.y = pg8::cvt_pk_bf16(O0[4 * g4 + 2] * inv, O0[4 * g4 + 3] * inv);
                o1.x = pg8::cvt_pk_bf16(O1[4 * g4 + 0] * inv, O1[4 * g4 + 1] * inv); o1.y = pg8::cvt_pk_bf16(O1[4 * g4 + 2] * inv, O1[4 * g4 + 3] * inv);
                *(LAS u32x2*)(Os + q * SWA_OP + (8 * g4 + 4 * h) * 2) = o0;
                *(LAS u32x2*)(Os + q * SWA_OP + (32 + 8 * g4 + 4 * h) * 2) = o1;
            }
            asm volatile("s_waitcnt lgkmcnt(0)" ::: "memory");
            {
#pragma unroll
                for (int i = 0; i < 4; ++i) {
                    const v4u ob = *(const LAS v4u*)(Os + (mq + 8 * i) * SWA_OP + mp8 * 16), oa = oav[i]; const u32x2 ga = gav[i], gb = gbv[i];
                    float sa[8], sb[8]; constexpr float I255 = 1.f / 255.f;
#pragma unroll
                    for (int j = 0; j < 4; ++j) { sa[j] = (float)((ga.x >> (8 * j)) & 0xffu) * I255; sa[4 + j] = (float)((ga.y >> (8 * j)) & 0xffu) * I255;
                                                  sb[j] = (float)((gb.x >> (8 * j)) & 0xffu) * I255; sb[4 + j] = (float)((gb.y >> (8 * j)) & 0xffu) * I255; }
                    v4u o;
                    o.x = pg8::cvt_pk_bf16(sa[0] * bfl(oa.x) + sb[0] * bfl(ob.x), sa[1] * bfh(oa.x) + sb[1] * bfh(ob.x));
                    o.y = pg8::cvt_pk_bf16(sa[2] * bfl(oa.y) + sb[2] * bfl(ob.y), sa[3] * bfh(oa.y) + sb[3] * bfh(ob.y));
                    o.z = pg8::cvt_pk_bf16(sa[4] * bfl(oa.z) + sb[4] * bfl(ob.z), sa[5] * bfh(oa.z) + sb[5] * bfh(ob.z));
                    o.w = pg8::cvt_pk_bf16(sa[6] * bfl(oa.w) + sb[6] * bfl(ob.w), sa[7] * bfh(oa.w) + sb[7] * bfh(ob.w));
                    *(v4u*)(Mg + (mrow + 8 * i) * D + mcol) = o;
                }
            }
            asm volatile("s_waitcnt lgkmcnt(0)" ::: "memory");
        }
    }
}
constexpr int GLA_SC = 256, GLA_NSC = SEQ / GLA_SC, GLA_UNITS = NB * GLA_NSC * 4;
constexpr size_t OUT_ST = 0, OUT_DEC = 32 * MiB, OUT_OA = 64 * MiB;
constexpr int G3_ZT = 0, G3_KRAW = 2048, G3_TOT = G3_KRAW + 32 * 272, G3_BT = G3_TOT + 2048, G3_KTE = G3_BT + 16384, G3_VT = G3_KTE + 128 * 80, G3_DEC = G3_VT + 256 * 80, G3_END = G3_DEC + 512;
static_assert(G3_END <= RING_BYTES, "gla p3 lds");
constexpr int G5_KT = 0, G5_VT = 32 * 272, G5_OS = 32768, G5_ST = 32768, G5_END = G5_ST + 65536;
static_assert(G5_VT + 256 * 80 <= G5_OS && G5_OS + 8 * 32 * 144 <= G5_END && G5_END <= RING_BYTES, "gla p5 lds");

__device__ __forceinline__ unsigned pk_bf16(float lo, float hi) { return pg8::cvt_pk_bf16(lo, hi); }

__device__ __forceinline__ void p3_gla_upd(Frame& F0, bf16* P, const float* w_gk2, const float* b_gk, unsigned char* outb) {
    Frame F = F0; { int t__ = threadIdx.x; asm volatile("" : "+v"(t__)); F.tid = t__; F.lane = t__ & 63; F.wave = __builtin_amdgcn_readfirstlane(t__ >> 6); }
    const int tid = F.tid, lane = F.lane, w = F.wave;
    LAS unsigned char* L = F.lds + RING_OFF;
    LAS float* zt = (LAS float*)(L + G3_ZT); LAS unsigned char* kraw = L + G3_KRAW; LAS float* tot = (LAS float*)(L + G3_TOT); LAS float* bt = (LAS float*)(L + G3_BT);
    LAS unsigned char* kte = L + G3_KTE; LAS unsigned char* vt_ = L + G3_VT; LAS float* decl = (LAS float*)(L + G3_DEC);
    bf16* ST = (bf16*)(outb + OUT_ST); float* DEC = (float*)(outb + OUT_DEC);
    const int gk = tid & 127, gq = tid >> 7;
    const int rt = tid >> 4, rq = tid & 15;
    const int vp = tid & 127;
    const int ktile = w >> 1, vt0 = 4 * (w & 1), vl = lane & 31, hh = lane >> 5;
    constexpr float QS = 0.08838834764831845f;
    for (int unit = blockIdx.x; unit < GLA_UNITS; unit += F.G) {
        const int head = unit & 3, sc = (unit >> 2) & 31, b = unit >> 7;
        const size_t row0 = (size_t)b * SEQ + (size_t)sc * GLA_SC;
        float wreg[16];
#pragma unroll
        for (int r = 0; r < 16; ++r) wreg[r] = w_gk2[r * 512 + head * 128 + gk];
        const float bias = b_gk[head * 128 + gk];
        float carry = 0.f;
        f32x16 acc[4];
#pragma unroll
        for (int i = 0; i < 4; ++i) acc[i] = (f32x16){0.f, 0.f, 0.f, 0.f, 0.f, 0.f, 0.f, 0.f, 0.f, 0.f, 0.f, 0.f, 0.f, 0.f, 0.f, 0.f};
        v4u qraw_n, kr_n; unsigned short z_n; unsigned vraw_n[8];
        { const size_t trow = row0;
          qraw_n = *(const v4u*)(P + (trow + rt) * PWB + PE_QA + head * 128 + 8 * rq); kr_n = *(const v4u*)(P + (trow + rt) * PWB + PE_KA + head * 128 + 8 * rq);
          z_n = P[(trow + rt) * PWB + PE_Z + rq];
#pragma unroll
          for (int c = 0; c < 8; ++c) vraw_n[c] = *(const unsigned*)(P + (trow + 8 * gq + c) * PWB + PE_VA + head * 256 + 2 * vp); }
        for (int st = 0; st < 8; ++st) {
            const size_t trow = row0 + 32 * st;
            bf16* qptr = P + (trow + rt) * PWB + PE_QA + head * 128 + 8 * rq; bf16* kptr = P + (trow + rt) * PWB + PE_KA + head * 128 + 8 * rq;
            const v4u qraw = qraw_n, kr = kr_n;
            const float zval = __uint_as_float(((unsigned)z_n) << 16);
            unsigned vraw[8];
#pragma unroll
            for (int c = 0; c < 8; ++c) vraw[c] = vraw_n[c];
            if (st < 7) { const size_t nrow = trow + 32;
                qraw_n = *(const v4u*)(P + (nrow + rt) * PWB + PE_QA + head * 128 + 8 * rq); kr_n = *(const v4u*)(P + (nrow + rt) * PWB + PE_KA + head * 128 + 8 * rq);
                z_n = P[(nrow + rt) * PWB + PE_Z + rq];
#pragma unroll
                for (int c = 0; c < 8; ++c) vraw_n[c] = *(const unsigned*)(P + (nrow + 8 * gq + c) * PWB + PE_VA + head * 256 + 2 * vp); }
            LDS_BARRIER();
            *(LAS v4u*)(kraw + rt * 272 + rq * 16) = kr;
            zt[rt * 16 + rq] = zval;
            LDS_BARRIER();
            float cs[8]; float cum = 0.f;
#pragma unroll
            for (int c = 0; c < 8; ++c) { float x = bias; const LAS float* zr = zt + (8 * gq + c) * 16;
#pragma unroll
                for (int r = 0; r < 16; ++r) x += zr[r] * wreg[r];
                const float ls = fminf(x, 0.f) - __logf(1.f + __expf(-fabsf(x)));
                cum += ls * 0.0625f; cs[c] = cum; }
            tot[gq * 128 + gk] = cum;
            LDS_BARRIER();
            {
                const float t0 = tot[gk], t1 = tot[128 + gk], t2 = tot[256 + gk], t3 = tot[384 + gk];
                const float prefix = (gq > 0 ? t0 : 0.f) + (gq > 1 ? t1 : 0.f) + (gq > 2 ? t2 : 0.f), ttot = (t0 + t1) + (t2 + t3);
                float kv[8];
#pragma unroll
                for (int c = 0; c < 8; ++c) { const int t = 8 * gq + c; bt[t * 128 + gk] = carry + prefix + cs[c];
                    const float kx = __uint_as_float(((unsigned)*(const LAS unsigned short*)(kraw + t * 272 + gk * 2)) << 16);
                    kv[c] = kx * __expf(ttot - prefix - cs[c]); }
                v4u ko; ko.x = pk_bf16(kv[0], kv[1]); ko.y = pk_bf16(kv[2], kv[3]); ko.z = pk_bf16(kv[4], kv[5]); ko.w = pk_bf16(kv[6], kv[7]);
                *(LAS v4u*)(kte + gk * 80 + gq * 16) = ko;
                if (gq == 0) decl[gk] = __expf(ttot);
                carry += ttot;
                v4u v0, v1;
                v0.x = (vraw[0] & 0xffffu) | (vraw[1] << 16); v0.y = (vraw[2] & 0xffffu) | (vraw[3] << 16); v0.z = (vraw[4] & 0xffffu) | (vraw[5] << 16); v0.w = (vraw[6] & 0xffffu) | (vraw[7] << 16);
                v1.x = (vraw[0] >> 16) | (vraw[1] & 0xffff0000u); v1.y = (vraw[2] >> 16) | (vraw[3] & 0xffff0000u); v1.z = (vraw[4] >> 16) | (vraw[5] & 0xffff0000u); v1.w = (vraw[6] >> 16) | (vraw[7] & 0xffff0000u);
                *(LAS v4u*)(vt_ + (2 * vp) * 80 + gq * 16) = v0;
                *(LAS v4u*)(vt_ + (2 * vp + 1) * 80 + gq * 16) = v1;
            }
            LDS_BARRIER();
            {
#pragma unroll
                for (int g4 = 0; g4 < 4; ++g4) { const f32x4 d4 = *(const LAS f32x4*)(decl + 32 * ktile + 8 * g4 + 4 * hh);
#pragma unroll
                    for (int i = 0; i < 4; ++i) { acc[i][4 * g4 + 0] *= d4.x; acc[i][4 * g4 + 1] *= d4.y; acc[i][4 * g4 + 2] *= d4.z; acc[i][4 * g4 + 3] *= d4.w; } }
#pragma unroll
                for (int s = 0; s < 2; ++s) {
                    const bf16x8 a = *(const LAS bf16x8*)(kte + (32 * ktile + vl) * 80 + (16 * s + 8 * hh) * 2);
#pragma unroll
                    for (int i = 0; i < 4; ++i) { const bf16x8 bb = *(const LAS bf16x8*)(vt_ + (32 * (vt0 + i) + vl) * 80 + (16 * s + 8 * hh) * 2);
                        acc[i] = __builtin_amdgcn_mfma_f32_32x32x16_bf16(a, bb, acc[i], 0, 0, 0); }
                }
                const f32x4 b0 = *(const LAS f32x4*)(bt + rt * 128 + 8 * rq), b1 = *(const LAS f32x4*)(bt + rt * 128 + 8 * rq + 4);
                const float bb8[8] = {b0.x, b0.y, b0.z, b0.w, b1.x, b1.y, b1.z, b1.w};
                const unsigned qw[4] = {qraw.x, qraw.y, qraw.z, qraw.w}, kw[4] = {kr.x, kr.y, kr.z, kr.w};
                unsigned qo[4], ko[4];
#pragma unroll
                for (int e = 0; e < 4; ++e) {
                    qo[e] = pk_bf16(bfl(qw[e]) * QS * __expf(bb8[2 * e]), bfh(qw[e]) * QS * __expf(bb8[2 * e + 1]));
                    ko[e] = pk_bf16(bfl(kw[e]) * __expf(-bb8[2 * e]), bfh(kw[e]) * __expf(-bb8[2 * e + 1])); }
                *(v4u*)qptr = (v4u){qo[0], qo[1], qo[2], qo[3]};
                *(v4u*)kptr = (v4u){ko[0], ko[1], ko[2], ko[3]};
            }
        }
        bf16* stu = ST + (size_t)unit * 32768;
#pragma unroll
        for (int i = 0; i < 4; ++i)
#pragma unroll
            for (int g4 = 0; g4 < 4; ++g4) {
                const int kk = 2 * ktile + (g4 >> 1), fh = g4 & 1;
                u32x2 o; o.x = pk_bf16(acc[i][4 * g4 + 0], acc[i][4 * g4 + 1]); o.y = pk_bf16(acc[i][4 * g4 + 2], acc[i][4 * g4 + 3]);
                *(u32x2*)(stu + ((((vt0 + i) * 8 + kk) * 64 + fh * 32 + vl) * 8 + 4 * hh)) = o;
            }
        if (gq == 0) DEC[unit * 128 + gk] = __expf(carry);
    }
}

__device__ __forceinline__ void p4_gla_scan(Frame& F0, unsigned char* outb) {
    Frame F = F0; { int t__ = threadIdx.x; asm volatile("" : "+v"(t__)); F.tid = t__; F.lane = t__ & 63; F.wave = __builtin_amdgcn_readfirstlane(t__ >> 6); }
    bf16* ST = (bf16*)(outb + OUT_ST); const float* DEC = (const float*)(outb + OUT_DEC);
    for (int gt = blockIdx.x * (NWAVES * 64) + F.tid; gt < 16 * 8192; gt += F.G * NWAVES * 64) {
        const int pair = gt >> 13, e4 = gt & 8191, b = pair >> 2, head = pair & 3;
        const int Ln = (e4 >> 1) & 63, kk = (e4 >> 7) & 7, k0 = 16 * kk + 8 * (Ln >> 5) + 4 * (e4 & 1);
        const size_t ub0 = (size_t)(b * 32 * 4 + head);
        float s0 = 0.f, s1 = 0.f, s2 = 0.f, s3 = 0.f;
        u32x2 uq[4]; f32x4 dq[4];
#pragma unroll
        for (int i = 0; i < 4; ++i) { uq[i] = *(const u32x2*)(ST + (ub0 + 4 * i) * 32768 + 4 * e4); dq[i] = *(const f32x4*)(DEC + (ub0 + 4 * i) * 128 + k0); }
        for (int sc = 0; sc < GLA_NSC; sc += 4) {
#pragma unroll
            for (int i = 0; i < 4; ++i) {
                const size_t ub = ub0 + 4 * (sc + i);
                const u32x2 u = uq[i]; const f32x4 d = dq[i];
                if (sc + 4 < GLA_NSC) { uq[i] = *(const u32x2*)(ST + (ub + 16) * 32768 + 4 * e4); dq[i] = *(const f32x4*)(DEC + (ub + 16) * 128 + k0); }
                u32x2 o; o.x = pk_bf16(s0, s1); o.y = pk_bf16(s2, s3);
                *(u32x2*)(ST + ub * 32768 + 4 * e4) = o;
                s0 = d.x * s0 + bfl(u.x); s1 = d.y * s1 + bfh(u.x); s2 = d.z * s2 + bfl(u.y); s3 = d.w * s3 + bfh(u.y);
            }
        }
    }
}

__device__ __forceinline__ void p5_gla_out(Frame& F0, const bf16* P, const float* gng, unsigned char* outb) {
    Frame F = F0; { int t__ = threadIdx.x; asm volatile("" : "+v"(t__)); F.tid = t__; F.lane = t__ & 63; F.wave = __builtin_amdgcn_readfirstlane(t__ >> 6); }
    const int tid = F.tid, lane = F.lane, w = F.wave, vl = lane & 31, hh = lane >> 5;
    LAS unsigned char* L = F.lds + RING_OFF;
    LAS unsigned char* Kt = L + G5_KT; LAS unsigned char* Vt = L + G5_VT; LAS unsigned char* Os = L + G5_OS + w * (32 * 144);
    const bf16* ST = (const bf16*)(outb + OUT_ST); bf16* OA = (bf16*)(outb + OUT_OA);
    const int rt = tid >> 4, rq = tid & 15, vp = tid & 127, gq = tid >> 7;
    for (int unit = blockIdx.x; unit < GLA_UNITS; unit += F.G) {
        const int head = unit & 3, sc = (unit >> 2) & 31, b = unit >> 7;
        const size_t row0 = (size_t)b * SEQ + (size_t)sc * GLA_SC;
        bf16x8 qf[8];
        { const bf16* qp = P + (row0 + 32 * w + vl) * PWB + PE_QA + head * 128 + 8 * hh;
#pragma unroll
          for (int kk = 0; kk < 8; ++kk) qf[kk] = *(const bf16x8*)(qp + 16 * kk); }
        f32x16 acc[8];
        { const v4u* stg = (const v4u*)(ST + (size_t)unit * 32768) + tid; v4u sv[8];
#pragma unroll
          for (int i = 0; i < 8; ++i) sv[i] = stg[i * 512];
          LDS_BARRIER();
#pragma unroll
          for (int i = 0; i < 8; ++i) *(LAS v4u*)(L + G5_ST + (tid + i * 512) * 16) = sv[i];
          LDS_BARRIER();
#pragma unroll
          for (int vt = 0; vt < 8; ++vt) { f32x16 a16 = {0.f, 0.f, 0.f, 0.f, 0.f, 0.f, 0.f, 0.f, 0.f, 0.f, 0.f, 0.f, 0.f, 0.f, 0.f, 0.f};
#pragma unroll
              for (int kk = 0; kk < 8; ++kk) { const bf16x8 a = *(const LAS bf16x8*)(L + G5_ST + ((vt * 8 + kk) * 64 + lane) * 16); a16 = __builtin_amdgcn_mfma_f32_32x32x16_bf16(a, qf[kk], a16, 0, 0, 0); }
              acc[vt] = a16; } }
        v4u kr_n; unsigned vraw_n[8];
        { kr_n = *(const v4u*)(P + (row0 + rt) * PWB + PE_KA + head * 128 + 8 * rq);
#pragma unroll
          for (int c = 0; c < 8; ++c) vraw_n[c] = *(const unsigned*)(P + (row0 + 8 * gq + c) * PWB + PE_VA + head * 256 + 2 * vp); }
        for (int jt = 0; jt < 8; ++jt) {
            const v4u kr = kr_n; unsigned vraw[8];
#pragma unroll
            for (int c = 0; c < 8; ++c) vraw[c] = vraw_n[c];
            if (jt < 7) { const size_t nrow = row0 + 32 * (jt + 1);
                kr_n = *(const v4u*)(P + (nrow + rt) * PWB + PE_KA + head * 128 + 8 * rq);
#pragma unroll
                for (int c = 0; c < 8; ++c) vraw_n[c] = *(const unsigned*)(P + (nrow + 8 * gq + c) * PWB + PE_VA + head * 256 + 2 * vp); }
            LDS_BARRIER();
            *(LAS v4u*)(Kt + rt * 272 + rq * 16) = kr;
            { v4u v0, v1;
              v0.x = (vraw[0] & 0xffffu) | (vraw[1] << 16); v0.y = (vraw[2] & 0xffffu) | (vraw[3] << 16); v0.z = (vraw[4] & 0xffffu) | (vraw[5] << 16); v0.w = (vraw[6] & 0xffffu) | (vraw[7] << 16);
              v1.x = (vraw[0] >> 16) | (vraw[1] & 0xffff0000u); v1.y = (vraw[2] >> 16) | (vraw[3] & 0xffff0000u); v1.z = (vraw[4] >> 16) | (vraw[5] & 0xffff0000u); v1.w = (vraw[6] >> 16) | (vraw[7] & 0xffff0000u);
              *(LAS v4u*)(Vt + (2 * vp) * 80 + gq * 16) = v0; *(LAS v4u*)(Vt + (2 * vp + 1) * 80 + gq * 16) = v1; }
            LDS_BARRIER();
            if (w >= jt) {
                f32x16 X = {0.f, 0.f, 0.f, 0.f, 0.f, 0.f, 0.f, 0.f, 0.f, 0.f, 0.f, 0.f, 0.f, 0.f, 0.f, 0.f};
#pragma unroll
                for (int kk = 0; kk < 8; ++kk) { const bf16x8 a = *(const LAS bf16x8*)(Kt + vl * 272 + (16 * kk + 8 * hh) * 2); X = __builtin_amdgcn_mfma_f32_32x32x16_bf16(a, qf[kk], X, 0, 0, 0); }
                if (w == jt) {
#pragma unroll
                    for (int r = 0; r < 16; ++r) { const int j = (r & 3) + 8 * (r >> 2) + 4 * hh; X[r] = (j <= vl) ? X[r] : 0.f; }
                }
                bf16x8 pf[2];
#pragma unroll
                for (int s = 0; s < 2; ++s) { v4u pw; pw.x = pk_bf16(X[8 * s + 0], X[8 * s + 1]); pw.y = pk_bf16(X[8 * s + 2], X[8 * s + 3]); pw.z = pk_bf16(X[8 * s + 4], X[8 * s + 5]); pw.w = pk_bf16(X[8 * s + 6], X[8 * s + 7]);
                    pf[s] = __builtin_bit_cast(bf16x8, pw); }
#pragma unroll
                for (int vt = 0; vt < 8; ++vt)
#pragma unroll
                    for (int s = 0; s < 2; ++s) {
                        const u32x2 lo = *(const LAS u32x2*)(Vt + (32 * vt + vl) * 80 + (16 * s + 4 * hh) * 2), hi = *(const LAS u32x2*)(Vt + (32 * vt + vl) * 80 + (16 * s + 8 + 4 * hh) * 2);
                        const v4u av = {lo.x, lo.y, hi.x, hi.y};
                        acc[vt] = __builtin_amdgcn_mfma_f32_32x32x16_bf16(__builtin_bit_cast(bf16x8, av), pf[s], acc[vt], 0, 0, 0);
                    }
            }
        }
        float ssq = 0.f;
#pragma unroll
        for (int vt = 0; vt < 8; ++vt)
#pragma unroll
            for (int r = 0; r < 16; ++r) ssq += acc[vt][r] * acc[vt][r];
        ssq += __shfl_xor(ssq, 32);
        const float rstd = rsqrtf(ssq * (1.f / 256.f) + EPS);
        const int mq = lane >> 3, mp8 = lane & 7; const size_t orow = row0 + 32 * w + mq;
        u32x2 rv_n[4];
#pragma unroll
        for (int i = 0; i < 4; ++i) rv_n[i] = *(const u32x2*)((const unsigned char*)(P + (orow + 8 * i) * PWB) + head * 256 + 8 * mp8);
#pragma unroll
        for (int c = 0; c < 4; ++c) {
            u32x2 rvc[4];
#pragma unroll
            for (int i = 0; i < 4; ++i) rvc[i] = rv_n[i];
            if (c < 3) {
#pragma unroll
                for (int i = 0; i < 4; ++i) rv_n[i] = *(const u32x2*)((const unsigned char*)(P + (orow + 8 * i) * PWB) + head * 256 + 64 * (c + 1) + 8 * mp8); }
#pragma unroll
            for (int tl = 0; tl < 2; ++tl)
#pragma unroll
                for (int g4 = 0; g4 < 4; ++g4) { u32x2 o; const f32x16& A = acc[2 * c + tl];
                    o.x = pk_bf16(A[4 * g4 + 0] * rstd, A[4 * g4 + 1] * rstd); o.y = pk_bf16(A[4 * g4 + 2] * rstd, A[4 * g4 + 3] * rstd);
                    *(LAS u32x2*)(Os + vl * 144 + (32 * tl + 8 * g4 + 4 * hh) * 2) = o; }
            asm volatile("s_waitcnt lgkmcnt(0)" ::: "memory");
            const int col = head * 256 + 64 * c + 8 * mp8;
            const f32x4 g0 = *(const f32x4*)(gng + 64 * c + 8 * mp8), g1 = *(const f32x4*)(gng + 64 * c + 8 * mp8 + 4);
#pragma unroll
            for (int i = 0; i < 4; ++i) {
                const v4u ob = *(const LAS v4u*)(Os + (mq + 8 * i) * 144 + mp8 * 16); const u32x2 rv = rvc[i];
                float rr[8];
#pragma unroll
                for (int j = 0; j < 4; ++j) { rr[j] = ((float)((rv.x >> (8 * j)) & 0xffu) - 128.f) * 0.05f; rr[4 + j] = ((float)((rv.y >> (8 * j)) & 0xffu) - 128.f) * 0.05f; }
                v4u o;
                o.x = pk_bf16(bfl(ob.x) * g0.x * rr[0] * fast_sigmoid(rr[0]), bfh(ob.x) * g0.y * rr[1] * fast_sigmoid(rr[1]));
                o.y = pk_bf16(bfl(ob.y) * g0.z * rr[2] * fast_sigmoid(rr[2]), bfh(ob.y) * g0.w * rr[3] * fast_sigmoid(rr[3]));
                o.z = pk_bf16(bfl(ob.z) * g1.x * rr[4] * fast_sigmoid(rr[4]), bfh(ob.z) * g1.y * rr[5] * fast_sigmoid(rr[5]));
                o.w = pk_bf16(bfl(ob.w) * g1.z * rr[6] * fast_sigmoid(rr[6]), bfh(ob.w) * g1.w * rr[7] * fast_sigmoid(rr[7]));
                *(v4u*)(OA + (orow + 8 * i) * D + col) = o;
            }
            asm volatile("s_waitcnt lgkmcnt(0)" ::: "memory");
        }
    }
}
__device__ __forceinline__ void p0_mod_item(Frame& F0, const float* c, const float* w_ada, const float* b_ada, float* mod, int item) {
    Frame F = F0; { int t__ = threadIdx.x; asm volatile("" : "+v"(t__)); F.tid = t__; F.lane = t__ & 63; F.wave = __builtin_amdgcn_readfirstlane(t__ >> 6); }
    LAS float* sc = (LAS float*)(F.lds + RING_OFF);
    LAS float* red = (LAS float*)(F.lds + RING_OFF + 16384);
    for (int i = F.tid; i < NB * D; i += NWAVES * 64) { const float v = c[i]; sc[i] = v * __builtin_amdgcn_rcpf(1.f + __expf(-v)); }
    __syncthreads();
    const int cl = F.lane & 31, rh = F.lane >> 5, col = item * 32 + cl;
    float acc[NB] = {0.f, 0.f, 0.f, 0.f};
    const float* wp = w_ada + (size_t)(F.wave * 128 + rh) * NMOD + col;
#pragma unroll 32
    for (int i = 0; i < 64; ++i) { const float w = wp[(size_t)(2 * i) * NMOD];
#pragma unroll
        for (int b = 0; b < NB; ++b) acc[b] += sc[b * D + F.wave * 128 + 2 * i + rh] * w; }
#pragma unroll
    for (int b = 0; b < NB; ++b) { acc[b] += __shfl_xor(acc[b], 32); if (rh == 0) red[(F.wave * NB + b) * 32 + cl] = acc[b]; }
    __syncthreads();
    if (F.tid < 128) { const int b = F.tid >> 5, cc = F.tid & 31; float s = b_ada[item * 32 + cc];
#pragma unroll
        for (int w = 0; w < 8; ++w) s += red[(w * NB + b) * 32 + cc];
        mod[b * NMOD + item * 32 + cc] = s; }
    __syncthreads();
}
template <bool F8 = false>
__device__ __forceinline__ void tr_item(const float* W, int N, int k0, int n0, int nvalid, bf16* WT, size_t drow0, int dpitch, int dcol0, LAS float* scr, int lane, float wscale = 1.f) {
    const int nn = lane & 31;
    float tmp[32];
#pragma unroll
    for (int i = 0; i < 32; ++i) { const int kk = 2 * i + (lane >> 5); tmp[i] = (nn < nvalid) ? W[(size_t)(k0 + kk) * N + n0 + nn] : 0.f; }
#pragma unroll
    for (int i = 0; i < 32; ++i) { const int kk = 2 * i + (lane >> 5); scr[kk * 33 + nn] = tmp[i]; }
    LDS_WAIT(); asm volatile("" ::: "memory");
    const int c = lane & 7;
#pragma unroll
    for (int j = 0; j < 4; ++j) { const int n = (lane >> 3) + 8 * j; const LAS float* s = scr + (8 * c) * 33 + n;
        v4u o; o.x = pg8::cvt_pk_bf16(s[0 * 33], s[1 * 33]); o.y = pg8::cvt_pk_bf16(s[2 * 33], s[3 * 33]); o.z = pg8::cvt_pk_bf16(s[4 * 33], s[5 * 33]); o.w = pg8::cvt_pk_bf16(s[6 * 33], s[7 * 33]);
        if constexpr (F8) {
            int w0 = __builtin_amdgcn_cvt_pk_fp8_f32(s[0 * 33] * wscale, s[1 * 33] * wscale, 0, false); w0 = __builtin_amdgcn_cvt_pk_fp8_f32(s[2 * 33] * wscale, s[3 * 33] * wscale, w0, true);
            int w1 = __builtin_amdgcn_cvt_pk_fp8_f32(s[4 * 33] * wscale, s[5 * 33] * wscale, 0, false); w1 = __builtin_amdgcn_cvt_pk_fp8_f32(s[6 * 33] * wscale, s[7 * 33] * wscale, w1, true);
            if (n < nvalid) *(GAS u32x2*)((unsigned char*)WT + (drow0 + n) * (size_t)dpitch + dcol0 + k0 + 8 * c) = (u32x2){(unsigned)w0, (unsigned)w1};
        } else {
        if (n < nvalid) *(GAS v4u*)(WT + (drow0 + n) * (size_t)dpitch + dcol0 + k0 + 8 * c) = o; } }
    LDS_WAIT(); asm volatile("" ::: "memory");
}
__device__ __forceinline__ void p0_convert(Frame& F0, const Args& args, int part) {
    Frame F = F0; { int t__ = threadIdx.x; asm volatile("" : "+v"(t__)); F.tid = t__; F.lane = t__ & 63; F.wave = __builtin_amdgcn_readfirstlane(t__ >> 6); }
    unsigned char* ws = args.ws;
    bf16* WIN = (bf16*)(ws + WS_WIN); bf16* WO = (bf16*)(ws + WS_WO); bf16* WGU = (bf16*)(ws + WS_WGU); bf16* WD = (bf16*)(ws + WS_WD);
    const float* w_in = args.in[5]; const float* w_o = args.in[10]; const float* w_gate = args.in[16]; const float* w_up = args.in[17]; const float* w_down = args.in[18];
    LAS float* scr = (LAS float*)(F.lds + RING_OFF + 32768 + F.wave * 8704);
    const int gw = F.vcu * NWAVES + F.wave, NGW = F.G * NWAVES;
    constexpr int I0 = 16 * 201, I3 = 16 * 32, I4 = 16 * 128, I5 = 16 * 128, I6 = 16 * 128;
    constexpr int NITEMS = I0 + I3 + I4 + I5 + I6;
    bf16* WIN8 = (bf16*)(ws + WS_WIN8);
    const int it0 = part == 0 ? 0 : I0 + I3, it1 = part == 0 ? I0 + I3 : NITEMS;
    for (int it = it0 + gw; it < it1; it += NGW) {
        int r = it;
        if (r < I0) {
            const int kb = r / 201, cb = r % 201; int src, dst, nv = 32;
            if (cb < 16) { src = 32 * cb; dst = PC_QA + 32 * cb; }
            else if (cb < 32) { src = 512 + 32 * (cb - 16); dst = PC_KA + 32 * (cb - 16); }
            else if (cb < 64) { src = 1024 + 32 * (cb - 32); dst = PC_VA + 32 * (cb - 32); }
            else if (cb < 96) { src = 2048 + 32 * (cb - 64); dst = PC_RA + 32 * (cb - 64); }
            else if (cb < 97) { src = 3072; dst = PC_Z; nv = 16; }
            else if (cb < 129) { src = 3088 + 32 * (cb - 97); dst = PC_QB + 32 * (cb - 97); }
            else if (cb < 133) { src = 4112 + 32 * (cb - 129); dst = PC_KB + 32 * (cb - 129); }
            else if (cb < 137) { src = 4240 + 32 * (cb - 133); dst = PC_VB + 32 * (cb - 133); }
            else if (cb < 169) { src = 4368 + 32 * (cb - 137); dst = PC_GA + 32 * (cb - 137); }
            else { src = 5392 + 32 * (cb - 169); dst = PC_GB + 32 * (cb - 169); }
            if (dst < NF8 * 256) tr_item<true>(w_in, IN_TOTAL, 64 * kb, src, nv, WIN8, dst, D, 0, scr, F.lane, 32.f);
            else tr_item(w_in, IN_TOTAL, 64 * kb, src, nv, WIN, dst, D, 0, scr, F.lane);
            continue; } r -= I0;
        if (r < I3) { const int kb = r / 32, nb = r % 32; tr_item(w_o, D, 64 * kb, 32 * nb, 32, WO, 32 * nb, D, 0, scr, F.lane); continue; } r -= I3;
        if (r < I4 + I5) { const bool up = r >= I4; if (up) r -= I4; const int e = r / 128, q = r % 128, kb = q / 8, nb = q % 8, n0 = 32 * nb;
            tr_item<true>((up ? w_up : w_gate) + (size_t)e * D * 256, 256, 64 * kb, n0, 32, WGU, (size_t)e * 512 + (n0 >> 7) * 256 + (up ? 128 : 0) + (n0 & 127), D, 0, scr, F.lane, 32.f); continue; } r -= I4 + I5;
        { const int e = r / 128, q = r % 128, kb = q / 32, nb = q % 32;
            tr_item<true>(w_down + (size_t)e * 256 * D, D, 64 * kb, 32 * nb, 32, WD, (size_t)(e >> 2) * D + 32 * nb, D, (e & 3) * 256, scr, F.lane, 16.f); }
    }
    if (part == 0) { GAS v4u* z = (GAS v4u*)(WIN + (size_t)IN_TOTAL * D); const int n16 = (PW - IN_TOTAL) * D * 2 / 16; const v4u zero = {0u, 0u, 0u, 0u};
      for (int i = gw * 64 + F.lane; i < n16; i += NGW * 64) z[i] = zero; }
}
__device__ __forceinline__ void p1_h1(Frame& F0, const float* x, const float* g1, const float* mod, bf16* H1) {
    Frame F = F0; { int t__ = threadIdx.x; asm volatile("" : "+v"(t__)); F.tid = t__; F.lane = t__ & 63; F.wave = __builtin_amdgcn_readfirstlane(t__ >> 6); }
    const int gw = F.vcu * NWAVES + F.wave, NGW = F.G * NWAVES, c0 = F.lane * 8;
    f32x4 scl[4], sft[4]; int curb = -1;
    f32x4 nx[4];
    const int NIT = T / NGW;
    {
#pragma unroll
        for (int j = 0; j < 2; ++j) { nx[2 * j] = *(const GAS f32x4*)(x + (size_t)(NIT * gw) * D + c0 + 512 * j); nx[2 * j + 1] = *(const GAS f32x4*)(x + (size_t)(NIT * gw) * D + c0 + 512 * j + 4); } }
    for (int k = 0; k < NIT; ++k) {
        const int m = NIT * gw + k, mn = m + 1;
        const int b = m / SEQ;
        if (b != curb) { curb = b; const float* sh = mod + b * NMOD; const float* sc = sh + D;
#pragma unroll
            for (int q = 0; q < 4; ++q) { const int cc = c0 + 512 * (q >> 1) + 4 * (q & 1); scl[q] = *(const f32x4*)(g1 + cc) * (*(const f32x4*)(sc + cc) + 1.f); sft[q] = *(const f32x4*)(sh + cc); } }
        f32x4 v[4]; float s = 0.f;
#pragma unroll
        for (int q = 0; q < 4; ++q) v[q] = nx[q];
        if (k + 1 < NIT) {
#pragma unroll
            for (int j = 0; j < 2; ++j) { nx[2 * j] = *(const GAS f32x4*)(x + (size_t)mn * D + c0 + 512 * j); nx[2 * j + 1] = *(const GAS f32x4*)(x + (size_t)mn * D + c0 + 512 * j + 4); } }
#pragma unroll
        for (int q = 0; q < 4; ++q) s += (v[q].x * v[q].x + v[q].y * v[q].y) + (v[q].z * v[q].z + v[q].w * v[q].w);
#pragma unroll
        for (int o = 1; o < 64; o <<= 1) s += __shfl_xor(s, o);
        const float rstd = rsqrtf(s * (1.f / D) + EPS);
#pragma unroll
        for (int j = 0; j < 2; ++j) { const f32x4 y0 = v[2 * j] * rstd * scl[2 * j] + sft[2 * j], y1 = v[2 * j + 1] * rstd * scl[2 * j + 1] + sft[2 * j + 1];
            *(GAS v4u*)(H1 + (size_t)m * D + c0 + 512 * j) = (v4u){pg8::cvt_pk_bf16(y0.x, y0.y), pg8::cvt_pk_bf16(y0.z, y0.w), pg8::cvt_pk_bf16(y1.x, y1.y), pg8::cvt_pk_bf16(y1.z, y1.w)};
            if constexpr (NF8 > 0) { int q0 = __builtin_amdgcn_cvt_pk_fp8_f32(y0.x, y0.y, 0, false); q0 = __builtin_amdgcn_cvt_pk_fp8_f32(y0.z, y0.w, q0, true);
                int q1 = __builtin_amdgcn_cvt_pk_fp8_f32(y1.x, y1.y, 0, false); q1 = __builtin_amdgcn_cvt_pk_fp8_f32(y1.z, y1.w, q1, true);
                *(GAS u32x2*)((unsigned char*)H1 + 64 * MiB + (size_t)m * D + c0 + 512 * j) = (u32x2){(unsigned)q0, (unsigned)q1}; } }
    }
}

__global__ void __launch_bounds__(NWAVES * 64, 2) skel_fwd(Args args) {
    extern __shared__ __attribute__((aligned(16))) unsigned char lds[];
    Frame F;
    F.lds = (LAS unsigned char*)lds;
    F.MISC = (volatile LAS unsigned*)(F.lds + MISC_OFF);
    F.tid = threadIdx.x; F.lane = F.tid & 63; F.wave = __builtin_amdgcn_readfirstlane(F.tid >> 6);
    F.G = gridDim.x; { const int bx = blockIdx.x; F.vcu = (F.G % 8 == 0) ? (bx % 8) * (F.G / 8) + bx / 8 : bx; }
    unsigned char* ws = args.ws;
    F.ctl = (gu32*)(ws + WS_CTL);
    for (int u = F.tid; u < (LDS_BYTES - LDSCTL_OFF) / 4; u += NWAVES * 64) ((LAS unsigned*)(F.lds + LDSCTL_OFF))[u] = 0u;
    __syncthreads();
    XcdBarrier bar = xcd_barrier_post((unsigned*)(F.ctl + CW_BAR) + args.li * XCD_BAR_WORDS, F.MISC + 8);
    const int lo = args.ph_lo, hi = args.ph_hi;
#define IN(k) (lo <= (k) && (k) < hi)
#define BOTH(k) (IN(k) && IN((k) + 1))
#define GRID_BAR() xcd_barrier(bar)
#if defined(PROBE_LO)
    volatile LAS unsigned long long* tsl = (volatile LAS unsigned long long*)(F.lds + LDSCTL_OFF + 64);
#define STAMP(k) do { if (blockIdx.x == 0 && F.tid == 0) tsl[k] = rt(); } while (0)
#else
#define STAMP(k) do { } while (0)
#endif
#define REFRESH() do { int t__ = threadIdx.x; asm volatile("" : "+v"(t__)); F.tid = t__; F.lane = t__ & 63; F.wave = __builtin_amdgcn_readfirstlane(t__ >> 6); } while (0)
    float* mod = (float*)(ws + WS_MOD);
    bf16* P = (bf16*)(ws + WS_P);
    bf16* H1 = (bf16*)args.out;

    STAMP(0); if (IN(0)) {
        if (blockIdx.x < NMOD / 32) p0_mod_item(F, args.in[1], args.in[2], args.in[3], mod, blockIdx.x);
        p0_convert(F, args, 0);
        {
            GAS v4u* xz = (GAS v4u*)(ws + WS_XBUF); const v4u zero = {0u, 0u, 0u, 0u};
            for (int i = blockIdx.x * (NWAVES * 64) + F.tid; i < (int)(XBUF_BYTES / 16); i += F.G * NWAVES * 64) xz[i] = zero; }
        if (BOTH(0)) GRID_BAR();
    }
    STAMP(1); if (IN(1)) {
        p1_h1(F, args.in[0], args.in[4], mod, H1);
        if (BOTH(1)) GRID_BAR();
    }
    STAMP(2); if (IN(2)) {
        if constexpr (NF8 > 0) {
            pg8::Gemm g{(const unsigned char*)H1 + 64 * MiB, ws + WS_WIN8, D / 128, D, D, 0x7f7f7f7f, 0x7a7a7a7a}; pg8::StaticOrder S; S.init(T, NF8 * 256, F.G, (int)blockIdx.x);
            static_assert(NF8 == 0 || (NF8 == 12 && PC_RA == 0 && PC_GA == 1024 && PC_GB == 2048), "the byte-coded gate epilogue assumes the gate tiles come first");
            pg8::EpiGate E{P, PWB};
            pg8::gemm_phase<pg8::EpiGate, pg8::StaticOrder, false, true, true>(F.lds + RING_OFF, g, S, E);
        }
        {
            pg8::Gemm g{H1, ws + WS_WIN + (size_t)NF8 * 256 * D * 2, D / 64, D * 2, D * 2, 0, 0}; pg8::StaticOrder S; S.init(T, PW - NF8 * 256, F.G, (int)blockIdx.x);
            pg8::EpiBf16 E{P + NF8 * 256 - PBOFF, PWB};
            pg8::gemm_phase<pg8::EpiBf16, pg8::StaticOrder, false, true>(F.lds + RING_OFF, g, S, E);
        }
        if (BOTH(2)) GRID_BAR();
    }
    STAMP(3); if (IN(3)) { p3_gla_upd(F, P, args.in[6], args.in[7], (unsigned char*)args.out); if (BOTH(3)) GRID_BAR(); }
    STAMP(4); if (IN(4)) { p4_gla_scan(F, (unsigned char*)args.out); if (BOTH(4)) GRID_BAR(); }
    STAMP(5); if (IN(5)) { p5_gla_out(F, P, args.in[8], (unsigned char*)args.out); if (BOTH(5)) GRID_BAR(); }
    STAMP(6); if (IN(6)) {
        p6_swa_merge(F, P, (bf16*)(ws + WS_M), (const bf16*)((const unsigned char*)args.out + 64 * MiB), args.in[9]);
        if (BOTH(6)) GRID_BAR();
    }
    STAMP(7); if (IN(7)) {
        pg8::Gemm g{ws + WS_M, ws + WS_WO, D / 64, D * 2, D * 2, 0, 0}; pg8::StaticOrder S; S.init(T, D, F.G, (int)blockIdx.x);
        pg8::EpiX1 E{args.in[0], mod + 2 * D, (bf16*)args.out};
        pg8::gemm_phase<pg8::EpiX1, pg8::StaticOrder, false, true>(F.lds + RING_OFF, g, S, E);
        if (BOTH(7)) GRID_BAR();
    }
    STAMP(8); if (IN(8)) {
        p8_h2_route(F, args, mod, (unsigned char*)P);
        if (BOTH(8)) GRID_BAR();
    }
    STAMP(9); if (IN(9)) {
        p9_sort(F, args);
        p0_convert(F, args, 1);
        if (BOTH(9)) GRID_BAR();
    }
    const int* seg = (const int*)(ws + WS_SORT + SORT_SEG); const int* rowlist = (const int*)(ws + WS_SORT + SORT_ROWLIST); const int* tileb = (const int*)(ws + WS_SORT + SORT_TILEB);
    unsigned char* HID = (unsigned char*)P + 64 * MiB;
    STAMP(10); if (IN(10)) {
        const int ntile = __builtin_amdgcn_readfirstlane(seg[32]);
        PairOrder10 S; S.so.init(ntile * 256, 1024, F.G, (int)blockIdx.x); S.rl = rowlist; S.tileb = tileb;
        pg8::Gemm g{P, ws + WS_WGU, D / 128, D, D, 0x7f7f7f7f, 0x7a7a7a7a};
        EpiHid E{HID, (const float*)(ws + WS_SORT + SORT_CW)};
        pg8::gemm_phase<EpiHid, PairOrder10, true, true, true>(F.lds + RING_OFF, g, S, E);
        if (BOTH(10)) GRID_BAR();
    }
    STAMP(11); if (IN(11)) {
        const int ntile = __builtin_amdgcn_readfirstlane(seg[32]);
        PairOrder11 S; S.tileb = tileb; S.nunits = ntile * 4; S.G = F.G; S.c = F.vcu;
        pg8::Gemm g{HID, ws + WS_WD, 4, 512, D, 0x7b7b7b7b, 0x7b7b7b7b};
        EpiFinal E{rowlist, mod + 5 * D, (const bf16*)args.out, args.out, args.in[19], (unsigned long long*)(ws + WS_XBUF), F.lds + 140288};
        pg8::gemm_phase<EpiFinal, PairOrder11, false, true, true, true>(F.lds + RING_OFF, g, S, E);
    }
    STAMP(12);
    STAMP(13);
#if defined(PROBE_LO)
    if (blockIdx.x == 0 && F.tid == 0) { const unsigned long long dt = (tsl[PROBE_HI] - tsl[PROBE_LO]) * PROBE_MULT, t0 = rt(); while (rt() - t0 < dt) __builtin_amdgcn_s_sleep(8); }
#endif
#undef IN
#undef BOTH
#undef GRID_BAR
#undef STAMP
#undef REFRESH
}

extern "C" void kernel_launch(void* const* d_in, const int* in_sizes, int n_in, void* d_out, int out_size, void* d_ws, size_t ws_size, hipStream_t stream) {
    static int grid = 0;
    if (grid == 0) {
        int dev = 0, cus = 0, per_cu = 0;
        if (hipGetDevice(&dev) != hipSuccess || hipDeviceGetAttribute(&cus, hipDeviceAttributeMultiprocessorCount, dev) != hipSuccess) { grid = -1; return; }
        if (hipFuncSetAttribute((const void*)skel_fwd, hipFuncAttributeMaxDynamicSharedMemorySize, LDS_BYTES) != hipSuccess) { grid = -1; return; }
        if (hipOccupancyMaxActiveBlocksPerMultiprocessor(&per_cu, (const void*)skel_fwd, NWAVES * 64, LDS_BYTES) != hipSuccess || per_cu < 1) per_cu = 1;
        (void)hipGetLastError();
        grid = cus;
        if (ws_size < WS_END) { fprintf(stderr, "kernel_launch: workspace too small (%zu < %zu)\n", ws_size, (size_t)WS_END); grid = -1; return; }
    }
    if (grid < 0) return;
    unsigned char* ws = (unsigned char*)d_ws; float* out = (float*)d_out;
    (void)hipMemsetAsync((char*)d_ws + WS_CTL, 0, CTL_ZERO_BYTES, stream);
    Args a{};
    for (int i = 0; i < 20; ++i) a.in[i] = (const float*)d_in[i];
    a.out = out; a.ws = ws;
    a.ph_lo = 0; a.ph_hi = 12; a.li = 0;
    hipLaunchKernelGGL(skel_fwd, dim3(grid), dim3(NWAVES * 64), LDS_BYTES, stream, a);
}
```

```cpp
#include <hip/hip_runtime.h>
#include <stdint.h>
#include <cstdio>

constexpr int D = 1024, NB = 4, SEQ = 8192, T = NB * SEQ;
constexpr int NMOD = 6 * D;
constexpr int IN_TOTAL = 6416;
constexpr int PW = 6656;
constexpr int PC_RA = 0, PC_GA = 1024, PC_GB = 2048, PC_KA = 3072, PC_VA = 3584, PC_KB = 4608, PC_VB = 4736, PC_QA = 4864, PC_QB = 5376, PC_Z = 6400;
constexpr int PWB = 5120, PBOFF = 1536;
constexpr int PE_KA = PC_KA - PBOFF, PE_VA = PC_VA - PBOFF, PE_KB = PC_KB - PBOFF, PE_VB = PC_VB - PBOFF, PE_QA = PC_QA - PBOFF, PE_QB = PC_QB - PBOFF, PE_Z = PC_Z - PBOFF;
#ifndef NF8_TILES
#define NF8_TILES 12
#endif
constexpr int NF8 = NF8_TILES;
constexpr float EPS = 1e-6f;
constexpr int PROWS = T + 1024;

constexpr size_t MiB = 1u << 20;
constexpr size_t WS_CTL = 0, CTL_ZERO_BYTES = 65536;
constexpr size_t WS_MOD = 1 * MiB;
constexpr size_t WS_ROUTE = 2 * MiB;
constexpr size_t WS_SORT = 3 * MiB;
constexpr size_t WS_WIN = 8 * MiB, WS_WO = 21 * MiB, WS_WGU = 23 * MiB, WS_WIN8 = 31 * MiB, WS_WD = 39 * MiB;
constexpr size_t WS_P = 48 * MiB;
constexpr size_t WS_M = WS_P + (size_t)PROWS * PWB * 2;
constexpr size_t WS_END = WS_M + (size_t)T * D * 2;
static_assert(WS_END <= 512 * MiB, "ws map");
constexpr int CW_BAR = 4096;
#define GAS __attribute__((address_space(1)))
#define LAS __attribute__((address_space(3)))
typedef unsigned short bf16;
typedef unsigned v4u __attribute__((ext_vector_type(4)));
typedef float f32x4 __attribute__((ext_vector_type(4)));
typedef short bf16x8 __attribute__((ext_vector_type(8)));
typedef GAS unsigned gu32;
typedef GAS unsigned long long gu64;
#define RLX_AGENT __ATOMIC_RELAXED, __HIP_MEMORY_SCOPE_AGENT
#define LDS_WAIT() asm volatile("s_waitcnt lgkmcnt(0)" ::: "memory")
#define VM_WAIT() asm volatile("s_waitcnt vmcnt(0)" ::: "memory")
__device__ __forceinline__ unsigned long long rt() { return __builtin_amdgcn_s_memrealtime(); }
__device__ __forceinline__ unsigned f2bf(float f) { unsigned u = __builtin_bit_cast(unsigned, f); return (u + 0x7fffu + ((u >> 16) & 1u)) >> 16; }
__device__ __forceinline__ unsigned pk2(float lo, float hi) { return f2bf(lo) | (f2bf(hi) << 16); }

#define XB_TMO      128
#define XB_XCNT(j)  (256  + 64 * (j))
#define XB_XSUB(j)  (1280 + 64 * (j))
#define XB_XGEN(j)  (2304 + 64 * (j))
#define XB_TOP      3328
#define XB_TOPGEN   3392
#define XCD_BAR_WORDS 3456
#define XB_SPIN_CAP (1u << 18)

__device__ __forceinline__ unsigned xb_ld(unsigned* p)              { return __hip_atomic_load(p, __ATOMIC_RELAXED, __HIP_MEMORY_SCOPE_AGENT); }
__device__ __forceinline__ unsigned xb_add(unsigned* p, unsigned v) { return __hip_atomic_fetch_add(p, v, __ATOMIC_RELAXED, __HIP_MEMORY_SCOPE_AGENT); }
__device__ __forceinline__ unsigned xb_xcc_id() { return (unsigned)__builtin_amdgcn_s_getreg((3 << 11) | 20) & 0xFu; }
#define XB_SPIN(cond, bar) do { unsigned _sp = 0; while (cond) { __builtin_amdgcn_s_sleep(1); \
    if ((++_sp & 255u) == 0u) { if (xb_ld(&(bar)[XB_TMO])) break; if (_sp > XB_SPIN_CAP) { atomicAdd(&(bar)[XB_TMO], 1u); break; } } } } while (0)

struct XcdBarrier {
    unsigned* bar; unsigned x;
    volatile LAS unsigned* st;
};

__device__ __forceinline__ XcdBarrier xcd_barrier_post(unsigned* bar, volatile LAS unsigned* st) {
    XcdBarrier b; b.bar = bar; b.x = xb_xcc_id(); b.st = st;
    if (threadIdx.x == 0) (void)xb_add(&bar[XB_XCNT(b.x)], 1u);
    return b;
}
__device__ __forceinline__ void xcd_barrier_complete(unsigned* bar, unsigned x, unsigned& nloc, unsigned& nx) {
    const unsigned G = gridDim.x * gridDim.y * gridDim.z;
    unsigned sum, cnt, mine, sp = 0u;
    for (;;) {
        sum = 0u; cnt = 0u; mine = 0u;
#pragma unroll
        for (unsigned j = 0; j < 16; ++j) { const unsigned c = xb_ld(&bar[XB_XCNT(j)]); sum += c; cnt += (c > 0u) ? 1u : 0u; mine = (j == x) ? c : mine; }
        if (sum == G) break;
        __builtin_amdgcn_s_sleep(1);
        if ((++sp & 255u) == 0u) { if (xb_ld(&bar[XB_TMO])) break; if (sp > XB_SPIN_CAP) { atomicAdd(&bar[XB_TMO], 1u); break; } }
    }
    nloc = mine > 0u ? mine : 1u; nx = cnt > 0u ? cnt : 1u;
}

__device__ __forceinline__ void xcd_barrier(const XcdBarrier& b) {
    asm volatile("s_waitcnt vmcnt(0)" ::: "memory");
    __syncthreads();
    if (threadIdx.x == 0) {
        unsigned* bar = b.bar;
        __builtin_amdgcn_s_waitcnt(0);
        unsigned nloc = b.st[0], nx = b.st[1];
        if (nloc == 0u) { xcd_barrier_complete(bar, b.x, nloc, nx); b.st[0] = nloc; b.st[1] = nx; }
        const unsigned old = xb_add(&bar[XB_XSUB(b.x)], 1u);
        const unsigned gen = old / nloc;
        if (old + 1u == (gen + 1u) * nloc) {
            __builtin_amdgcn_fence(__ATOMIC_RELEASE, "agent");
            asm volatile("s_waitcnt vmcnt(0)" ::: "memory");
            const unsigned og = xb_add(&bar[XB_TOP], 1u);
            const unsigned tg = og / nx;
            if (og + 1u == (tg + 1u) * nx) xb_add(&bar[XB_TOPGEN], 1u);
            else XB_SPIN(xb_ld(&bar[XB_TOPGEN]) == tg, bar);
            __builtin_amdgcn_fence(__ATOMIC_ACQUIRE, "agent");
            xb_add(&bar[XB_XGEN(b.x)], 1u);
            asm volatile("s_waitcnt vmcnt(0)" ::: "memory");
        } else {
            XB_SPIN(xb_ld(&bar[XB_XGEN(b.x)]) == gen, bar);
            __builtin_amdgcn_fence(__ATOMIC_ACQUIRE, "agent");
            asm volatile("s_waitcnt vmcnt(0)" ::: "memory");
        }
    }
    __syncthreads();
}
namespace pg8 {
#define PG8_LAS __attribute__((address_space(3)))
typedef unsigned short bf16_t;
typedef short bf16x8 __attribute__((ext_vector_type(8)));
typedef float f32x4 __attribute__((ext_vector_type(4)));
typedef unsigned u32x4 __attribute__((ext_vector_type(4)));
constexpr int BM = 256, BK = 64, HALF = 128, HTB = HALF * BK * 2  , STAGE_BYTES = 8 * HTB, NXCD = 8, WGM = 4;

__host__ __device__ __forceinline__ int lds_byte(int r, int c) { const int st = (r >> 4) * 2 + (c >> 5), rr = r & 15, cc = c & 31, ob = rr * 64 + cc * 2; return st * 1024 + (ob ^ (((ob >> 9) & 1) << 5)); }
__host__ __device__ __forceinline__ void stage_rc(int b, int& R, int& C) { const int st = b / 1024, sb = b % 1024, swz = sb ^ (((sb >> 9) & 1) << 5); R = (st >> 1) * 16 + swz / 64; C = (st & 1) * 32 + (swz % 64) / 2; }
__host__ __device__ __forceinline__ int perm32(int rho) { const int n = rho >> 4, i = rho & 15; return 8 * (i >> 2) + 4 * n + (i & 3); }

struct Unit { int pm, pn; };
struct Gemm { const void* A; const void* Bt; int nt, ldaB, ldbB; int sa, sb; };
typedef int v8i __attribute__((ext_vector_type(8)));

struct StaticOrder {
    int nM, nN, nwg, G, c;
    __host__ __device__ void init(int M, int N, int G_, int c_) { nM = M / BM; nN = N / BM; nwg = nM * nN; G = G_; c = c_; }
    __host__ __device__ bool next(int i, Unit& u) const {
        const long L = (long)i * G + c; if (L >= nwg) return false;
        int wgid = (int)L; { const int q = nwg / NXCD, r = nwg % NXCD, xcd = wgid % NXCD, off = wgid / NXCD; wgid = (xcd < r ? xcd * (q + 1) : r * (q + 1) + (xcd - r) * q) + off; }
        const int nig = WGM * nN, gid = wgid / nig, fm = gid * WGM, gsz = (nM - fm) < WGM ? (nM - fm) : WGM;
        u.pm = fm + ((wgid % nig) % gsz); u.pn = (wgid % nig) / gsz; return true;
    }
    __device__ __forceinline__ int brow(const Unit& u) const { return u.pn * BM; }
    __device__ __forceinline__ const int* rowlist() const { return nullptr; }
    static constexpr bool WAITS = false, SIGNALS = false;
    __device__ __forceinline__ void a_ready(const Unit&) const {}
    __device__ __forceinline__ void done(const Unit&) const {}
};

__device__ __forceinline__ unsigned cvt_pk_bf16(float lo, float hi) { unsigned r; asm volatile("v_cvt_pk_bf16_f32 %0, %1, %2" : "=v"(r) : "v"(lo), "v"(hi)); return r; }

struct EpiBf16 {
    static constexpr bool PERM = true;
    bf16_t* O; int ldc;
    __device__ __forceinline__ void operator()(const f32x4 (&acc)[2][2][4][2], const Unit& u, int wr_, int wc_, int fr_, int fq_) const {
        int t_ = threadIdx.x; asm volatile("" : "+v"(t_));
        const int wid_ = __builtin_amdgcn_readfirstlane(t_ >> 6), wr = wid_ >> 2, wc = wid_ & 3, fr = t_ & 15, fq = (t_ & 63) >> 4; (void)wr_; (void)wc_; (void)fr_; (void)fq_;
        const int row0 = u.pm * BM + wr * 64 + fr; const int col0 = u.pn * BM + wc * 32 + 8 * fq;
#pragma unroll
        for (int ai = 0; ai < 2; ++ai)
#pragma unroll
            for (int m = 0; m < 4; ++m) { bf16_t* rowp = O + (size_t)(row0 + ai * HALF + m * 16) * ldc + col0;
#pragma unroll
                for (int bj = 0; bj < 2; ++bj) { const f32x4 v0 = acc[ai][bj][m][0], v1 = acc[ai][bj][m][1];
                    u32x4 w; w.x = cvt_pk_bf16(v0[0], v0[1]); w.y = cvt_pk_bf16(v0[2], v0[3]); w.z = cvt_pk_bf16(v1[0], v1[1]); w.w = cvt_pk_bf16(v1[2], v1[3]);
                    *(u32x4*)(rowp + bj * HALF) = w; } }
    }
};
struct EpiGate {
    static constexpr bool PERM = true;
    bf16_t* P; int ldp;
    __device__ __forceinline__ void operator()(const f32x4 (&acc)[2][2][4][2], const Unit& u, int wr_, int wc_, int fr_, int fq_) const {
        int t_ = threadIdx.x; asm volatile("" : "+v"(t_));
        const int wid_ = __builtin_amdgcn_readfirstlane(t_ >> 6), wr = wid_ >> 2, wc = wid_ & 3, fr = t_ & 15, fq = (t_ & 63) >> 4; (void)wr_; (void)wc_; (void)fr_; (void)fq_;
        const int row0 = u.pm * BM + wr * 64 + fr; const int col0 = u.pn * BM + wc * 32 + 8 * fq;
        const bool sig = u.pn >= 4;
#pragma unroll
        for (int ai = 0; ai < 2; ++ai)
#pragma unroll
            for (int m = 0; m < 4; ++m) { unsigned char* rowp = (unsigned char*)(P + (size_t)(row0 + ai * HALF + m * 16) * ldp) + col0;
#pragma unroll
                for (int bj = 0; bj < 2; ++bj) { const f32x4 v0 = acc[ai][bj][m][0], v1 = acc[ai][bj][m][1];
                    float e[8] = {v0[0], v0[1], v0[2], v0[3], v1[0], v1[1], v1[2], v1[3]};
#pragma unroll
                    for (int j = 0; j < 8; ++j) e[j] = __builtin_rintf(sig ? 255.f * __builtin_amdgcn_rcpf(1.f + __expf(-e[j])) : e[j] * 20.f + 128.f);
                    unsigned w0 = 0u, w1 = 0u;
                    w0 = __builtin_amdgcn_cvt_pk_u8_f32(e[0], 0, w0); w0 = __builtin_amdgcn_cvt_pk_u8_f32(e[1], 1, w0); w0 = __builtin_amdgcn_cvt_pk_u8_f32(e[2], 2, w0); w0 = __builtin_amdgcn_cvt_pk_u8_f32(e[3], 3, w0);
                    w1 = __builtin_amdgcn_cvt_pk_u8_f32(e[4], 0, w1); w1 = __builtin_amdgcn_cvt_pk_u8_f32(e[5], 1, w1); w1 = __builtin_amdgcn_cvt_pk_u8_f32(e[6], 2, w1); w1 = __builtin_amdgcn_cvt_pk_u8_f32(e[7], 3, w1);
                    typedef unsigned u32x2_ __attribute__((ext_vector_type(2)));
                    *(u32x2_*)(rowp + bj * HALF) = (u32x2_){w0, w1}; } }
    }
};
struct EpiX1 {
    static constexpr bool PERM = true;
    const float* x; const float* gt; bf16_t* xo;
    __device__ __forceinline__ void operator()(const f32x4 (&acc)[2][2][4][2], const Unit& u, int wr_, int wc_, int fr_, int fq_) const {
        int t_ = threadIdx.x; asm volatile("" : "+v"(t_));
        const int wid_ = __builtin_amdgcn_readfirstlane(t_ >> 6), wr = wid_ >> 2, wc = wid_ & 3, fr = t_ & 15, fq = (t_ & 63) >> 4; (void)wr_; (void)wc_; (void)fr_; (void)fq_;
        const int b = (u.pm * BM) / SEQ; const float* g = gt + (size_t)b * NMOD;
        const int col0 = u.pn * BM + wc * 32 + 8 * fq;
        f32x4 gv[2][2];
#pragma unroll
        for (int bj = 0; bj < 2; ++bj)
#pragma unroll
            for (int n = 0; n < 2; ++n) gv[bj][n] = *(const f32x4*)(g + col0 + bj * HALF + n * 4);
#pragma unroll
        for (int ai = 0; ai < 2; ++ai)
#pragma unroll
            for (int m = 0; m < 4; ++m) { const size_t row = (size_t)(u.pm * BM + ai * HALF + wr * 64 + m * 16 + fr);
#pragma unroll
                for (int bj = 0; bj < 2; ++bj) {
                    const f32x4 x0 = *(const f32x4*)(x + row * D + col0 + bj * HALF), x1 = *(const f32x4*)(x + row * D + col0 + bj * HALF + 4);
                    const f32x4 v0 = x0 + gv[bj][0] * acc[ai][bj][m][0], v1 = x1 + gv[bj][1] * acc[ai][bj][m][1];
                    u32x4 w; w.x = cvt_pk_bf16(v0[0], v0[1]); w.y = cvt_pk_bf16(v0[2], v0[3]); w.z = cvt_pk_bf16(v1[0], v1[1]); w.w = cvt_pk_bf16(v1[2], v1[3]);
                    *(u32x4*)(xo + row * 2048 + col0 + bj * HALF) = w; } }
    }
};

template <bool GATHER>
__device__ __forceinline__ void mk_voff(const int* rowlist, int ldaB, int pm, int tid, unsigned (&o)[2][2]) {
#pragma unroll
    for (int h = 0; h < 2; ++h)
#pragma unroll
        for (int i = 0; i < 2; ++i) {
            int R, C; stage_rc(tid * 16 + i * 8192, R, C);
            int row = pm * BM + h * HALF + R;
            if (GATHER) { row = rowlist[row]; row = row < 0 ? 0 : row; }
            o[h][i] = (unsigned)(row * ldaB + C * 2);
        }
}

template <class Epi, class Sched, bool GATHER, bool ALIGN_EPI, bool F8 = false, bool BSPLIT = false>
__device__ __forceinline__ void gemm_phase(PG8_LAS unsigned char* lds, const Gemm g, const Sched& S, const Epi& E) {
    int tid_ = threadIdx.x; asm volatile("" : "+v"(tid_));
    const int tid = tid_, wid = __builtin_amdgcn_readfirstlane(tid >> 6), lane = tid & 63, wr = wid >> 2, wc = wid & 3, fr = lane & 15, fq = lane >> 4;
    const int nt = g.nt, lda = g.ldaB, ldbB = g.ldbB;
    const int* rl = S.rowlist();
    unsigned voffB[2], voffA0[2];
#pragma unroll
    for (int i = 0; i < 2; ++i) { int R, C; stage_rc(tid * 16 + i * 8192, R, C); const int Rb = Epi::PERM ? ((R & ~31) + perm32(R & 31)) : R;
        voffB[i] = (unsigned)(Rb * ldbB + C * 2); voffA0[i] = (unsigned)(R * lda + C * 2); }
    PG8_LAS u32x4* const xslot = (PG8_LAS u32x4*)(lds + 132096 + tid * 16);
    const size_t kstep = (size_t)(BK * 2);
    const size_t hstepB = (size_t)HALF * ldbB;
    const unsigned ldsw = (unsigned)wid * 1024u;
    const int aoff = lds_byte(wr * 64 + fr, fq * 8), boff = lds_byte(wc * 32 + fr, fq * 8);
#define PG8_SA(b, h) (((b) * 2 + (h)) * HTB)
#define PG8_SB(b, h) ((4 + (b) * 2 + (h)) * HTB)
#define PG8_STAGE(bufoff, RS, soff, voff) do { _Pragma("unroll") for (int _i = 0; _i < 2; ++_i) \
        __builtin_amdgcn_raw_ptr_buffer_load_lds(RS, (PG8_LAS unsigned*)(lds + (bufoff) + ldsw + _i * 8192), 16, (int)(voff)[_i], (int)(soff), 0, 0); } while (0)
#define PG8_LD8(p) __builtin_bit_cast(v8i, __builtin_shufflevector(*(const PG8_LAS u32x4*)(p), *(const PG8_LAS u32x4*)((p) + 1024), 0, 1, 2, 3, 4, 5, 6, 7))
#define PG8_LDA(dst, b, h) do { _Pragma("unroll") for (int m = 0; m < 4; ++m) { if constexpr (F8) dst##8[m] = PG8_LD8(lds + PG8_SA(b, h) + aoff + m * 2048); else { _Pragma("unroll") for (int k = 0; k < 2; ++k) dst[m][k] = *(const PG8_LAS bf16x8*)(lds + PG8_SA(b, h) + aoff + m * 2048 + k * 1024); } } } while (0)
#define PG8_LDB(dst, b, h) do { _Pragma("unroll") for (int n = 0; n < 2; ++n) { if constexpr (F8) dst##8[n] = PG8_LD8(lds + PG8_SB(b, h) + boff + n * 2048); else { _Pragma("unroll") for (int k = 0; k < 2; ++k) dst[n][k] = *(const PG8_LAS bf16x8*)(lds + PG8_SB(b, h) + boff + n * 2048 + k * 1024); } } } while (0)
#define PG8_MMA(ai, bj, At, Bt) do { __builtin_amdgcn_s_setprio(1); _Pragma("unroll") for (int m = 0; m < 4; ++m) _Pragma("unroll") for (int n = 0; n < 2; ++n) { \
        if constexpr (F8) asm volatile("v_mfma_scale_f32_16x16x128_f8f6f4 %0, %1, %2, %0, %3, %4 op_sel_hi:[0,0,0]" : "+v"(acc[ai][bj][m][n]) : "v"(Bt##8[n]), "v"(At##8[m]), "v"(SCALE_B), "v"(SCALE_A)); \
        else { _Pragma("unroll") for (int k = 0; k < 2; ++k) acc[ai][bj][m][n] = __builtin_amdgcn_mfma_f32_16x16x32_bf16(Bt[n][k], At[m][k], acc[ai][bj][m][n], 0, 0, 0); } } \
        __builtin_amdgcn_s_setprio(0); } while (0)
#define PG8_WAIT_V(n) asm volatile("s_waitcnt vmcnt(" #n ")" ::: "memory")
#define PG8_WAIT_L(n) asm volatile("s_waitcnt lgkmcnt(" #n ")" ::: "memory")
#define PG8_BAR __builtin_amdgcn_s_barrier()
#define PG8_SCHED __builtin_amdgcn_sched_barrier(0)
    const int SCALE_A = g.sa, SCALE_B = g.sb;
    Unit cur, nxt; int ui = 0;
    if (!S.next(0, cur)) return;
    if constexpr (Sched::WAITS) S.a_ready(cur);
    f32x4 acc[2][2][4][2];
#pragma unroll
    for (int a = 0; a < 2; ++a)
#pragma unroll
        for (int b = 0; b < 2; ++b)
#pragma unroll
            for (int m = 0; m < 4; ++m)
#pragma unroll
                for (int n = 0; n < 2; ++n) acc[a][b][m][n] = (f32x4){0.f, 0.f, 0.f, 0.f};
    bf16x8 At[4][2], B0[2][2], B1[2][2]; v8i At8[4], B08[2], B18[2];
    unsigned voffA[2][2];
    const unsigned hstepA = (unsigned)HALF * (unsigned)lda, tstepA = 2u * hstepA;
    const __amdgpu_buffer_rsrc_t rsA = __builtin_amdgcn_make_buffer_rsrc((void*)g.A, 0, 0x7fffffff, 0x00020000), rsB = __builtin_amdgcn_make_buffer_rsrc((void*)g.Bt, 0, 0x7fffffff, 0x00020000);
    unsigned cAo = 0u, nAo = 0u;
    if constexpr (GATHER) mk_voff<true>(rl, lda, cur.pm, tid, voffA);
    else cAo = (unsigned)cur.pm * tstepA;
#define PG8_STAGE_A(bufoff, soff, h, OFFS) do { if constexpr (GATHER) PG8_STAGE(bufoff, rsA, soff, (OFFS)[h]); else PG8_STAGE(bufoff, rsA, (soff) + (h) * hstepA, voffA0); } while (0)
    unsigned cBo = (unsigned)S.brow(cur) * (unsigned)ldbB;
    const unsigned kstepu = (unsigned)kstep, hstepBu = (unsigned)hstepB;
    int cK0 = 0, cK1 = 0, nK0 = 0, nK1 = 0;
    if constexpr (BSPLIT) S.kb(cur, cK0, cK1);
#define PG8_BOFF(base, k0, k1, j) ((base) + (BSPLIT ? (unsigned)(((j) < 2 ? (k0) : (k1)) + ((j) & 1) * 128) : (unsigned)(j) * kstepu))
    { const unsigned p0 = PG8_BOFF(cBo, cK0, cK1, 0), p1 = PG8_BOFF(cBo, cK0, cK1, 1);
    PG8_STAGE(PG8_SB(0, 0), rsB, p0, voffB); PG8_STAGE(PG8_SB(0, 1), rsB, p0 + hstepBu, voffB); PG8_STAGE_A(PG8_SA(0, 0), cAo, 0, voffA); PG8_STAGE_A(PG8_SA(0, 1), cAo, 1, voffA);
    if (wr == 1) PG8_BAR;
    PG8_WAIT_V(2); PG8_BAR;
    PG8_STAGE(PG8_SB(1, 0), rsB, p1, voffB); PG8_STAGE_A(PG8_SA(1, 0), cAo + kstepu, 0, voffA); PG8_STAGE(PG8_SB(1, 1), rsB, p1 + hstepBu, voffB); }
    PG8_WAIT_V(6); PG8_BAR;
    for (;;) {
        const bool has_next = S.next(ui + 1, nxt);
        if constexpr (GATHER) {
            unsigned vn[2][2];
            if (has_next) mk_voff<true>(rl, lda, nxt.pm, tid, vn);
            else {
#pragma unroll
                for (int h = 0; h < 2; ++h)
#pragma unroll
                    for (int i = 0; i < 2; ++i) vn[h][i] = voffA[h][i]; }
            *xslot = (u32x4){vn[0][0], vn[0][1], vn[1][0], vn[1][1]};
        } else nAo = has_next ? (unsigned)nxt.pm * tstepA : cAo;
        const unsigned nBo = has_next ? (unsigned)S.brow(nxt) * (unsigned)ldbB : cBo;
        if constexpr (BSPLIT) { if (has_next) S.kb(nxt, nK0, nK1); else { nK0 = cK0; nK1 = cK1; } }
#pragma nounroll
        for (int t = 0; t < nt; t += 2) {
            const bool last = (t == nt - 2);
            if constexpr (Sched::WAITS) { if (last && has_next) S.a_ready(nxt); }
            const unsigned a1 = cAo + (unsigned)(t + 1) * kstepu;
            const unsigned a2 = last ? nAo : cAo + (unsigned)(t + 2) * kstepu, b2 = last ? PG8_BOFF(nBo, nK0, nK1, 0) : PG8_BOFF(cBo, cK0, cK1, t + 2);
            const unsigned a3 = a2 + kstepu, b3 = last ? PG8_BOFF(nBo, nK0, nK1, 1) : PG8_BOFF(cBo, cK0, cK1, t + 3);
            unsigned sl[2][2];
            if constexpr (GATHER) {
                if (last) { const u32x4 vn = *xslot; sl[0][0] = vn.x; sl[0][1] = vn.y; sl[1][0] = vn.z; sl[1][1] = vn.w; }
                else {
#pragma unroll
                    for (int h = 0; h < 2; ++h)
#pragma unroll
                        for (int i = 0; i < 2; ++i) sl[h][i] = voffA[h][i]; } }
            PG8_LDB(B0, 0, 0); PG8_LDB(B1, 0, 1); PG8_SCHED; PG8_LDA(At, 0, 0); PG8_STAGE_A(PG8_SA(1, 1), a1, 1, voffA);
            PG8_WAIT_V(8); PG8_WAIT_L(0); PG8_BAR; PG8_MMA(0, 0, At, B0); PG8_MMA(0, 1, At, B1); PG8_BAR; PG8_SCHED;
            PG8_LDA(At, 0, 1); PG8_STAGE(PG8_SB(0, 0), rsB, b2, voffB); PG8_STAGE(PG8_SB(0, 1), rsB, b2 + hstepBu, voffB); PG8_STAGE_A(PG8_SA(0, 0), a2, 0, sl);
            PG8_WAIT_V(8); PG8_WAIT_L(0); PG8_BAR; PG8_MMA(1, 0, At, B0); PG8_MMA(1, 1, At, B1); PG8_BAR; PG8_SCHED;
            PG8_LDB(B0, 1, 0); PG8_LDB(B1, 1, 1); PG8_SCHED; PG8_LDA(At, 1, 0); PG8_STAGE_A(PG8_SA(0, 1), a2, 1, sl);
            PG8_WAIT_V(8); PG8_WAIT_L(0); PG8_BAR; PG8_MMA(0, 0, At, B0); PG8_MMA(0, 1, At, B1); PG8_BAR; PG8_SCHED;
            PG8_LDA(At, 1, 1); PG8_STAGE(PG8_SB(1, 0), rsB, b3, voffB); PG8_STAGE(PG8_SB(1, 1), rsB, b3 + hstepBu, voffB); PG8_STAGE_A(PG8_SA(1, 0), a3, 0, sl);
            PG8_WAIT_V(8); PG8_WAIT_L(0); PG8_BAR; PG8_MMA(1, 0, At, B0); PG8_MMA(1, 1, At, B1); PG8_BAR; PG8_SCHED;
        }
        if constexpr (ALIGN_EPI) { if (wr == 0) PG8_BAR; }
        if constexpr (F8) asm volatile("s_nop 15\n\ts_nop 7" ::: "memory");
        E(acc, cur, wr, wc, fr, fq);
        if constexpr (Sched::SIGNALS) S.done(cur);
        if (!has_next) break;
#pragma unroll
        for (int a = 0; a < 2; ++a)
#pragma unroll
            for (int b = 0; b < 2; ++b)
#pragma unroll
                for (int m = 0; m < 4; ++m)
#pragma unroll
                    for (int n = 0; n < 2; ++n) acc[a][b][m][n] = (f32x4){0.f, 0.f, 0.f, 0.f};
        cur = nxt; cBo = nBo; cAo = nAo; cK0 = nK0; cK1 = nK1; ++ui;
        if constexpr (GATHER) { const u32x4 vn = *xslot; voffA[0][0] = vn.x; voffA[0][1] = vn.y; voffA[1][0] = vn.z; voffA[1][1] = vn.w; }
        if constexpr (ALIGN_EPI) { if (wr == 1) PG8_BAR; }
    }
    PG8_WAIT_V(0);
    if constexpr (!ALIGN_EPI) { if (wr == 0) PG8_BAR; }
    PG8_BAR;
#undef PG8_SA
#undef PG8_SB
#undef PG8_STAGE
#undef PG8_STAGE_A
#undef PG8_BOFF
#undef PG8_LDA
#undef PG8_LDB
#undef PG8_MMA
#undef PG8_LD8
#undef PG8_WAIT_V
#undef PG8_WAIT_L
#undef PG8_BAR
#undef PG8_SCHED
}
}
constexpr int NWAVES = 8;
constexpr int RING_OFF = 0, RING_BYTES = 131072;
constexpr int LDSCTL_OFF = RING_BYTES, MISC_OFF = LDSCTL_OFF + 320;
constexpr int LDS_BYTES = 147456;
static_assert(MISC_OFF + 128 <= LDS_BYTES, "LDS map");

struct Frame {
    LAS unsigned char* lds;
    volatile LAS unsigned* MISC;
    gu32* ctl;
    int tid, lane, wave;
    int vcu, G;
};
struct Args { const float* in[20]; float* out; unsigned char* ws; int ph_lo, ph_hi, li, pad; };

typedef float f32x16 __attribute__((ext_vector_type(16)));
typedef unsigned u32x2 __attribute__((ext_vector_type(2)));
__device__ __forceinline__ float bfl(unsigned w) { return __uint_as_float(w << 16); }
__device__ __forceinline__ float bfh(unsigned w) { return __uint_as_float(w & 0xffff0000u); }
#define LDS_BARRIER() do { asm volatile("s_waitcnt lgkmcnt(0)" ::: "memory"); __builtin_amdgcn_s_barrier(); asm volatile("" ::: "memory"); } while (0)
constexpr int NBK = 24, MAXPOS = 40960, MAXTILES = MAXPOS / 256;
constexpr size_t SORT_CNT = 0;
constexpr size_t SORT_SEG = 32768;
constexpr size_t SORT_TILEB = 33024;
constexpr size_t SORT_ROWLIST = 65536;
constexpr size_t SORT_CW = 262144;
constexpr int RB_ROWS = 128, NRB = T / RB_ROWS;
__device__ __forceinline__ int pair_id(int lo, int hi) { return (lo == 0 ? 0 : (lo == 1 ? 3 : 5)) + hi - lo - 1; }
__device__ __forceinline__ void pair_lohi(int pid, int& lo, int& hi) { lo = pid < 3 ? 0 : (pid < 5 ? 1 : 2); hi = pid < 3 ? pid + 1 : (pid < 5 ? pid - 1 : 3); }

__device__ __forceinline__ float wsum64(float v) {
#pragma unroll
    for (int o = 1; o < 64; o <<= 1) v += __shfl_xor(v, o);
    return v;
}

constexpr int R8_PITCH = 2064, R8_TILE = 0, R8_WT = 32 * R8_PITCH, R8_RED = R8_WT + 20 * R8_PITCH, R8_CNT = R8_RED + 8 * 32 * 20 * 4, R8_END = R8_CNT + 128;
static_assert(R8_END <= RING_BYTES, "p8 lds");
__device__ __forceinline__ void p8_h2_route(Frame& F0, const Args& args, const float* mod, unsigned char* A1) {
    Frame F = F0; { int t__ = threadIdx.x; asm volatile("" : "+v"(t__)); F.tid = t__; F.lane = t__ & 63; F.wave = __builtin_amdgcn_readfirstlane(t__ >> 6); }
    const bf16* x1 = (const bf16*)args.out; const float* g2 = args.in[11]; const float* w_group = args.in[12]; const float* b_group = args.in[13]; const float* w_router = args.in[14]; const float* b_router = args.in[15];
    int4* route = (int4*)(args.ws + WS_ROUTE); int* cnt = (int*)(args.ws + WS_SORT + SORT_CNT);
    LAS unsigned char* tile = F.lds + RING_OFF + R8_TILE; LAS unsigned char* wt = F.lds + RING_OFF + R8_WT; LAS float* red = (LAS float*)(F.lds + RING_OFF + R8_RED); LAS int* lcnt = (LAS int*)(F.lds + RING_OFF + R8_CNT);
    const int lane = F.lane, w = F.wave, vl = lane & 31, hh = lane >> 5;
    for (int d = F.tid; d < D; d += NWAVES * 64) {
        const f32x4 wg = *(const f32x4*)(w_group + (size_t)d * 4);
        *(LAS unsigned short*)(wt + 0 * R8_PITCH + d * 2) = (unsigned short)f2bf(wg.x); *(LAS unsigned short*)(wt + 1 * R8_PITCH + d * 2) = (unsigned short)f2bf(wg.y);
        *(LAS unsigned short*)(wt + 2 * R8_PITCH + d * 2) = (unsigned short)f2bf(wg.z); *(LAS unsigned short*)(wt + 3 * R8_PITCH + d * 2) = (unsigned short)f2bf(wg.w);
#pragma unroll
        for (int q = 0; q < 4; ++q) { const f32x4 w4 = *(const f32x4*)(w_router + (size_t)d * 16 + q * 4);
            *(LAS unsigned short*)(wt + (4 + q * 4 + 0) * R8_PITCH + d * 2) = (unsigned short)f2bf(w4.x); *(LAS unsigned short*)(wt + (4 + q * 4 + 1) * R8_PITCH + d * 2) = (unsigned short)f2bf(w4.y);
            *(LAS unsigned short*)(wt + (4 + q * 4 + 2) * R8_PITCH + d * 2) = (unsigned short)f2bf(w4.z); *(LAS unsigned short*)(wt + (4 + q * 4 + 3) * R8_PITCH + d * 2) = (unsigned short)f2bf(w4.w); }
    }
    __syncthreads();
    for (int rb = blockIdx.x; rb < NRB; rb += F.G) {
        const int b = (rb * RB_ROWS) / SEQ; const float* sh = mod + b * NMOD + 3 * D; const float* sc = mod + b * NMOD + 4 * D;
        f32x4 scl[4], sft[4];
#pragma unroll
        for (int j = 0; j < 2; ++j)
#pragma unroll
            for (int q = 0; q < 2; ++q) { const int c0 = lane * 8 + 512 * j + 4 * q; scl[2 * j + q] = *(const f32x4*)(g2 + c0) * (*(const f32x4*)(sc + c0) + 1.f); sft[2 * j + q] = *(const f32x4*)(sh + c0); }
        if (F.tid < NBK) lcnt[F.tid] = 0;
        for (int bt = 0; bt < 4; ++bt) {
            const int rbase = rb * RB_ROWS + bt * 32;
            v4u xr[4][2];
#pragma unroll
            for (int i = 0; i < 4; ++i)
#pragma unroll
                for (int j = 0; j < 2; ++j) xr[i][j] = *(const GAS v4u*)(x1 + (size_t)(rbase + w * 4 + i) * 2048 + lane * 8 + 512 * j);
#pragma unroll
            for (int i = 0; i < 4; ++i) {
                const int row = rbase + w * 4 + i;
                f32x4 v[4]; float s = 0.f;
#pragma unroll
                for (int j = 0; j < 2; ++j) { v[2 * j] = (f32x4){bfl(xr[i][j].x), bfh(xr[i][j].x), bfl(xr[i][j].y), bfh(xr[i][j].y)}; v[2 * j + 1] = (f32x4){bfl(xr[i][j].z), bfh(xr[i][j].z), bfl(xr[i][j].w), bfh(xr[i][j].w)}; }

#pragma unroll
                for (int q = 0; q < 4; ++q) s += (v[q].x * v[q].x + v[q].y * v[q].y) + (v[q].z * v[q].z + v[q].w * v[q].w);
                const float rstd = rsqrtf(wsum64(s) * (1.f / D) + EPS);
#pragma unroll
                for (int j = 0; j < 2; ++j) { const f32x4 y0 = v[2 * j] * rstd * scl[2 * j] + sft[2 * j], y1 = v[2 * j + 1] * rstd * scl[2 * j + 1] + sft[2 * j + 1];
                    const v4u o = {pg8::cvt_pk_bf16(y0.x, y0.y), pg8::cvt_pk_bf16(y0.z, y0.w), pg8::cvt_pk_bf16(y1.x, y1.y), pg8::cvt_pk_bf16(y1.z, y1.w)};
                    { int q0 = __builtin_amdgcn_cvt_pk_fp8_f32(y0.x, y0.y, 0, false); q0 = __builtin_amdgcn_cvt_pk_fp8_f32(y0.z, y0.w, q0, true);
                      int q1 = __builtin_amdgcn_cvt_pk_fp8_f32(y1.x, y1.y, 0, false); q1 = __builtin_amdgcn_cvt_pk_fp8_f32(y1.z, y1.w, q1, true);
                      *(GAS u32x2*)(A1 + (size_t)row * D + lane * 8 + 512 * j) = (u32x2){(unsigned)q0, (unsigned)q1}; }
                    *(LAS v4u*)(tile + (w * 4 + i) * R8_PITCH + (lane * 8 + 512 * j) * 2) = o; }
            }
            __syncthreads();
            {
                f32x16 acc = {0.f, 0.f, 0.f, 0.f, 0.f, 0.f, 0.f, 0.f, 0.f, 0.f, 0.f, 0.f, 0.f, 0.f, 0.f, 0.f};
                const int cr = vl < 20 ? vl : 19;
#pragma unroll
                for (int kk = 0; kk < 8; ++kk) { const bf16x8 a = *(const LAS bf16x8*)(tile + vl * R8_PITCH + (128 * w + 16 * kk + 8 * hh) * 2), bb = *(const LAS bf16x8*)(wt + cr * R8_PITCH + (128 * w + 16 * kk + 8 * hh) * 2);
                    acc = __builtin_amdgcn_mfma_f32_32x32x16_bf16(a, bb, acc, 0, 0, 0); }
                if (vl < 20) {
#pragma unroll
                    for (int r = 0; r < 16; ++r) red[(w * 32 + (r & 3) + 8 * (r >> 2) + 4 * hh) * 20 + vl] = acc[r]; }
            }
            __syncthreads();
            if (F.tid < 32) {
                const int row = rbase + F.tid;
                float lg[20];
#pragma unroll
                for (int c = 0; c < 20; ++c) { float a = 0.f;
#pragma unroll
                    for (int ww = 0; ww < 8; ++ww) a += red[(ww * 32 + F.tid) * 20 + c];
                    lg[c] = a; }
                float bg[4], br[16];
#pragma unroll
                for (int c = 0; c < 4; ++c) bg[c] = b_group[c];
#pragma unroll
                for (int c = 0; c < 16; ++c) br[c] = b_router[c];
                float gl[4]; int gi = 0;
#pragma unroll
                for (int c = 0; c < 4; ++c) gl[c] = lg[c] + bg[c];
                float gm = gl[0];
#pragma unroll
                for (int c = 1; c < 4; ++c) if (gl[c] > gm) { gm = gl[c]; gi = c; }
                float den = 0.f;
#pragma unroll
                for (int c = 0; c < 4; ++c) den += __expf(gl[c] - gm);
                const float gw = 1.f / den;
                float el[4];
#pragma unroll
                for (int c = 0; c < 4; ++c) { float vsel = lg[4 + c] + br[c];
#pragma unroll
                    for (int g = 1; g < 4; ++g) { const float cand = lg[4 + g * 4 + c] + br[g * 4 + c]; vsel = (gi == g) ? cand : vsel; }
                    el[c] = vsel; }
                int i0 = 0; float v0 = el[0];
#pragma unroll
                for (int c = 1; c < 4; ++c) if (el[c] > v0) { v0 = el[c]; i0 = c; }
                int i1 = -1; float v1 = -3.0e38f;
#pragma unroll
                for (int c = 0; c < 4; ++c) if (c != i0 && el[c] > v1) { v1 = el[c]; i1 = c; }
                const float p1 = __expf(v1 - v0), w0 = gw / (1.f + p1), w1 = gw * p1 / (1.f + p1);
                route[row] = make_int4(gi * 4 + i0, gi * 4 + i1, __float_as_int(w0), __float_as_int(w1));
                const int lo = i0 < i1 ? i0 : i1, hi = i0 < i1 ? i1 : i0;
                atomicAdd((int*)(lcnt + gi * 6 + pair_id(lo, hi)), 1);
            }
        }
        if (F.tid < 32) { asm volatile("s_waitcnt lgkmcnt(0)" ::: "memory"); if (F.tid < NBK) cnt[rb * NBK + F.tid] = lcnt[F.tid]; }
    }
}

__device__ __forceinline__ void p9_sort(Frame& F0, const Args& args) {
    Frame F = F0; { int t__ = threadIdx.x; asm volatile("" : "+v"(t__)); F.tid = t__; F.lane = t__ & 63; F.wave = __builtin_amdgcn_readfirstlane(t__ >> 6); }
    const int4* route = (const int4*)(args.ws + WS_ROUTE); const int* cnt = (const int*)(args.ws + WS_SORT + SORT_CNT);
    int* seg = (int*)(args.ws + WS_SORT + SORT_SEG); int* tileb = (int*)(args.ws + WS_SORT + SORT_TILEB); int* rowlist = (int*)(args.ws + WS_SORT + SORT_ROWLIST); float* cw = (float*)(args.ws + WS_SORT + SORT_CW);
    LAS int* scn = (LAS int*)(F.lds + RING_OFF);
    LAS int* sst = (LAS int*)(F.lds + RING_OFF + 24576);
    LAS int* sw0 = (LAS int*)(F.lds + RING_OFF + 24576 + 256);
    LAS int* sbase = (LAS int*)(F.lds + RING_OFF + 24576 + 384);
    for (int i = F.tid; i < NRB * NBK; i += NWAVES * 64) scn[i] = cnt[i];
    __syncthreads();
    if (F.tid < NBK) { int s = 0; for (int r = 0; r < NRB; ++r) s += scn[r * NBK + F.tid]; sst[32 + F.tid] = s; }
    __syncthreads();
    if (F.tid == 0) { int p = 0; for (int k = 0; k < NBK; ++k) { sst[k] = p; p += (sst[32 + k] + 255) & ~255; } sst[NBK] = p; }
    __syncthreads();
    if (blockIdx.x == 0) {
        if (F.tid <= NBK) seg[F.tid] = sst[F.tid];
        if (F.tid == 32) seg[32] = sst[NBK] / 256;
        for (int t = F.tid; t < sst[NBK] / 256; t += NWAVES * 64) { int k = 0;
#pragma unroll 1
            for (int q = 1; q < NBK; ++q) k += (t * 256 >= sst[q]) ? 1 : 0;
            while (k > 0 && sst[32 + k] == 0) --k;
            tileb[t] = k; }
    }
    if (blockIdx.x < NBK) {
        const int k = blockIdx.x, p0 = sst[k] + sst[32 + k], p1 = sst[k + 1];
        for (int p = p0 + F.tid; p < p1; p += NWAVES * 64) { rowlist[p] = -1; cw[2 * p] = 0.f; cw[2 * p + 1] = 0.f; }
    }
    for (int rb = blockIdx.x; rb < NRB; rb += F.G) {
        if (F.tid < NBK) { int s = 0; for (int r = 0; r < rb; ++r) s += scn[r * NBK + F.tid]; sbase[F.tid] = sst[F.tid] + s; }
        const bool act = F.tid < RB_ROWS;
        const int row = rb * RB_ROWS + (act ? F.tid : 0);
        int4 rt = make_int4(0, 0, 0, 0); int bk = -1, lo = 0;
        if (act) { rt = route[row]; const int a = rt.x & 3, c = rt.y & 3; lo = a < c ? a : c; const int hi = a < c ? c : a; bk = (rt.x >> 2) * 6 + pair_id(lo, hi); }
        const unsigned long long lt = (1ull << F.lane) - 1ull;
        int rank = 0, mycount = 0;
#pragma unroll 1
        for (int q = 0; q < NBK; ++q) { const unsigned long long mk = __ballot(bk == q); if (bk == q) rank = __popcll(mk & lt); if (F.lane == q) mycount = __popcll(mk); }
        if (F.wave == 0 && F.lane < NBK) sw0[F.lane] = mycount;
        __syncthreads();
        if (act) {
            if (F.wave == 1) rank += sw0[bk];
            const int pos = sbase[bk] + rank;
            const float w0 = __int_as_float(rt.z), w1 = __int_as_float(rt.w);
            const bool first_is_lo = (rt.x & 3) == lo;
            rowlist[pos] = row; cw[2 * pos] = first_is_lo ? w0 : w1; cw[2 * pos + 1] = first_is_lo ? w1 : w0;
        }
        __syncthreads();
    }
}

constexpr int CW_HIDCNT = 8192, HIDCNT_STRIDE = 16, HIDCNT_FULL = 32;
struct PairOrder10 {
    static constexpr bool WAITS = false, SIGNALS = true;
    const int* rl; const int* tileb; gu32* cnt; int nunits, G, c;
    __device__ __forceinline__ bool next(int i, pg8::Unit& u) const { const int L = i * G + c; if (L >= nunits) return false; u.pm = L >> 2; u.pn = L & 3; return true; }
    __device__ __forceinline__ int brow(const pg8::Unit& u) const { const int bk = __builtin_amdgcn_readfirstlane(tileb[u.pm]); int lo, hi; pair_lohi(bk % 6, lo, hi);
        return ((bk / 6) * 4 + ((u.pn >> 1) ? hi : lo)) * 512 + (u.pn & 1) * 256; }
    __device__ __forceinline__ const int* rowlist() const { return rl; }
    __device__ __forceinline__ void a_ready(const pg8::Unit&) const {}
    __device__ __forceinline__ void done(const pg8::Unit& u) const {
        asm volatile("s_waitcnt vmcnt(0)" ::: "memory");
        if ((threadIdx.x & 63) == 0) (void)__hip_atomic_fetch_add(cnt + u.pm * HIDCNT_STRIDE, 1u, RLX_AGENT);
    }
};
struct PairOrder11 {
    static constexpr bool WAITS = true, SIGNALS = false;
    const int* tileb; gu32* cnt; gu32* tmo; int nunits, G, c, full, R, off;
    __device__ __forceinline__ void init(int nunits_, int G_, int c_) { nunits = nunits_; G = G_; c = c_; full = nunits / G; R = nunits - full * G; off = (2 * R <= G) ? R : 0; }
    __device__ __forceinline__ bool next(int i, pg8::Unit& u) const { int L;
        if (i < full) L = i * G + c; else if (i == full && c >= off && c < off + R) L = full * G + (c - off); else return false;
        u.pm = L >> 2; u.pn = L & 3; return true; }
    __device__ __forceinline__ int brow(const pg8::Unit& u) const { const int bk = __builtin_amdgcn_readfirstlane(tileb[u.pm]); return (bk / 6) * 1024 + u.pn * 256; }
    __device__ __forceinline__ void kb(const pg8::Unit& u, int& k0, int& k1) const { const int bk = __builtin_amdgcn_readfirstlane(tileb[u.pm]); int lo, hi; pair_lohi(bk % 6, lo, hi); k0 = lo * 256; k1 = hi * 256; }
    __device__ __forceinline__ const int* rowlist() const { return nullptr; }
    __device__ __forceinline__ void a_ready(const pg8::Unit& u) const {
        if (threadIdx.x == 0) {
            gu32* w = cnt + u.pm * HIDCNT_STRIDE; unsigned sp = 0u;
            while (__hip_atomic_load(w, RLX_AGENT) < (unsigned)HIDCNT_FULL) { __builtin_amdgcn_s_sleep(1);
                if ((++sp & 255u) == 0u) { if (__hip_atomic_load(tmo, RLX_AGENT)) break; if (sp > XB_SPIN_CAP) { (void)__hip_atomic_fetch_add(tmo, 1u, RLX_AGENT); break; } } }
            __builtin_amdgcn_fence(__ATOMIC_ACQUIRE, "agent");
            asm volatile("s_waitcnt vmcnt(0)" ::: "memory");
        }
        __builtin_amdgcn_s_barrier(); asm volatile("" ::: "memory");
    }
    __device__ __forceinline__ void done(const pg8::Unit&) const {}
};
struct EpiHid {
    static constexpr bool PERM = true;
    unsigned char* H; const float* cw;
    __device__ __forceinline__ void operator()(const pg8::f32x4 (&acc)[2][2][4][2], const pg8::Unit& u, int wr_, int wc_, int fr_, int fq_) const {
        int t_ = threadIdx.x; asm volatile("" : "+v"(t_));
        const int wid_ = __builtin_amdgcn_readfirstlane(t_ >> 6), wr = wid_ >> 2, wc = wid_ & 3, fr = t_ & 15, fq = (t_ & 63) >> 4; (void)wr_; (void)wc_; (void)fr_; (void)fq_;
        const int sl = u.pn >> 1; const int col0 = sl * 256 + (u.pn & 1) * 128 + wc * 32 + 8 * fq;
#pragma unroll
        for (int ai = 0; ai < 2; ++ai)
#pragma unroll
            for (int m = 0; m < 4; ++m) { const int pos = u.pm * 256 + ai * 128 + wr * 64 + m * 16 + fr; const float w = cw[(size_t)pos * 2 + sl] * 16.f;
                const pg8::f32x4 g0 = acc[ai][0][m][0], g1 = acc[ai][0][m][1], u0 = acc[ai][1][m][0], u1 = acc[ai][1][m][1];
                float h[8];
#pragma unroll
                for (int j = 0; j < 4; ++j) { h[j] = g0[j] * __builtin_amdgcn_rcpf(1.f + __expf(-g0[j])) * u0[j] * w; h[4 + j] = g1[j] * __builtin_amdgcn_rcpf(1.f + __expf(-g1[j])) * u1[j] * w; }
                int q0 = __builtin_amdgcn_cvt_pk_fp8_f32(h[0], h[1], 0, false); q0 = __builtin_amdgcn_cvt_pk_fp8_f32(h[2], h[3], q0, true);
                int q1 = __builtin_amdgcn_cvt_pk_fp8_f32(h[4], h[5], 0, false); q1 = __builtin_amdgcn_cvt_pk_fp8_f32(h[6], h[7], q1, true);
                __hip_atomic_store((gu64*)(H + (size_t)pos * 512 + col0), ((unsigned long long)(unsigned)q1 << 32) | (unsigned long long)(unsigned)q0, RLX_AGENT); }
    }
};
constexpr size_t WS_XBUF = 5 * MiB, XBUF_BYTES = (size_t)MAXPOS * 4 * 8;
struct EpiFinal {
    static constexpr bool PERM = true;
    const int* rl; const float* gt; const pg8::bf16_t* x1; float* out; const float* gf; unsigned long long* xbuf; LAS unsigned char* xl;
    __device__ __forceinline__ void operator()(const pg8::f32x4 (&acc)[2][2][4][2], const pg8::Unit& u, int wr_, int wc_, int fr_, int fq_) const {
        int t_ = threadIdx.x; asm volatile("" : "+v"(t_));
        const int wid_ = __builtin_amdgcn_readfirstlane(t_ >> 6), wr = wid_ >> 2, wc = wid_ & 3, fr = t_ & 15, fq = (t_ & 63) >> 4; (void)wr_; (void)wc_; (void)fr_; (void)fq_;
        LAS float* Pl = (LAS float*)xl; LAS float* Sl = (LAS float*)(xl + 4096);
        const int col0 = u.pn * 256 + wc * 32 + 8 * fq;
        pg8::f32x4 v[2][2][4][2]; int tok[2][4];
#pragma unroll
        for (int ai = 0; ai < 2; ++ai) {
#pragma unroll
            for (int m = 0; m < 4; ++m) tok[ai][m] = rl[u.pm * 256 + ai * 128 + wr * 64 + m * 16 + fr];
#pragma unroll
            for (int m = 0; m < 4; ++m) { const int t = tok[ai][m]; float s = 0.f;
                if (t >= 0) { const float* g = gt + (size_t)(t / SEQ) * NMOD + col0; const pg8::bf16_t* o = x1 + (size_t)t * 2048 + col0;
#pragma unroll
                    for (int bj = 0; bj < 2; ++bj) { const pg8::f32x4 g0 = *(const pg8::f32x4*)(g + bj * 128), g1 = *(const pg8::f32x4*)(g + bj * 128 + 4); const pg8::u32x4 xv = *(const pg8::u32x4*)(o + bj * 128);
                        const pg8::f32x4 a0 = acc[ai][bj][m][0], a1 = acc[ai][bj][m][1];
                        const pg8::f32x4 y0 = {bfl(xv.x) + g0[0] * a0[0], bfh(xv.x) + g0[1] * a0[1], bfl(xv.y) + g0[2] * a0[2], bfh(xv.y) + g0[3] * a0[3]};
                        const pg8::f32x4 y1 = {bfl(xv.z) + g1[0] * a1[0], bfh(xv.z) + g1[1] * a1[1], bfl(xv.w) + g1[2] * a1[2], bfh(xv.w) + g1[3] * a1[3]};
                        v[ai][bj][m][0] = y0; v[ai][bj][m][1] = y1;
                        s += (y0[0] * y0[0] + y0[1] * y0[1]) + (y0[2] * y0[2] + y0[3] * y0[3]) + (y1[0] * y1[0] + y1[1] * y1[1]) + (y1[2] * y1[2] + y1[3] * y1[3]); } }
                else {
#pragma unroll
                    for (int bj = 0; bj < 2; ++bj) { v[ai][bj][m][0] = (pg8::f32x4){0.f, 0.f, 0.f, 0.f}; v[ai][bj][m][1] = (pg8::f32x4){0.f, 0.f, 0.f, 0.f}; } }
                s += __shfl_xor(s, 16); s += __shfl_xor(s, 32);
                if (fq == 0) Pl[(ai * 128 + wr * 64 + m * 16 + fr) * 4 + wc] = s; }
        }
        asm volatile("s_waitcnt lgkmcnt(0)" ::: "memory"); __builtin_amdgcn_s_barrier(); asm volatile("" ::: "memory");
        if (t_ < 256) {
            const float ps = (Pl[t_ * 4 + 0] + Pl[t_ * 4 + 1]) + (Pl[t_ * 4 + 2] + Pl[t_ * 4 + 3]);
            unsigned long long* slot = xbuf + (size_t)(u.pm * 256 + t_) * 4;
            __hip_atomic_store(slot + u.pn, (1ull << 32) | (unsigned long long)__float_as_uint(ps), __ATOMIC_RELAXED, __HIP_MEMORY_SCOPE_AGENT);
            float tot = 0.f;
            for (unsigned sp = 0; sp < (1u << 16); ++sp) {
                const unsigned long long g0 = __hip_atomic_load(slot + 0, __ATOMIC_RELAXED, __HIP_MEMORY_SCOPE_AGENT), g1 = __hip_atomic_load(slot + 1, __ATOMIC_RELAXED, __HIP_MEMORY_SCOPE_AGENT),
                                         g2 = __hip_atomic_load(slot + 2, __ATOMIC_RELAXED, __HIP_MEMORY_SCOPE_AGENT), g3 = __hip_atomic_load(slot + 3, __ATOMIC_RELAXED, __HIP_MEMORY_SCOPE_AGENT);
                tot = (__uint_as_float((unsigned)g0) + __uint_as_float((unsigned)g1)) + (__uint_as_float((unsigned)g2) + __uint_as_float((unsigned)g3));
                if (((g0 >> 32) & (g1 >> 32) & (g2 >> 32) & (g3 >> 32)) == 1ull) break;
                __builtin_amdgcn_s_sleep(2);
            }
            Sl[t_] = rsqrtf(tot * (1.f / D) + EPS);
        }
        asm volatile("s_waitcnt vmcnt(0) lgkmcnt(0)" ::: "memory"); __builtin_amdgcn_s_barrier(); asm volatile("" ::: "memory");
#pragma unroll
        for (int ai = 0; ai < 2; ++ai)
#pragma unroll
            for (int m = 0; m < 4; ++m) { const int t = tok[ai][m];
                if (t >= 0) { const float rstd = Sl[ai * 128 + wr * 64 + m * 16 + fr]; float* o = out + (size_t)t * D + col0;
#pragma unroll
                    for (int bj = 0; bj < 2; ++bj) { const pg8::f32x4 f0 = *(const pg8::f32x4*)(gf + col0 + bj * 128), f1 = *(const pg8::f32x4*)(gf + col0 + bj * 128 + 4);
                        *(pg8::f32x4*)(o + bj * 128) = v[ai][bj][m][0] * rstd * f0; *(pg8::f32x4*)(o + bj * 128 + 4) = v[ai][bj][m][1] * rstd * f1; } } }
        asm volatile("s_waitcnt lgkmcnt(0)" ::: "memory"); __builtin_amdgcn_s_barrier(); asm volatile("" ::: "memory");
    }
};
constexpr int SWA_KP = 144, SWA_VP = 520, SWA_OP = 144;
constexpr int SWA_KS = 0, SWA_VT = 256 * SWA_KP, SWA_OS = SWA_VT + 64 * SWA_VP, SWA_LDS = SWA_OS + 8 * 32 * SWA_OP;
static_assert(SWA_LDS <= RING_BYTES, "swa lds");
__device__ __forceinline__ float fast_sigmoid(float x) { return __builtin_amdgcn_rcpf(1.f + __expf(-x)); }

__device__ __forceinline__ void p6_swa_merge(Frame& F0, bf16* P, bf16* Mg, const bf16* OA, const float* sink) {
    Frame F = F0; { int t__ = threadIdx.x; asm volatile("" : "+v"(t__)); F.tid = t__; F.lane = t__ & 63; F.wave = __builtin_amdgcn_readfirstlane(t__ >> 6); }
    const int lane = F.lane, w = F.wave, q = lane & 31, h = lane >> 5, tid = F.tid;
    LAS unsigned char* Ks = F.lds + RING_OFF + SWA_KS;
    LAS unsigned char* Vt = F.lds + RING_OFF + SWA_VT;
    LAS unsigned char* Os = F.lds + RING_OFF + SWA_OS + w * (32 * SWA_OP);
    constexpr float L2E = 1.4426950408889634f, CS = 0.125f * L2E;
    for (int unit = blockIdx.x; unit < NB * 64 * 2; unit += F.G) {
        const int hk = unit & 1, qb = (unit >> 1) & 63, b = unit >> 7;
        const int t0 = qb * 128; const size_t rowbase = (size_t)b * SEQ;
        LDS_BARRIER();
        {
        {
            const int pc = tid & 7;
            v4u kv[4], vv[4];
#pragma unroll
            for (int i = 0; i < 4; ++i) { const int kr = (tid >> 3) + 64 * i; int tp = t0 - 128 + kr; tp = tp < 0 ? 0 : tp;
                const bf16* src = P + (rowbase + tp) * PWB;
                kv[i] = *(const v4u*)(src + PE_KB + hk * 64 + pc * 8); vv[i] = *(const v4u*)(src + PE_VB + hk * 64 + pc * 8); }
#pragma unroll
            for (int i = 0; i < 4; ++i) { const int kr = (tid >> 3) + 64 * i;
                *(LAS v4u*)(Ks + kr * SWA_KP + pc * 16) = kv[i];
                const unsigned wds[4] = {vv[i].x, vv[i].y, vv[i].z, vv[i].w};
#pragma unroll
                for (int e = 0; e < 4; ++e) { const int d = pc * 8 + e * 2;
                    *(LAS unsigned short*)(Vt + d * SWA_VP + kr * 2) = (unsigned short)(wds[e] & 0xffffu);
                    *(LAS unsigned short*)(Vt + (d + 1) * SWA_VP + kr * 2) = (unsigned short)(wds[e] >> 16); }
            }
        }
        }
        LDS_BARRIER();
        const int head = hk * 8 + w; const float snk = sink[head] * L2E;
        bf16x8 qf_n[4];
        { const bf16* qp = P + (rowbase + t0 + q) * PWB + PE_QB + head * 64 + 8 * h;
#pragma unroll
          for (int kk = 0; kk < 4; ++kk) qf_n[kk] = *(const bf16x8*)(qp + 16 * kk); }
        for (int sb = 0; sb < 4; ++sb) {
            const int q0 = t0 + 32 * sb;
            bf16x8 qf[4];
#pragma unroll
            for (int kk = 0; kk < 4; ++kk) qf[kk] = qf_n[kk];
            const int mq = lane >> 3, mp8 = lane & 7; const size_t mrow = rowbase + q0 + mq; const int mcol = head * 64 + 8 * mp8;
            u32x2 gav[4], gbv[4]; v4u oav[4];
#pragma unroll
            for (int i = 0; i < 4; ++i) { const size_t r = mrow + 8 * i;
                gav[i] = *(const u32x2*)((const unsigned char*)(P + r * PWB) + PC_GA + mcol); gbv[i] = *(const u32x2*)((const unsigned char*)(P + r * PWB) + PC_GB + mcol); oav[i] = *(const v4u*)(OA + r * D + mcol); }
            if (sb < 3) { const bf16* qp = P + (rowbase + q0 + 32 + q) * PWB + PE_QB + head * 64 + 8 * h;
#pragma unroll
                for (int kk = 0; kk < 4; ++kk) qf_n[kk] = *(const bf16x8*)(qp + 16 * kk); }
            f32x16 O0, O1; float inv;
            {
            f32x16 S[5];
#pragma unroll
            for (int kt = 0; kt < 5; ++kt) {
                f32x16 acc = {0.f, 0.f, 0.f, 0.f, 0.f, 0.f, 0.f, 0.f, 0.f, 0.f, 0.f, 0.f, 0.f, 0.f, 0.f, 0.f};
#pragma unroll
                for (int kk = 0; kk < 4; ++kk) { const bf16x8 a = *(const LAS bf16x8*)(Ks + (32 * (sb + kt) + q) * SWA_KP + (16 * kk + 8 * h) * 2);
                    acc = __builtin_amdgcn_mfma_f32_32x32x16_bf16(a, qf[kk], acc, 0, 0, 0); }
                S[kt] = acc;
            }
            float mx = snk;
#pragma unroll
            for (int kt = 0; kt < 5; ++kt)
#pragma unroll
                for (int r = 0; r < 16; ++r) { const int kin = (r & 3) + 8 * (r >> 2) + 4 * h;
                    bool ok = (q0 - 128 + 32 * kt + kin) >= 0;
                    if (kt == 0) ok = ok && (kin > q);
                    if (kt == 4) ok = ok && (kin <= q);
                    const float v = ok ? S[kt][r] * CS : -1.0e30f; S[kt][r] = v; mx = fmaxf(mx, v); }
            mx = fmaxf(mx, __shfl_xor(mx, 32));
            float sum = 0.f;
#pragma unroll
            for (int kt = 0; kt < 5; ++kt)
#pragma unroll
                for (int r = 0; r < 16; ++r) { const float p = __builtin_amdgcn_exp2f(S[kt][r] - mx); S[kt][r] = p; sum += p; }
            sum += __shfl_xor(sum, 32); sum += __builtin_amdgcn_exp2f(snk - mx);
            inv = 1.f / sum;
            O0 = (f32x16){0.f, 0.f, 0.f, 0.f, 0.f, 0.f, 0.f, 0.f, 0.f, 0.f, 0.f, 0.f, 0.f, 0.f, 0.f, 0.f}; O1 = O0;
#pragma unroll
            for (int kt = 0; kt < 5; ++kt)
#pragma unroll
                for (int s = 0; s < 2; ++s) {
                    v4u pw; pw.x = pg8::cvt_pk_bf16(S[kt][8 * s + 0], S[kt][8 * s + 1]); pw.y = pg8::cvt_pk_bf16(S[kt][8 * s + 2], S[kt][8 * s + 3]);
                    pw.z = pg8::cvt_pk_bf16(S[kt][8 * s + 4], S[kt][8 * s + 5]); pw.w = pg8::cvt_pk_bf16(S[kt][8 * s + 6], S[kt][8 * s + 7]);
                    const bf16x8 pf = __builtin_bit_cast(bf16x8, pw);
                    const int kidx = 32 * (sb + kt) + 16 * s + 4 * h;
                    const u32x2 a0l = *(const LAS u32x2*)(Vt + q * SWA_VP + kidx * 2), a0h = *(const LAS u32x2*)(Vt + q * SWA_VP + (kidx + 8) * 2);
                    const u32x2 a1l = *(const LAS u32x2*)(Vt + (q + 32) * SWA_VP + kidx * 2), a1h = *(const LAS u32x2*)(Vt + (q + 32) * SWA_VP + (kidx + 8) * 2);
                    const v4u a0 = {a0l.x, a0l.y, a0h.x, a0h.y}, a1 = {a1l.x, a1l.y, a1h.x, a1h.y};
                    O0 = __builtin_amdgcn_mfma_f32_32x32x16_bf16(__builtin_bit_cast(bf16x8, a0), pf, O0, 0, 0, 0);
                    O1 = __builtin_amdgcn_mfma_f32_32x32x16_bf16(__builtin_bit_cast(bf16x8, a1), pf, O1, 0, 0, 0);
                }
            asm volatile("" : "+v"(O0), "+v"(O1));
            }
#pragma unroll
            for (int g4 = 0; g4 < 4; ++g4) {
                u32x2 o0, o1;
                o0.x = pg8::cvt_pk_bf16(O0[4 * g4 + 0] * inv, O0[4 * g4 + 1] * inv); o0.y = pg8::cvt_pk_bf16(O0[4 * g4 + 2] * inv, O0[4 * g4 + 3] * inv);
                o1.x = pg8::cvt_pk_bf16(O1[4 * g4 + 0] * inv, O1[4 * g4 + 1] * inv); o1.y = pg8::cvt_pk_bf16(O1[4 * g4 + 2] * inv, O1[4 * g4 + 3] * inv);
                *(LAS u32x2*)(Os + q * SWA_OP + (8 * g4 + 4 * h) * 2) = o0;
                *(LAS u32x2*)(Os + q * SWA_OP + (32 + 8 * g4 + 4 * h) * 2) = o1;
            }
            asm volatile("s_waitcnt lgkmcnt(0)" ::: "memory");
            {
#pragma unroll
                for (int i = 0; i < 4; ++i) {
                    const v4u ob = *(const LAS v4u*)(Os + (mq + 8 * i) * SWA_OP + mp8 * 16), oa = oav[i]; const u32x2 ga = gav[i], gb = gbv[i];
                    float sa[8], sb[8]; constexpr float I255 = 1.f / 255.f;
#pragma unroll
                    for (int j = 0; j < 4; ++j) { sa[j] = (float)((ga.x >> (8 * j)) & 0xffu) * I255; sa[4 + j] = (float)((ga.y >> (8 * j)) & 0xffu) * I255;
                                                  sb[j] = (float)((gb.x >> (8 * j)) & 0xffu) * I255; sb[4 + j] = (float)((gb.y >> (8 * j)) & 0xffu) * I255; }
                    v4u o;
                    o.x = pg8::cvt_pk_bf16(sa[0] * bfl(oa.x) + sb[0] * bfl(ob.x), sa[1] * bfh(oa.x) + sb[1] * bfh(ob.x));
                    o.y = pg8::cvt_pk_bf16(sa[2] * bfl(oa.y) + sb[2] * bfl(ob.y), sa[3] * bfh(oa.y) + sb[3] * bfh(ob.y));
                    o.z = pg8::cvt_pk_bf16(sa[4] * bfl(oa.z) + sb[4] * bfl(ob.z), sa[5] * bfh(oa.z) + sb[5] * bfh(ob.z));
                    o.w = pg8::cvt_pk_bf16(sa[6] * bfl(oa.w) + sb[6] * bfl(ob.w), sa[7] * bfh(oa.w) + sb[7] * bfh(ob.w));
                    *(v4u*)(Mg + (mrow + 8 * i) * D + mcol) = o;
                }
            }
            asm volatile("s_waitcnt lgkmcnt(0)" ::: "memory");
        }
    }
}
constexpr int GLA_SC = 256, GLA_NSC = SEQ / GLA_SC, GLA_UNITS = NB * GLA_NSC * 4;
constexpr size_t OUT_ST = 0, OUT_DEC = 32 * MiB, OUT_OA = 64 * MiB;
constexpr int G3_ZT = 0, G3_KRAW = 2048, G3_TOT = G3_KRAW + 32 * 272, G3_BT = G3_TOT + 2048, G3_KTE = G3_BT + 16384, G3_VT = G3_KTE + 128 * 80, G3_DEC = G3_VT + 256 * 80, G3_END = G3_DEC + 512;
static_assert(G3_END <= RING_BYTES, "gla p3 lds");
constexpr int G5_KT = 0, G5_VT = 32 * 272, G5_OS = 32768, G5_ST = 32768, G5_END = G5_ST + 65536;
static_assert(G5_VT + 256 * 80 <= G5_OS && G5_OS + 8 * 32 * 144 <= G5_END && G5_END <= RING_BYTES, "gla p5 lds");

__device__ __forceinline__ unsigned pk_bf16(float lo, float hi) { return pg8::cvt_pk_bf16(lo, hi); }

__device__ __forceinline__ void p3_gla_upd(Frame& F0, bf16* P, const float* w_gk2, const float* b_gk, unsigned char* outb) {
    Frame F = F0; { int t__ = threadIdx.x; asm volatile("" : "+v"(t__)); F.tid = t__; F.lane = t__ & 63; F.wave = __builtin_amdgcn_readfirstlane(t__ >> 6); }
    const int tid = F.tid, lane = F.lane, w = F.wave;
    LAS unsigned char* L = F.lds + RING_OFF;
    LAS float* zt = (LAS float*)(L + G3_ZT); LAS unsigned char* kraw = L + G3_KRAW; LAS float* tot = (LAS float*)(L + G3_TOT); LAS float* bt = (LAS float*)(L + G3_BT);
    LAS unsigned char* kte = L + G3_KTE; LAS unsigned char* vt_ = L + G3_VT; LAS float* decl = (LAS float*)(L + G3_DEC);
    bf16* ST = (bf16*)(outb + OUT_ST); float* DEC = (float*)(outb + OUT_DEC);
    const int gk = tid & 127, gq = tid >> 7;
    const int rt = tid >> 4, rq = tid & 15;
    const int vp = tid & 127;
    const int ktile = w >> 1, vt0 = 4 * (w & 1), vl = lane & 31, hh = lane >> 5;
    constexpr float QS = 0.08838834764831845f;
    for (int unit = blockIdx.x; unit < GLA_UNITS; unit += F.G) {
        const int head = unit & 3, sc = (unit >> 2) & 31, b = unit >> 7;
        const size_t row0 = (size_t)b * SEQ + (size_t)sc * GLA_SC;
        float wreg[16];
#pragma unroll
        for (int r = 0; r < 16; ++r) wreg[r] = w_gk2[r * 512 + head * 128 + gk];
        const float bias = b_gk[head * 128 + gk];
        float carry = 0.f;
        f32x16 acc[4];
#pragma unroll
        for (int i = 0; i < 4; ++i) acc[i] = (f32x16){0.f, 0.f, 0.f, 0.f, 0.f, 0.f, 0.f, 0.f, 0.f, 0.f, 0.f, 0.f, 0.f, 0.f, 0.f, 0.f};
        v4u qraw_n, kr_n; unsigned short z_n; unsigned vraw_n[8];
        { const size_t trow = row0;
          qraw_n = *(const v4u*)(P + (trow + rt) * PWB + PE_QA + head * 128 + 8 * rq); kr_n = *(const v4u*)(P + (trow + rt) * PWB + PE_KA + head * 128 + 8 * rq);
          z_n = P[(trow + rt) * PWB + PE_Z + rq];
#pragma unroll
          for (int c = 0; c < 8; ++c) vraw_n[c] = *(const unsigned*)(P + (trow + 8 * gq + c) * PWB + PE_VA + head * 256 + 2 * vp); }
        for (int st = 0; st < 8; ++st) {
            const size_t trow = row0 + 32 * st;
            bf16* qptr = P + (trow + rt) * PWB + PE_QA + head * 128 + 8 * rq; bf16* kptr = P + (trow + rt) * PWB + PE_KA + head * 128 + 8 * rq;
            const v4u qraw = qraw_n, kr = kr_n;
            const float zval = __uint_as_float(((unsigned)z_n) << 16);
            unsigned vraw[8];
#pragma unroll
            for (int c = 0; c < 8; ++c) vraw[c] = vraw_n[c];
            if (st < 7) { const size_t nrow = trow + 32;
                qraw_n = *(const v4u*)(P + (nrow + rt) * PWB + PE_QA + head * 128 + 8 * rq); kr_n = *(const v4u*)(P + (nrow + rt) * PWB + PE_KA + head * 128 + 8 * rq);
                z_n = P[(nrow + rt) * PWB + PE_Z + rq];
#pragma unroll
                for (int c = 0; c < 8; ++c) vraw_n[c] = *(const unsigned*)(P + (nrow + 8 * gq + c) * PWB + PE_VA + head * 256 + 2 * vp); }
            LDS_BARRIER();
            *(LAS v4u*)(kraw + rt * 272 + rq * 16) = kr;
            zt[rt * 16 + rq] = zval;
            LDS_BARRIER();
            float cs[8]; float cum = 0.f;
#pragma unroll
            for (int c = 0; c < 8; ++c) { float x = bias; const LAS float* zr = zt + (8 * gq + c) * 16;
#pragma unroll
                for (int r = 0; r < 16; ++r) x += zr[r] * wreg[r];
                const float ls = fminf(x, 0.f) - __logf(1.f + __expf(-fabsf(x)));
                cum += ls * 0.0625f; cs[c] = cum; }
            tot[gq * 128 + gk] = cum;
            LDS_BARRIER();
            {
                const float t0 = tot[gk], t1 = tot[128 + gk], t2 = tot[256 + gk], t3 = tot[384 + gk];
                const float prefix = (gq > 0 ? t0 : 0.f) + (gq > 1 ? t1 : 0.f) + (gq > 2 ? t2 : 0.f), ttot = (t0 + t1) + (t2 + t3);
                float kv[8];
#pragma unroll
                for (int c = 0; c < 8; ++c) { const int t = 8 * gq + c; bt[t * 128 + gk] = carry + prefix + cs[c];
                    const float kx = __uint_as_float(((unsigned)*(const LAS unsigned short*)(kraw + t * 272 + gk * 2)) << 16);
                    kv[c] = kx * __expf(ttot - prefix - cs[c]); }
                v4u ko; ko.x = pk_bf16(kv[0], kv[1]); ko.y = pk_bf16(kv[2], kv[3]); ko.z = pk_bf16(kv[4], kv[5]); ko.w = pk_bf16(kv[6], kv[7]);
                *(LAS v4u*)(kte + gk * 80 + gq * 16) = ko;
                if (gq == 0) decl[gk] = __expf(ttot);
                carry += ttot;
                v4u v0, v1;
                v0.x = (vraw[0] & 0xffffu) | (vraw[1] << 16); v0.y = (vraw[2] & 0xffffu) | (vraw[3] << 16); v0.z = (vraw[4] & 0xffffu) | (vraw[5] << 16); v0.w = (vraw[6] & 0xffffu) | (vraw[7] << 16);
                v1.x = (vraw[0] >> 16) | (vraw[1] & 0xffff0000u); v1.y = (vraw[2] >> 16) | (vraw[3] & 0xffff0000u); v1.z = (vraw[4] >> 16) | (vraw[5] & 0xffff0000u); v1.w = (vraw[6] >> 16) | (vraw[7] & 0xffff0000u);
                *(LAS v4u*)(vt_ + (2 * vp) * 80 + gq * 16) = v0;
                *(LAS v4u*)(vt_ + (2 * vp + 1) * 80 + gq * 16) = v1;
            }
            LDS_BARRIER();
            {
#pragma unroll
                for (int g4 = 0; g4 < 4; ++g4) { const f32x4 d4 = *(const LAS f32x4*)(decl + 32 * ktile + 8 * g4 + 4 * hh);
#pragma unroll
                    for (int i = 0; i < 4; ++i) { acc[i][4 * g4 + 0] *= d4.x; acc[i][4 * g4 + 1] *= d4.y; acc[i][4 * g4 + 2] *= d4.z; acc[i][4 * g4 + 3] *= d4.w; } }
#pragma unroll
                for (int s = 0; s < 2; ++s) {
                    const bf16x8 a = *(const LAS bf16x8*)(kte + (32 * ktile + vl) * 80 + (16 * s + 8 * hh) * 2);
#pragma unroll
                    for (int i = 0; i < 4; ++i) { const bf16x8 bb = *(const LAS bf16x8*)(vt_ + (32 * (vt0 + i) + vl) * 80 + (16 * s + 8 * hh) * 2);
                        acc[i] = __builtin_amdgcn_mfma_f32_32x32x16_bf16(a, bb, acc[i], 0, 0, 0); }
                }
                const f32x4 b0 = *(const LAS f32x4*)(bt + rt * 128 + 8 * rq), b1 = *(const LAS f32x4*)(bt + rt * 128 + 8 * rq + 4);
                const float bb8[8] = {b0.x, b0.y, b0.z, b0.w, b1.x, b1.y, b1.z, b1.w};
                const unsigned qw[4] = {qraw.x, qraw.y, qraw.z, qraw.w}, kw[4] = {kr.x, kr.y, kr.z, kr.w};
                unsigned qo[4], ko[4];
#pragma unroll
                for (int e = 0; e < 4; ++e) {
                    qo[e] = pk_bf16(bfl(qw[e]) * QS * __expf(bb8[2 * e]), bfh(qw[e]) * QS * __expf(bb8[2 * e + 1]));
                    ko[e] = pk_bf16(bfl(kw[e]) * __expf(-bb8[2 * e]), bfh(kw[e]) * __expf(-bb8[2 * e + 1])); }
                *(v4u*)qptr = (v4u){qo[0], qo[1], qo[2], qo[3]};
                *(v4u*)kptr = (v4u){ko[0], ko[1], ko[2], ko[3]};
            }
        }
        bf16* stu = ST + (size_t)unit * 32768;
#pragma unroll
        for (int i = 0; i < 4; ++i)
#pragma unroll
            for (int g4 = 0; g4 < 4; ++g4) {
                const int kk = 2 * ktile + (g4 >> 1), fh = g4 & 1;
                u32x2 o; o.x = pk_bf16(acc[i][4 * g4 + 0], acc[i][4 * g4 + 1]); o.y = pk_bf16(acc[i][4 * g4 + 2], acc[i][4 * g4 + 3]);
                *(u32x2*)(stu + ((((vt0 + i) * 8 + kk) * 64 + fh * 32 + vl) * 8 + 4 * hh)) = o;
            }
        if (gq == 0) DEC[unit * 128 + gk] = __expf(carry);
    }
}

__device__ __forceinline__ void p4_gla_scan(Frame& F0, unsigned char* outb) {
    Frame F = F0; { int t__ = threadIdx.x; asm volatile("" : "+v"(t__)); F.tid = t__; F.lane = t__ & 63; F.wave = __builtin_amdgcn_readfirstlane(t__ >> 6); }
    bf16* ST = (bf16*)(outb + OUT_ST); const float* DEC = (const float*)(outb + OUT_DEC);
    for (int gt = blockIdx.x * (NWAVES * 64) + F.tid; gt < 16 * 8192; gt += F.G * NWAVES * 64) {
        const int pair = gt >> 13, e4 = gt & 8191, b = pair >> 2, head = pair & 3;
        const int Ln = (e4 >> 1) & 63, kk = (e4 >> 7) & 7, k0 = 16 * kk + 8 * (Ln >> 5) + 4 * (e4 & 1);
        const size_t ub0 = (size_t)(b * 32 * 4 + head);
        float s0 = 0.f, s1 = 0.f, s2 = 0.f, s3 = 0.f;
        u32x2 uq[4]; f32x4 dq[4];
#pragma unroll
        for (int i = 0; i < 4; ++i) { uq[i] = *(const u32x2*)(ST + (ub0 + 4 * i) * 32768 + 4 * e4); dq[i] = *(const f32x4*)(DEC + (ub0 + 4 * i) * 128 + k0); }
        for (int sc = 0; sc < GLA_NSC; sc += 4) {
#pragma unroll
            for (int i = 0; i < 4; ++i) {
                const size_t ub = ub0 + 4 * (sc + i);
                const u32x2 u = uq[i]; const f32x4 d = dq[i];
                if (sc + 4 < GLA_NSC) { uq[i] = *(const u32x2*)(ST + (ub + 16) * 32768 + 4 * e4); dq[i] = *(const f32x4*)(DEC + (ub + 16) * 128 + k0); }
                u32x2 o; o.x = pk_bf16(s0, s1); o.y = pk_bf16(s2, s3);
                *(u32x2*)(ST + ub * 32768 + 4 * e4) = o;
                s0 = d.x * s0 + bfl(u.x); s1 = d.y * s1 + bfh(u.x); s2 = d.z * s2 + bfl(u.y); s3 = d.w * s3 + bfh(u.y);
            }
        }
    }
}

__device__ __forceinline__ void p5_gla_out(Frame& F0, const bf16* P, const float* gng, unsigned char* outb) {
    Frame F = F0; { int t__ = threadIdx.x; asm volatile("" : "+v"(t__)); F.tid = t__; F.lane = t__ & 63; F.wave = __builtin_amdgcn_readfirstlane(t__ >> 6); }
    const int tid = F.tid, lane = F.lane, w = F.wave, vl = lane & 31, hh = lane >> 5;
    LAS unsigned char* L = F.lds + RING_OFF;
    LAS unsigned char* Kt = L + G5_KT; LAS unsigned char* Vt = L + G5_VT; LAS unsigned char* Os = L + G5_OS + w * (32 * 144);
    const bf16* ST = (const bf16*)(outb + OUT_ST); bf16* OA = (bf16*)(outb + OUT_OA);
    const int rt = tid >> 4, rq = tid & 15, vp = tid & 127, gq = tid >> 7;
    for (int unit = blockIdx.x; unit < GLA_UNITS; unit += F.G) {
        const int head = unit & 3, sc = (unit >> 2) & 31, b = unit >> 7;
        const size_t row0 = (size_t)b * SEQ + (size_t)sc * GLA_SC;
        bf16x8 qf[8];
        { const bf16* qp = P + (row0 + 32 * w + vl) * PWB + PE_QA + head * 128 + 8 * hh;
#pragma unroll
          for (int kk = 0; kk < 8; ++kk) qf[kk] = *(const bf16x8*)(qp + 16 * kk); }
        f32x16 acc[8];
        { const v4u* stg = (const v4u*)(ST + (size_t)unit * 32768) + tid; v4u sv[8];
#pragma unroll
          for (int i = 0; i < 8; ++i) sv[i] = stg[i * 512];
          LDS_BARRIER();
#pragma unroll
          for (int i = 0; i < 8; ++i) *(LAS v4u*)(L + G5_ST + (tid + i * 512) * 16) = sv[i];
          LDS_BARRIER();
#pragma unroll
          for (int vt = 0; vt < 8; ++vt) { f32x16 a16 = {0.f, 0.f, 0.f, 0.f, 0.f, 0.f, 0.f, 0.f, 0.f, 0.f, 0.f, 0.f, 0.f, 0.f, 0.f, 0.f};
#pragma unroll
              for (int kk = 0; kk < 8; ++kk) { const bf16x8 a = *(const LAS bf16x8*)(L + G5_ST + ((vt * 8 + kk) * 64 + lane) * 16); a16 = __builtin_amdgcn_mfma_f32_32x32x16_bf16(a, qf[kk], a16, 0, 0, 0); }
              acc[vt] = a16; } }
        v4u kr_n; unsigned vraw_n[8];
        { kr_n = *(const v4u*)(P + (row0 + rt) * PWB + PE_KA + head * 128 + 8 * rq);
#pragma unroll
          for (int c = 0; c < 8; ++c) vraw_n[c] = *(const unsigned*)(P + (row0 + 8 * gq + c) * PWB + PE_VA + head * 256 + 2 * vp); }
        for (int jt = 0; jt < 8; ++jt) {
            const v4u kr = kr_n; unsigned vraw[8];
#pragma unroll
            for (int c = 0; c < 8; ++c) vraw[c] = vraw_n[c];
            if (jt < 7) { const size_t nrow = row0 + 32 * (jt + 1);
                kr_n = *(const v4u*)(P + (nrow + rt) * PWB + PE_KA + head * 128 + 8 * rq);
#pragma unroll
                for (int c = 0; c < 8; ++c) vraw_n[c] = *(const unsigned*)(P + (nrow + 8 * gq + c) * PWB + PE_VA + head * 256 + 2 * vp); }
            LDS_BARRIER();
            *(LAS v4u*)(Kt + rt * 272 + rq * 16) = kr;
            { v4u v0, v1;
              v0.x = (vraw[0] & 0xffffu) | (vraw[1] << 16); v0.y = (vraw[2] & 0xffffu) | (vraw[3] << 16); v0.z = (vraw[4] & 0xffffu) | (vraw[5] << 16); v0.w = (vraw[6] & 0xffffu) | (vraw[7] << 16);
              v1.x = (vraw[0] >> 16) | (vraw[1] & 0xffff0000u); v1.y = (vraw[2] >> 16) | (vraw[3] & 0xffff0000u); v1.z = (vraw[4] >> 16) | (vraw[5] & 0xffff0000u); v1.w = (vraw[6] >> 16) | (vraw[7] & 0xffff0000u);
              *(LAS v4u*)(Vt + (2 * vp) * 80 + gq * 16) = v0; *(LAS v4u*)(Vt + (2 * vp + 1) * 80 + gq * 16) = v1; }
            LDS_BARRIER();
            if (w >= jt) {
                f32x16 X = {0.f, 0.f, 0.f, 0.f, 0.f, 0.f, 0.f, 0.f, 0.f, 0.f, 0.f, 0.f, 0.f, 0.f, 0.f, 0.f};
#pragma unroll
                for (int kk = 0; kk < 8; ++kk) { const bf16x8 a = *(const LAS bf16x8*)(Kt + vl * 272 + (16 * kk + 8 * hh) * 2); X = __builtin_amdgcn_mfma_f32_32x32x16_bf16(a, qf[kk], X, 0, 0, 0); }
                if (w == jt) {
#pragma unroll
                    for (int r = 0; r < 16; ++r) { const int j = (r & 3) + 8 * (r >> 2) + 4 * hh; X[r] = (j <= vl) ? X[r] : 0.f; }
                }
                bf16x8 pf[2];
#pragma unroll
                for (int s = 0; s < 2; ++s) { v4u pw; pw.x = pk_bf16(X[8 * s + 0], X[8 * s + 1]); pw.y = pk_bf16(X[8 * s + 2], X[8 * s + 3]); pw.z = pk_bf16(X[8 * s + 4], X[8 * s + 5]); pw.w = pk_bf16(X[8 * s + 6], X[8 * s + 7]);
                    pf[s] = __builtin_bit_cast(bf16x8, pw); }
#pragma unroll
                for (int vt = 0; vt < 8; ++vt)
#pragma unroll
                    for (int s = 0; s < 2; ++s) {
                        const u32x2 lo = *(const LAS u32x2*)(Vt + (32 * vt + vl) * 80 + (16 * s + 4 * hh) * 2), hi = *(const LAS u32x2*)(Vt + (32 * vt + vl) * 80 + (16 * s + 8 + 4 * hh) * 2);
                        const v4u av = {lo.x, lo.y, hi.x, hi.y};
                        acc[vt] = __builtin_amdgcn_mfma_f32_32x32x16_bf16(__builtin_bit_cast(bf16x8, av), pf[s], acc[vt], 0, 0, 0);
                    }
            }
        }
        float ssq = 0.f;
#pragma unroll
        for (int vt = 0; vt < 8; ++vt)
#pragma unroll
            for (int r = 0; r < 16; ++r) ssq += acc[vt][r] * acc[vt][r];
        ssq += __shfl_xor(ssq, 32);
        const float rstd = rsqrtf(ssq * (1.f / 256.f) + EPS);
        const int mq = lane >> 3, mp8 = lane & 7; const size_t orow = row0 + 32 * w + mq;
        u32x2 rv_n[4];
#pragma unroll
        for (int i = 0; i < 4; ++i) rv_n[i] = *(const u32x2*)((const unsigned char*)(P + (orow + 8 * i) * PWB) + head * 256 + 8 * mp8);
#pragma unroll
        for (int c = 0; c < 4; ++c) {
            u32x2 rvc[4];
#pragma unroll
            for (int i = 0; i < 4; ++i) rvc[i] = rv_n[i];
            if (c < 3) {
#pragma unroll
                for (int i = 0; i < 4; ++i) rv_n[i] = *(const u32x2*)((const unsigned char*)(P + (orow + 8 * i) * PWB) + head * 256 + 64 * (c + 1) + 8 * mp8); }
#pragma unroll
            for (int tl = 0; tl < 2; ++tl)
#pragma unroll
                for (int g4 = 0; g4 < 4; ++g4) { u32x2 o; const f32x16& A = acc[2 * c + tl];
                    o.x = pk_bf16(A[4 * g4 + 0] * rstd, A[4 * g4 + 1] * rstd); o.y = pk_bf16(A[4 * g4 + 2] * rstd, A[4 * g4 + 3] * rstd);
                    *(LAS u32x2*)(Os + vl * 144 + (32 * tl + 8 * g4 + 4 * hh) * 2) = o; }
            asm volatile("s_waitcnt lgkmcnt(0)" ::: "memory");
            const int col = head * 256 + 64 * c + 8 * mp8;
            const f32x4 g0 = *(const f32x4*)(gng + 64 * c + 8 * mp8), g1 = *(const f32x4*)(gng + 64 * c + 8 * mp8 + 4);
#pragma unroll
            for (int i = 0; i < 4; ++i) {
                const v4u ob = *(const LAS v4u*)(Os + (mq + 8 * i) * 144 + mp8 * 16); const u32x2 rv = rvc[i];
                float rr[8];
#pragma unroll
                for (int j = 0; j < 4; ++j) { rr[j] = ((float)((rv.x >> (8 * j)) & 0xffu) - 128.f) * 0.05f; rr[4 + j] = ((float)((rv.y >> (8 * j)) & 0xffu) - 128.f) * 0.05f; }
                v4u o;
                o.x = pk_bf16(bfl(ob.x) * g0.x * rr[0] * fast_sigmoid(rr[0]), bfh(ob.x) * g0.y * rr[1] * fast_sigmoid(rr[1]));
                o.y = pk_bf16(bfl(ob.y) * g0.z * rr[2] * fast_sigmoid(rr[2]), bfh(ob.y) * g0.w * rr[3] * fast_sigmoid(rr[3]));
                o.z = pk_bf16(bfl(ob.z) * g1.x * rr[4] * fast_sigmoid(rr[4]), bfh(ob.z) * g1.y * rr[5] * fast_sigmoid(rr[5]));
                o.w = pk_bf16(bfl(ob.w) * g1.z * rr[6] * fast_sigmoid(rr[6]), bfh(ob.w) * g1.w * rr[7] * fast_sigmoid(rr[7]));
                *(v4u*)(OA + (orow + 8 * i) * D + col) = o;
            }
            asm volatile("s_waitcnt lgkmcnt(0)" ::: "memory");
        }
    }
}
__device__ __forceinline__ void p0_mod_item(Frame& F0, const float* c, const float* w_ada, const float* b_ada, float* mod, int item) {
    Frame F = F0; { int t__ = threadIdx.x; asm volatile("" : "+v"(t__)); F.tid = t__; F.lane = t__ & 63; F.wave = __builtin_amdgcn_readfirstlane(t__ >> 6); }
    LAS float* sc = (LAS float*)(F.lds + RING_OFF);
    LAS float* red = (LAS float*)(F.lds + RING_OFF + 16384);
    for (int i = F.tid; i < NB * D; i += NWAVES * 64) { const float v = c[i]; sc[i] = v * __builtin_amdgcn_rcpf(1.f + __expf(-v)); }
    __syncthreads();
    const int cl = F.lane & 31, rh = F.lane >> 5, col = item * 32 + cl;
    float acc[NB] = {0.f, 0.f, 0.f, 0.f};
    const float* wp = w_ada + (size_t)(F.wave * 128 + rh) * NMOD + col;
#pragma unroll 32
    for (int i = 0; i < 64; ++i) { const float w = wp[(size_t)(2 * i) * NMOD];
#pragma unroll
        for (int b = 0; b < NB; ++b) acc[b] += sc[b * D + F.wave * 128 + 2 * i + rh] * w; }
#pragma unroll
    for (int b = 0; b < NB; ++b) { acc[b] += __shfl_xor(acc[b], 32); if (rh == 0) red[(F.wave * NB + b) * 32 + cl] = acc[b]; }
    __syncthreads();
    if (F.tid < 128) { const int b = F.tid >> 5, cc = F.tid & 31; float s = b_ada[item * 32 + cc];
#pragma unroll
        for (int w = 0; w < 8; ++w) s += red[(w * NB + b) * 32 + cc];
        mod[b * NMOD + item * 32 + cc] = s; }
    __syncthreads();
}
template <bool F8 = false>
__device__ __forceinline__ void tr_item(const float* W, int N, int k0, int n0, int nvalid, bf16* WT, size_t drow0, int dpitch, int dcol0, LAS float* scr, int lane, float wscale = 1.f) {
    const int nn = lane & 31;
    float tmp[32];
#pragma unroll
    for (int i = 0; i < 32; ++i) { const int kk = 2 * i + (lane >> 5); tmp[i] = (nn < nvalid) ? W[(size_t)(k0 + kk) * N + n0 + nn] : 0.f; }
#pragma unroll
    for (int i = 0; i < 32; ++i) { const int kk = 2 * i + (lane >> 5); scr[kk * 33 + nn] = tmp[i]; }
    LDS_WAIT(); asm volatile("" ::: "memory");
    const int c = lane & 7;
#pragma unroll
    for (int j = 0; j < 4; ++j) { const int n = (lane >> 3) + 8 * j; const LAS float* s = scr + (8 * c) * 33 + n;
        v4u o; o.x = pg8::cvt_pk_bf16(s[0 * 33], s[1 * 33]); o.y = pg8::cvt_pk_bf16(s[2 * 33], s[3 * 33]); o.z = pg8::cvt_pk_bf16(s[4 * 33], s[5 * 33]); o.w = pg8::cvt_pk_bf16(s[6 * 33], s[7 * 33]);
        if constexpr (F8) {
            int w0 = __builtin_amdgcn_cvt_pk_fp8_f32(s[0 * 33] * wscale, s[1 * 33] * wscale, 0, false); w0 = __builtin_amdgcn_cvt_pk_fp8_f32(s[2 * 33] * wscale, s[3 * 33] * wscale, w0, true);
            int w1 = __builtin_amdgcn_cvt_pk_fp8_f32(s[4 * 33] * wscale, s[5 * 33] * wscale, 0, false); w1 = __builtin_amdgcn_cvt_pk_fp8_f32(s[6 * 33] * wscale, s[7 * 33] * wscale, w1, true);
            if (n < nvalid) *(GAS u32x2*)((unsigned char*)WT + (drow0 + n) * (size_t)dpitch + dcol0 + k0 + 8 * c) = (u32x2){(unsigned)w0, (unsigned)w1};
        } else {
        if (n < nvalid) *(GAS v4u*)(WT + (drow0 + n) * (size_t)dpitch + dcol0 + k0 + 8 * c) = o; } }
    LDS_WAIT(); asm volatile("" ::: "memory");
}
__device__ __forceinline__ void p0_convert(Frame& F0, const Args& args, int part) {
    Frame F = F0; { int t__ = threadIdx.x; asm volatile("" : "+v"(t__)); F.tid = t__; F.lane = t__ & 63; F.wave = __builtin_amdgcn_readfirstlane(t__ >> 6); }
    unsigned char* ws = args.ws;
    bf16* WIN = (bf16*)(ws + WS_WIN); bf16* WO = (bf16*)(ws + WS_WO); bf16* WGU = (bf16*)(ws + WS_WGU); bf16* WD = (bf16*)(ws + WS_WD);
    const float* w_in = args.in[5]; const float* w_o = args.in[10]; const float* w_gate = args.in[16]; const float* w_up = args.in[17]; const float* w_down = args.in[18];
    LAS float* scr = (LAS float*)(F.lds + RING_OFF + 32768 + F.wave * 8704);
    const int gw = F.vcu * NWAVES + F.wave, NGW = F.G * NWAVES;
    constexpr int I0 = 16 * 201, I3 = 16 * 32, I4 = 16 * 128, I5 = 16 * 128, I6 = 16 * 128;
    constexpr int NITEMS = I0 + I3 + I4 + I5 + I6;
    bf16* WIN8 = (bf16*)(ws + WS_WIN8);
    const int it0 = part == 0 ? 0 : I0 + I3, it1 = part == 0 ? I0 + I3 : NITEMS;
    for (int it = it0 + gw; it < it1; it += NGW) {
        int r = it;
        if (r < I0) {
            const int kb = r / 201, cb = r % 201; int src, dst, nv = 32;
            if (cb < 16) { src = 32 * cb; dst = PC_QA + 32 * cb; }
            else if (cb < 32) { src = 512 + 32 * (cb - 16); dst = PC_KA + 32 * (cb - 16); }
            else if (cb < 64) { src = 1024 + 32 * (cb - 32); dst = PC_VA + 32 * (cb - 32); }
            else if (cb < 96) { src = 2048 + 32 * (cb - 64); dst = PC_RA + 32 * (cb - 64); }
            else if (cb < 97) { src = 3072; dst = PC_Z; nv = 16; }
            else if (cb < 129) { src = 3088 + 32 * (cb - 97); dst = PC_QB + 32 * (cb - 97); }
            else if (cb < 133) { src = 4112 + 32 * (cb - 129); dst = PC_KB + 32 * (cb - 129); }
            else if (cb < 137) { src = 4240 + 32 * (cb - 133); dst = PC_VB + 32 * (cb - 133); }
            else if (cb < 169) { src = 4368 + 32 * (cb - 137); dst = PC_GA + 32 * (cb - 137); }
            else { src = 5392 + 32 * (cb - 169); dst = PC_GB + 32 * (cb - 169); }
            if (dst < NF8 * 256) tr_item<true>(w_in, IN_TOTAL, 64 * kb, src, nv, WIN8, dst, D, 0, scr, F.lane, 32.f);
            else tr_item(w_in, IN_TOTAL, 64 * kb, src, nv, WIN, dst, D, 0, scr, F.lane);
            continue; } r -= I0;
        if (r < I3) { const int kb = r / 32, nb = r % 32; tr_item(w_o, D, 64 * kb, 32 * nb, 32, WO, 32 * nb, D, 0, scr, F.lane); continue; } r -= I3;
        if (r < I4 + I5) { const bool up = r >= I4; if (up) r -= I4; const int e = r / 128, q = r % 128, kb = q / 8, nb = q % 8, n0 = 32 * nb;
            tr_item<true>((up ? w_up : w_gate) + (size_t)e * D * 256, 256, 64 * kb, n0, 32, WGU, (size_t)e * 512 + (n0 >> 7) * 256 + (up ? 128 : 0) + (n0 & 127), D, 0, scr, F.lane, 32.f); continue; } r -= I4 + I5;
        { const int e = r / 128, q = r % 128, kb = q / 32, nb = q % 32;
            tr_item<true>(w_down + (size_t)e * 256 * D, D, 64 * kb, 32 * nb, 32, WD, (size_t)(e >> 2) * D + 32 * nb, D, (e & 3) * 256, scr, F.lane, 16.f); }
    }
    if (part == 0) { GAS v4u* z = (GAS v4u*)(WIN + (size_t)IN_TOTAL * D); const int n16 = (PW - IN_TOTAL) * D * 2 / 16; const v4u zero = {0u, 0u, 0u, 0u};
      for (int i = gw * 64 + F.lane; i < n16; i += NGW * 64) z[i] = zero; }
}
__device__ __forceinline__ void p1_h1(Frame& F0, const float* x, const float* g1, const float* mod, bf16* H1) {
    Frame F = F0; { int t__ = threadIdx.x; asm volatile("" : "+v"(t__)); F.tid = t__; F.lane = t__ & 63; F.wave = __builtin_amdgcn_readfirstlane(t__ >> 6); }
    const int gw = F.vcu * NWAVES + F.wave, NGW = F.G * NWAVES, c0 = F.lane * 8;
    f32x4 scl[4], sft[4]; int curb = -1;
    f32x4 nx[4];
    const int NIT = T / NGW;
    {
#pragma unroll
        for (int j = 0; j < 2; ++j) { nx[2 * j] = *(const GAS f32x4*)(x + (size_t)(NIT * gw) * D + c0 + 512 * j); nx[2 * j + 1] = *(const GAS f32x4*)(x + (size_t)(NIT * gw) * D + c0 + 512 * j + 4); } }
    for (int k = 0; k < NIT; ++k) {
        const int m = NIT * gw + k, mn = m + 1;
        const int b = m / SEQ;
        if (b != curb) { curb = b; const float* sh = mod + b * NMOD; const float* sc = sh + D;
#pragma unroll
            for (int q = 0; q < 4; ++q) { const int cc = c0 + 512 * (q >> 1) + 4 * (q & 1); scl[q] = *(const f32x4*)(g1 + cc) * (*(const f32x4*)(sc + cc) + 1.f); sft[q] = *(const f32x4*)(sh + cc); } }
        f32x4 v[4]; float s = 0.f;
#pragma unroll
        for (int q = 0; q < 4; ++q) v[q] = nx[q];
        if (k + 1 < NIT) {
#pragma unroll
            for (int j = 0; j < 2; ++j) { nx[2 * j] = *(const GAS f32x4*)(x + (size_t)mn * D + c0 + 512 * j); nx[2 * j + 1] = *(const GAS f32x4*)(x + (size_t)mn * D + c0 + 512 * j + 4); } }
#pragma unroll
        for (int q = 0; q < 4; ++q) s += (v[q].x * v[q].x + v[q].y * v[q].y) + (v[q].z * v[q].z + v[q].w * v[q].w);
#pragma unroll
        for (int o = 1; o < 64; o <<= 1) s += __shfl_xor(s, o);
        const float rstd = rsqrtf(s * (1.f / D) + EPS);
#pragma unroll
        for (int j = 0; j < 2; ++j) { const f32x4 y0 = v[2 * j] * rstd * scl[2 * j] + sft[2 * j], y1 = v[2 * j + 1] * rstd * scl[2 * j + 1] + sft[2 * j + 1];
            *(GAS v4u*)(H1 + (size_t)m * D + c0 + 512 * j) = (v4u){pg8::cvt_pk_bf16(y0.x, y0.y), pg8::cvt_pk_bf16(y0.z, y0.w), pg8::cvt_pk_bf16(y1.x, y1.y), pg8::cvt_pk_bf16(y1.z, y1.w)};
            if constexpr (NF8 > 0) { int q0 = __builtin_amdgcn_cvt_pk_fp8_f32(y0.x, y0.y, 0, false); q0 = __builtin_amdgcn_cvt_pk_fp8_f32(y0.z, y0.w, q0, true);
                int q1 = __builtin_amdgcn_cvt_pk_fp8_f32(y1.x, y1.y, 0, false); q1 = __builtin_amdgcn_cvt_pk_fp8_f32(y1.z, y1.w, q1, true);
                *(GAS u32x2*)((unsigned char*)H1 + 64 * MiB + (size_t)m * D + c0 + 512 * j) = (u32x2){(unsigned)q0, (unsigned)q1}; } }
    }
}

__global__ void __launch_bounds__(NWAVES * 64, 2) skel_fwd(Args args) {
    extern __shared__ __attribute__((aligned(16))) unsigned char lds[];
    Frame F;
    F.lds = (LAS unsigned char*)lds;
    F.MISC = (volatile LAS unsigned*)(F.lds + MISC_OFF);
    F.tid = threadIdx.x; F.lane = F.tid & 63; F.wave = __builtin_amdgcn_readfirstlane(F.tid >> 6);
    F.G = gridDim.x; { const int bx = blockIdx.x; F.vcu = (F.G % 8 == 0) ? (bx % 8) * (F.G / 8) + bx / 8 : bx; }
    unsigned char* ws = args.ws;
    F.ctl = (gu32*)(ws + WS_CTL);
    for (int u = F.tid; u < (LDS_BYTES - LDSCTL_OFF) / 4; u += NWAVES * 64) ((LAS unsigned*)(F.lds + LDSCTL_OFF))[u] = 0u;
    __syncthreads();
    XcdBarrier bar = xcd_barrier_post((unsigned*)(F.ctl + CW_BAR) + args.li * XCD_BAR_WORDS, F.MISC + 8);
    const int lo = args.ph_lo, hi = args.ph_hi;
#define IN(k) (lo <= (k) && (k) < hi)
#define BOTH(k) (IN(k) && IN((k) + 1))
#define GRID_BAR() xcd_barrier(bar)
#if defined(PROBE_LO)
    volatile LAS unsigned long long* tsl = (volatile LAS unsigned long long*)(F.lds + LDSCTL_OFF + 64);
#define STAMP(k) do { if (blockIdx.x == 0 && F.tid == 0) tsl[k] = rt(); } while (0)
#else
#define STAMP(k) do { } while (0)
#endif
#define REFRESH() do { int t__ = threadIdx.x; asm volatile("" : "+v"(t__)); F.tid = t__; F.lane = t__ & 63; F.wave = __builtin_amdgcn_readfirstlane(t__ >> 6); } while (0)
    float* mod = (float*)(ws + WS_MOD);
    bf16* P = (bf16*)(ws + WS_P);
    bf16* H1 = (bf16*)args.out;

    STAMP(0); if (IN(0)) {
        if (blockIdx.x < NMOD / 32) p0_mod_item(F, args.in[1], args.in[2], args.in[3], mod, blockIdx.x);
        p0_convert(F, args, 0);
        {
            GAS v4u* xz = (GAS v4u*)(ws + WS_XBUF); const v4u zero = {0u, 0u, 0u, 0u};
            for (int i = blockIdx.x * (NWAVES * 64) + F.tid; i < (int)(XBUF_BYTES / 16); i += F.G * NWAVES * 64) xz[i] = zero; }
        if (BOTH(0)) GRID_BAR();
    }
    STAMP(1); if (IN(1)) {
        p1_h1(F, args.in[0], args.in[4], mod, H1);
        if (BOTH(1)) GRID_BAR();
    }
    STAMP(2); if (IN(2)) {
        if constexpr (NF8 > 0) {
            pg8::Gemm g{(const unsigned char*)H1 + 64 * MiB, ws + WS_WIN8, D / 128, D, D, 0x7f7f7f7f, 0x7a7a7a7a}; pg8::StaticOrder S; S.init(T, NF8 * 256, F.G, (int)blockIdx.x);
            static_assert(NF8 == 0 || (NF8 == 12 && PC_RA == 0 && PC_GA == 1024 && PC_GB == 2048), "the byte-coded gate epilogue assumes the gate tiles come first");
            pg8::EpiGate E{P, PWB};
            pg8::gemm_phase<pg8::EpiGate, pg8::StaticOrder, false, true, true>(F.lds + RING_OFF, g, S, E);
        }
        {
            pg8::Gemm g{H1, ws + WS_WIN + (size_t)NF8 * 256 * D * 2, D / 64, D * 2, D * 2, 0, 0}; pg8::StaticOrder S; S.init(T, PW - NF8 * 256, F.G, (int)blockIdx.x);
            pg8::EpiBf16 E{P + NF8 * 256 - PBOFF, PWB};
            pg8::gemm_phase<pg8::EpiBf16, pg8::StaticOrder, false, true>(F.lds + RING_OFF, g, S, E);
        }
        if (BOTH(2)) GRID_BAR();
    }
    STAMP(3); if (IN(3)) { p3_gla_upd(F, P, args.in[6], args.in[7], (unsigned char*)args.out); if (BOTH(3)) GRID_BAR(); }
    STAMP(4); if (IN(4)) { p4_gla_scan(F, (unsigned char*)args.out); if (BOTH(4)) GRID_BAR(); }
    STAMP(5); if (IN(5)) { p5_gla_out(F, P, args.in[8], (unsigned char*)args.out); if (BOTH(5)) GRID_BAR(); }
    STAMP(6); if (IN(6)) {
        p6_swa_merge(F, P, (bf16*)(ws + WS_M), (const bf16*)((const unsigned char*)args.out + 64 * MiB), args.in[9]);
        if (BOTH(6)) GRID_BAR();
    }
    STAMP(7); if (IN(7)) {
        pg8::Gemm g{ws + WS_M, ws + WS_WO, D / 64, D * 2, D * 2, 0, 0}; pg8::StaticOrder S; S.init(T, D, F.G, (int)blockIdx.x);
        pg8::EpiX1 E{args.in[0], mod + 2 * D, (bf16*)args.out};
        pg8::gemm_phase<pg8::EpiX1, pg8::StaticOrder, false, true>(F.lds + RING_OFF, g, S, E);
        if (BOTH(7)) GRID_BAR();
    }
    STAMP(8); if (IN(8)) {
        p8_h2_route(F, args, mod, (unsigned char*)P);
        if (BOTH(8)) GRID_BAR();
    }
    STAMP(9); if (IN(9)) {
        p9_sort(F, args);
        p0_convert(F, args, 1);
        if (BOTH(9)) GRID_BAR();
    }
    const int* seg = (const int*)(ws + WS_SORT + SORT_SEG); const int* rowlist = (const int*)(ws + WS_SORT + SORT_ROWLIST); const int* tileb = (const int*)(ws + WS_SORT + SORT_TILEB);
    unsigned char* HID = (unsigned char*)P + 64 * MiB;
    STAMP(10); if (IN(10)) {
        const int ntile = __builtin_amdgcn_readfirstlane(seg[32]);
        PairOrder10 S; S.rl = rowlist; S.tileb = tileb; S.cnt = F.ctl + CW_HIDCNT; S.nunits = ntile * 4; S.G = F.G; S.c = F.vcu;
        pg8::Gemm g{P, ws + WS_WGU, D / 128, D, D, 0x7f7f7f7f, 0x7a7a7a7a};
        EpiHid E{HID, (const float*)(ws + WS_SORT + SORT_CW)};
        pg8::gemm_phase<EpiHid, PairOrder10, true, true, true>(F.lds + RING_OFF, g, S, E);
    }
    STAMP(11); if (IN(11)) {
        const int ntile = __builtin_amdgcn_readfirstlane(seg[32]);
        PairOrder11 S; S.tileb = tileb; S.cnt = F.ctl + CW_HIDCNT; S.tmo = F.ctl + CW_BAR + XB_TMO; S.init(ntile * 4, F.G, F.vcu);
        pg8::Gemm g{HID, ws + WS_WD, 4, 512, D, 0x7b7b7b7b, 0x7b7b7b7b};
        EpiFinal E{rowlist, mod + 5 * D, (const bf16*)args.out, args.out, args.in[19], (unsigned long long*)(ws + WS_XBUF), F.lds + 140288};
        pg8::gemm_phase<EpiFinal, PairOrder11, false, true, true, true>(F.lds + RING_OFF, g, S, E);
    }
    STAMP(12);
    STAMP(13);
#if defined(PROBE_LO)
    if (blockIdx.x == 0 && F.tid == 0) { const unsigned long long dt = (tsl[PROBE_HI] - tsl[PROBE_LO]) * PROBE_MULT, t0 = rt(); while (rt() - t0 < dt) __builtin_amdgcn_s_sleep(8); }
#endif
#undef IN
#undef BOTH
#undef GRID_BAR
#undef STAMP
#undef REFRESH
}

extern "C" void kernel_launch(void* const* d_in, const int* in_sizes, int n_in, void* d_out, int out_size, void* d_ws, size_t ws_size, hipStream_t stream) {
    static int grid = 0;
    if (grid == 0) {
        int dev = 0, cus = 0, per_cu = 0;
        if (hipGetDevice(&dev) != hipSuccess || hipDeviceGetAttribute(&cus, hipDeviceAttributeMultiprocessorCount, dev) != hipSuccess) { grid = -1; return; }
        if (hipFuncSetAttribute((const void*)skel_fwd, hipFuncAttributeMaxDynamicSharedMemorySize, LDS_BYTES) != hipSuccess) { grid = -1; return; }
        if (hipOccupancyMaxActiveBlocksPerMultiprocessor(&per_cu, (const void*)skel_fwd, NWAVES * 64, LDS_BYTES) != hipSuccess || per_cu < 1) per_cu = 1;
        (void)hipGetLastError();
        grid = cus;
        if (ws_size < WS_END) { fprintf(stderr, "kernel_launch: workspace too small (%zu < %zu)\n", ws_size, (size_t)WS_END); grid = -1; return; }
    }
    if (grid < 0) return;
    unsigned char* ws = (unsigned char*)d_ws; float* out = (float*)d_out;
    (void)hipMemsetAsync((char*)d_ws + WS_CTL, 0, CTL_ZERO_BYTES, stream);
    Args a{};
    for (int i = 0; i < 20; ++i) a.in[i] = (const float*)d_in[i];
    a.out = out; a.ws = ws;
    a.ph_lo = 0; a.ph_hi = 12; a.li = 0;
    hipLaunchKernelGGL(skel_fwd, dim3(grid), dim3(NWAVES * 64), LDS_BYTES, stream, a);
}
```

```cpp
#include <hip/hip_runtime.h>
#include <stdint.h>
#include <cstdio>

constexpr int D = 1024, NB = 4, SEQ = 8192, T = NB * SEQ;
constexpr int NMOD = 6 * D;
constexpr int IN_TOTAL = 6416;
constexpr int PW = 6656;
constexpr int PC_RA = 0, PC_GA = 1024, PC_GB = 2048, PC_KA = 3072, PC_VA = 3584, PC_KB = 4608, PC_VB = 4736, PC_QA = 4864, PC_QB = 5376, PC_Z = 6400;
constexpr int PWB = 5120, PBOFF = 1536;
constexpr int PE_KA = PC_KA - PBOFF, PE_VA = PC_VA - PBOFF, PE_KB = PC_KB - PBOFF, PE_VB = PC_VB - PBOFF, PE_QA = PC_QA - PBOFF, PE_QB = PC_QB - PBOFF, PE_Z = PC_Z - PBOFF;
#ifndef NF8_TILES
#define NF8_TILES 12
#endif
constexpr int NF8 = NF8_TILES;
constexpr float EPS = 1e-6f;
constexpr int PROWS = T + 1024;

constexpr size_t MiB = 1u << 20;
constexpr size_t WS_CTL = 0, CTL_ZERO_BYTES = 65536;
constexpr size_t WS_MOD = 1 * MiB;
constexpr size_t WS_ROUTE = 2 * MiB;
constexpr size_t WS_SORT = 3 * MiB;
constexpr size_t WS_WIN = 8 * MiB, WS_WO = 21 * MiB, WS_WGU = 23 * MiB, WS_WIN8 = 31 * MiB, WS_WD = 39 * MiB;
constexpr size_t WS_P = 48 * MiB;
constexpr size_t WS_M = WS_P + (size_t)PROWS * PWB * 2;
constexpr size_t WS_END = WS_M + (size_t)T * D * 2;
static_assert(WS_END <= 512 * MiB, "ws map");
constexpr int CW_BAR = 4096;
#define GAS __attribute__((address_space(1)))
#define LAS __attribute__((address_space(3)))
typedef unsigned short bf16;
typedef unsigned v4u __attribute__((ext_vector_type(4)));
typedef float f32x4 __attribute__((ext_vector_type(4)));
typedef short bf16x8 __attribute__((ext_vector_type(8)));
typedef GAS unsigned gu32;
typedef GAS unsigned long long gu64;
#define RLX_AGENT __ATOMIC_RELAXED, __HIP_MEMORY_SCOPE_AGENT
#define LDS_WAIT() asm volatile("s_waitcnt lgkmcnt(0)" ::: "memory")
#define VM_WAIT() asm volatile("s_waitcnt vmcnt(0)" ::: "memory")
__device__ __forceinline__ unsigned long long rt() { return __builtin_amdgcn_s_memrealtime(); }
__device__ __forceinline__ unsigned f2bf(float f) { unsigned u = __builtin_bit_cast(unsigned, f); return (u + 0x7fffu + ((u >> 16) & 1u)) >> 16; }
__device__ __forceinline__ unsigned pk2(float lo, float hi) { return f2bf(lo) | (f2bf(hi) << 16); }

#define XB_TMO      128
#define XB_XCNT(j)  (256  + 64 * (j))
#define XB_XSUB(j)  (1280 + 64 * (j))
#define XB_XGEN(j)  (2304 + 64 * (j))
#define XB_TOP      3328
#define XB_TOPGEN   3392
#define XCD_BAR_WORDS 3456
#define XB_SPIN_CAP (1u << 18)

__device__ __forceinline__ unsigned xb_ld(unsigned* p)              { return __hip_atomic_load(p, __ATOMIC_RELAXED, __HIP_MEMORY_SCOPE_AGENT); }
__device__ __forceinline__ unsigned xb_add(unsigned* p, unsigned v) { return __hip_atomic_fetch_add(p, v, __ATOMIC_RELAXED, __HIP_MEMORY_SCOPE_AGENT); }
__device__ __forceinline__ unsigned xb_xcc_id() { return (unsigned)__builtin_amdgcn_s_getreg((3 << 11) | 20) & 0xFu; }
#define XB_SPIN(cond, bar) do { unsigned _sp = 0; while (cond) { __builtin_amdgcn_s_sleep(1); \
    if ((++_sp & 255u) == 0u) { if (xb_ld(&(bar)[XB_TMO])) break; if (_sp > XB_SPIN_CAP) { atomicAdd(&(bar)[XB_TMO], 1u); break; } } } } while (0)

struct XcdBarrier {
    unsigned* bar; unsigned x;
    volatile LAS unsigned* st;
};

__device__ __forceinline__ XcdBarrier xcd_barrier_post(unsigned* bar, volatile LAS unsigned* st) {
    XcdBarrier b; b.bar = bar; b.x = xb_xcc_id(); b.st = st;
    if (threadIdx.x == 0) (void)xb_add(&bar[XB_XCNT(b.x)], 1u);
    return b;
}
__device__ __forceinline__ void xcd_barrier_complete(unsigned* bar, unsigned x, unsigned& nloc, unsigned& nx) {
    const unsigned G = gridDim.x * gridDim.y * gridDim.z;
    unsigned sum, cnt, mine, sp = 0u;
    for (;;) {
        sum = 0u; cnt = 0u; mine = 0u;
#pragma unroll
        for (unsigned j = 0; j < 16; ++j) { const unsigned c = xb_ld(&bar[XB_XCNT(j)]); sum += c; cnt += (c > 0u) ? 1u : 0u; mine = (j == x) ? c : mine; }
        if (sum == G) break;
        __builtin_amdgcn_s_sleep(1);
        if ((++sp & 255u) == 0u) { if (xb_ld(&bar[XB_TMO])) break; if (sp > XB_SPIN_CAP) { atomicAdd(&bar[XB_TMO], 1u); break; } }
    }
    nloc = mine > 0u ? mine : 1u; nx = cnt > 0u ? cnt : 1u;
}

__device__ __forceinline__ void xcd_barrier(const XcdBarrier& b) {
    asm volatile("s_waitcnt vmcnt(0)" ::: "memory");
    __syncthreads();
    if (threadIdx.x == 0) {
        unsigned* bar = b.bar;
        __builtin_amdgcn_s_waitcnt(0);
        unsigned nloc = b.st[0], nx = b.st[1];
        if (nloc == 0u) { xcd_barrier_complete(bar, b.x, nloc, nx); b.st[0] = nloc; b.st[1] = nx; }
        const unsigned old = xb_add(&bar[XB_XSUB(b.x)], 1u);
        const unsigned gen = old / nloc;
        if (old + 1u == (gen + 1u) * nloc) {
            __builtin_amdgcn_fence(__ATOMIC_RELEASE, "agent");
            asm volatile("s_waitcnt vmcnt(0)" ::: "memory");
            const unsigned og = xb_add(&bar[XB_TOP], 1u);
            const unsigned tg = og / nx;
            if (og + 1u == (tg + 1u) * nx) xb_add(&bar[XB_TOPGEN], 1u);
            else XB_SPIN(xb_ld(&bar[XB_TOPGEN]) == tg, bar);
            __builtin_amdgcn_fence(__ATOMIC_ACQUIRE, "agent");
            xb_add(&bar[XB_XGEN(b.x)], 1u);
            asm volatile("s_waitcnt vmcnt(0)" ::: "memory");
        } else {
            XB_SPIN(xb_ld(&bar[XB_XGEN(b.x)]) == gen, bar);
            __builtin_amdgcn_fence(__ATOMIC_ACQUIRE, "agent");
            asm volatile("s_waitcnt vmcnt(0)" ::: "memory");
        }
    }
    __syncthreads();
}
namespace pg8 {
#define PG8_LAS __attribute__((address_space(3)))
typedef unsigned short bf16_t;
typedef short bf16x8 __attribute__((ext_vector_type(8)));
typedef float f32x4 __attribute__((ext_vector_type(4)));
typedef unsigned u32x4 __attribute__((ext_vector_type(4)));
constexpr int BM = 256, BK = 64, HALF = 128, HTB = HALF * BK * 2  , STAGE_BYTES = 8 * HTB, NXCD = 8, WGM = 4;

__host__ __device__ __forceinline__ int lds_byte(int r, int c) { const int st = (r >> 4) * 2 + (c >> 5), rr = r & 15, cc = c & 31, ob = rr * 64 + cc * 2; return st * 1024 + (ob ^ (((ob >> 9) & 1) << 5)); }
__host__ __device__ __forceinline__ void stage_rc(int b, int& R, int& C) { const int st = b / 1024, sb = b % 1024, swz = sb ^ (((sb >> 9) & 1) << 5); R = (st >> 1) * 16 + swz / 64; C = (st & 1) * 32 + (swz % 64) / 2; }
__host__ __device__ __forceinline__ int perm32(int rho) { const int n = rho >> 4, i = rho & 15; return 8 * (i >> 2) + 4 * n + (i & 3); }

struct Unit { int pm, pn; };
struct Gemm { const void* A; const void* Bt; int nt, ldaB, ldbB; int sa, sb; };
typedef int v8i __attribute__((ext_vector_type(8)));

struct StaticOrder {
    int nM, nN, nwg, G, c;
    __host__ __device__ void init(int M, int N, int G_, int c_) { nM = M / BM; nN = N / BM; nwg = nM * nN; G = G_; c = c_; }
    __host__ __device__ bool next(int i, Unit& u) const {
        const long L = (long)i * G + c; if (L >= nwg) return false;
        int wgid = (int)L; { const int q = nwg / NXCD, r = nwg % NXCD, xcd = wgid % NXCD, off = wgid / NXCD; wgid = (xcd < r ? xcd * (q + 1) : r * (q + 1) + (xcd - r) * q) + off; }
        const int nig = WGM * nN, gid = wgid / nig, fm = gid * WGM, gsz = (nM - fm) < WGM ? (nM - fm) : WGM;
        u.pm = fm + ((wgid % nig) % gsz); u.pn = (wgid % nig) / gsz; return true;
    }
    __device__ __forceinline__ int brow(const Unit& u) const { return u.pn * BM; }
    __device__ __forceinline__ const int* rowlist() const { return nullptr; }
    static constexpr bool WAITS = false, SIGNALS = false;
    __device__ __forceinline__ void a_ready(const Unit&) const {}
    __device__ __forceinline__ void done(const Unit&) const {}
};

__device__ __forceinline__ unsigned cvt_pk_bf16(float lo, float hi) { unsigned r; asm volatile("v_cvt_pk_bf16_f32 %0, %1, %2" : "=v"(r) : "v"(lo), "v"(hi)); return r; }

struct EpiBf16 {
    static constexpr bool PERM = true;
    bf16_t* O; int ldc;
    __device__ __forceinline__ void operator()(const f32x4 (&acc)[2][2][4][2], const Unit& u, int wr_, int wc_, int fr_, int fq_) const {
        int t_ = threadIdx.x; asm volatile("" : "+v"(t_));
        const int wid_ = __builtin_amdgcn_readfirstlane(t_ >> 6), wr = wid_ >> 2, wc = wid_ & 3, fr = t_ & 15, fq = (t_ & 63) >> 4; (void)wr_; (void)wc_; (void)fr_; (void)fq_;
        const int row0 = u.pm * BM + wr * 64 + fr; const int col0 = u.pn * BM + wc * 32 + 8 * fq;
#pragma unroll
        for (int ai = 0; ai < 2; ++ai)
#pragma unroll
            for (int m = 0; m < 4; ++m) { bf16_t* rowp = O + (size_t)(row0 + ai * HALF + m * 16) * ldc + col0;
#pragma unroll
                for (int bj = 0; bj < 2; ++bj) { const f32x4 v0 = acc[ai][bj][m][0], v1 = acc[ai][bj][m][1];
                    u32x4 w; w.x = cvt_pk_bf16(v0[0], v0[1]); w.y = cvt_pk_bf16(v0[2], v0[3]); w.z = cvt_pk_bf16(v1[0], v1[1]); w.w = cvt_pk_bf16(v1[2], v1[3]);
                    *(u32x4*)(rowp + bj * HALF) = w; } }
    }
};
struct EpiGate {
    static constexpr bool PERM = true;
    bf16_t* P; int ldp;
    __device__ __forceinline__ void operator()(const f32x4 (&acc)[2][2][4][2], const Unit& u, int wr_, int wc_, int fr_, int fq_) const {
        int t_ = threadIdx.x; asm volatile("" : "+v"(t_));
        const int wid_ = __builtin_amdgcn_readfirstlane(t_ >> 6), wr = wid_ >> 2, wc = wid_ & 3, fr = t_ & 15, fq = (t_ & 63) >> 4; (void)wr_; (void)wc_; (void)fr_; (void)fq_;
        const int row0 = u.pm * BM + wr * 64 + fr; const int col0 = u.pn * BM + wc * 32 + 8 * fq;
        const bool sig = u.pn >= 4;
#pragma unroll
        for (int ai = 0; ai < 2; ++ai)
#pragma unroll
            for (int m = 0; m < 4; ++m) { unsigned char* rowp = (unsigned char*)(P + (size_t)(row0 + ai * HALF + m * 16) * ldp) + col0;
#pragma unroll
                for (int bj = 0; bj < 2; ++bj) { const f32x4 v0 = acc[ai][bj][m][0], v1 = acc[ai][bj][m][1];
                    float e[8] = {v0[0], v0[1], v0[2], v0[3], v1[0], v1[1], v1[2], v1[3]};
#pragma unroll
                    for (int j = 0; j < 8; ++j) e[j] = __builtin_rintf(sig ? 255.f * __builtin_amdgcn_rcpf(1.f + __expf(-e[j])) : e[j] * 20.f + 128.f);
                    unsigned w0 = 0u, w1 = 0u;
                    w0 = __builtin_amdgcn_cvt_pk_u8_f32(e[0], 0, w0); w0 = __builtin_amdgcn_cvt_pk_u8_f32(e[1], 1, w0); w0 = __builtin_amdgcn_cvt_pk_u8_f32(e[2], 2, w0); w0 = __builtin_amdgcn_cvt_pk_u8_f32(e[3], 3, w0);
                    w1 = __builtin_amdgcn_cvt_pk_u8_f32(e[4], 0, w1); w1 = __builtin_amdgcn_cvt_pk_u8_f32(e[5], 1, w1); w1 = __builtin_amdgcn_cvt_pk_u8_f32(e[6], 2, w1); w1 = __builtin_amdgcn_cvt_pk_u8_f32(e[7], 3, w1);
                    typedef unsigned u32x2_ __attribute__((ext_vector_type(2)));
                    *(u32x2_*)(rowp + bj * HALF) = (u32x2_){w0, w1}; } }
    }
};
struct EpiX1 {
    static constexpr bool PERM = true;
    const float* x; const float* gt; bf16_t* xo;
    __device__ __forceinline__ void operator()(const f32x4 (&acc)[2][2][4][2], const Unit& u, int wr_, int wc_, int fr_, int fq_) const {
        int t_ = threadIdx.x; asm volatile("" : "+v"(t_));
        const int wid_ = __builtin_amdgcn_readfirstlane(t_ >> 6), wr = wid_ >> 2, wc = wid_ & 3, fr = t_ & 15, fq = (t_ & 63) >> 4; (void)wr_; (void)wc_; (void)fr_; (void)fq_;
        const int b = (u.pm * BM) / SEQ; const float* g = gt + (size_t)b * NMOD;
        const int col0 = u.pn * BM + wc * 32 + 8 * fq;
        f32x4 gv[2][2];
#pragma unroll
        for (int bj = 0; bj < 2; ++bj)
#pragma unroll
            for (int n = 0; n < 2; ++n) gv[bj][n] = *(const f32x4*)(g + col0 + bj * HALF + n * 4);
#pragma unroll
        for (int ai = 0; ai < 2; ++ai)
#pragma unroll
            for (int m = 0; m < 4; ++m) { const size_t row = (size_t)(u.pm * BM + ai * HALF + wr * 64 + m * 16 + fr);
#pragma unroll
                for (int bj = 0; bj < 2; ++bj) {
                    const f32x4 x0 = *(const f32x4*)(x + row * D + col0 + bj * HALF), x1 = *(const f32x4*)(x + row * D + col0 + bj * HALF + 4);
                    const f32x4 v0 = x0 + gv[bj][0] * acc[ai][bj][m][0], v1 = x1 + gv[bj][1] * acc[ai][bj][m][1];
                    u32x4 w; w.x = cvt_pk_bf16(v0[0], v0[1]); w.y = cvt_pk_bf16(v0[2], v0[3]); w.z = cvt_pk_bf16(v1[0], v1[1]); w.w = cvt_pk_bf16(v1[2], v1[3]);
                    *(u32x4*)(xo + row * 2048 + col0 + bj * HALF) = w; } }
    }
};

template <bool GATHER>
__device__ __forceinline__ void mk_voff(const int* rowlist, int ldaB, int pm, int tid, unsigned (&o)[2][2]) {
#pragma unroll
    for (int h = 0; h < 2; ++h)
#pragma unroll
        for (int i = 0; i < 2; ++i) {
            int R, C; stage_rc(tid * 16 + i * 8192, R, C);
            int row = pm * BM + h * HALF + R;
            if (GATHER) { row = rowlist[row]; row = row < 0 ? 0 : row; }
            o[h][i] = (unsigned)(row * ldaB + C * 2);
        }
}

template <class Epi, class Sched, bool GATHER, bool ALIGN_EPI, bool F8 = false, bool BSPLIT = false>
__device__ __forceinline__ void gemm_phase(PG8_LAS unsigned char* lds, const Gemm g, const Sched& S, const Epi& E) {
    int tid_ = threadIdx.x; asm volatile("" : "+v"(tid_));
    const int tid = tid_, wid = __builtin_amdgcn_readfirstlane(tid >> 6), lane = tid & 63, wr = wid >> 2, wc = wid & 3, fr = lane & 15, fq = lane >> 4;
    const int nt = g.nt, lda = g.ldaB, ldbB = g.ldbB;
    const int* rl = S.rowlist();
    unsigned voffB[2], voffA0[2];
#pragma unroll
    for (int i = 0; i < 2; ++i) { int R, C; stage_rc(tid * 16 + i * 8192, R, C); const int Rb = Epi::PERM ? ((R & ~31) + perm32(R & 31)) : R;
        voffB[i] = (unsigned)(Rb * ldbB + C * 2); voffA0[i] = (unsigned)(R * lda + C * 2); }
    PG8_LAS u32x4* const xslot = (PG8_LAS u32x4*)(lds + 132096 + tid * 16);
    const size_t kstep = (size_t)(BK * 2);
    const size_t hstepB = (size_t)HALF * ldbB;
    const unsigned ldsw = (unsigned)wid * 1024u;
    const int aoff = lds_byte(wr * 64 + fr, fq * 8), boff = lds_byte(wc * 32 + fr, fq * 8);
#define PG8_SA(b, h) (((b) * 2 + (h)) * HTB)
#define PG8_SB(b, h) ((4 + (b) * 2 + (h)) * HTB)
#define PG8_STAGE(bufoff, RS, soff, voff) do { _Pragma("unroll") for (int _i = 0; _i < 2; ++_i) \
        __builtin_amdgcn_raw_ptr_buffer_load_lds(RS, (PG8_LAS unsigned*)(lds + (bufoff) + ldsw + _i * 8192), 16, (int)(voff)[_i], (int)(soff), 0, 0); } while (0)
#define PG8_LD8(p) __builtin_bit_cast(v8i, __builtin_shufflevector(*(const PG8_LAS u32x4*)(p), *(const PG8_LAS u32x4*)((p) + 1024), 0, 1, 2, 3, 4, 5, 6, 7))
#define PG8_LDA(dst, b, h) do { _Pragma("unroll") for (int m = 0; m < 4; ++m) { if constexpr (F8) dst##8[m] = PG8_LD8(lds + PG8_SA(b, h) + aoff + m * 2048); else { _Pragma("unroll") for (int k = 0; k < 2; ++k) dst[m][k] = *(const PG8_LAS bf16x8*)(lds + PG8_SA(b, h) + aoff + m * 2048 + k * 1024); } } } while (0)
#define PG8_LDB(dst, b, h) do { _Pragma("unroll") for (int n = 0; n < 2; ++n) { if constexpr (F8) dst##8[n] = PG8_LD8(lds + PG8_SB(b, h) + boff + n * 2048); else { _Pragma("unroll") for (int k = 0; k < 2; ++k) dst[n][k] = *(const PG8_LAS bf16x8*)(lds + PG8_SB(b, h) + boff + n * 2048 + k * 1024); } } } while (0)
#define PG8_MMA(ai, bj, At, Bt) do { __builtin_amdgcn_s_setprio(1); _Pragma("unroll") for (int m = 0; m < 4; ++m) _Pragma("unroll") for (int n = 0; n < 2; ++n) { \
        if constexpr (F8) asm volatile("v_mfma_scale_f32_16x16x128_f8f6f4 %0, %1, %2, %0, %3, %4 op_sel_hi:[0,0,0]" : "+v"(acc[ai][bj][m][n]) : "v"(Bt##8[n]), "v"(At##8[m]), "v"(SCALE_B), "v"(SCALE_A)); \
        else { _Pragma("unroll") for (int k = 0; k < 2; ++k) acc[ai][bj][m][n] = __builtin_amdgcn_mfma_f32_16x16x32_bf16(Bt[n][k], At[m][k], acc[ai][bj][m][n], 0, 0, 0); } } \
        __builtin_amdgcn_s_setprio(0); } while (0)
#define PG8_WAIT_V(n) asm volatile("s_waitcnt vmcnt(" #n ")" ::: "memory")
#define PG8_WAIT_L(n) asm volatile("s_waitcnt lgkmcnt(" #n ")" ::: "memory")
#define PG8_BAR __builtin_amdgcn_s_barrier()
#define PG8_SCHED __builtin_amdgcn_sched_barrier(0)
    const int SCALE_A = g.sa, SCALE_B = g.sb;
    Unit cur, nxt; int ui = 0;
    if (!S.next(0, cur)) return;
    if constexpr (Sched::WAITS) S.a_ready(cur);
    f32x4 acc[2][2][4][2];
#pragma unroll
    for (int a = 0; a < 2; ++a)
#pragma unroll
        for (int b = 0; b < 2; ++b)
#pragma unroll
            for (int m = 0; m < 4; ++m)
#pragma unroll
                for (int n = 0; n < 2; ++n) acc[a][b][m][n] = (f32x4){0.f, 0.f, 0.f, 0.f};
    bf16x8 At[4][2], B0[2][2], B1[2][2]; v8i At8[4], B08[2], B18[2];
    unsigned voffA[2][2];
    const unsigned hstepA = (unsigned)HALF * (unsigned)lda, tstepA = 2u * hstepA;
    const __amdgpu_buffer_rsrc_t rsA = __builtin_amdgcn_make_buffer_rsrc((void*)g.A, 0, 0x7fffffff, 0x00020000), rsB = __builtin_amdgcn_make_buffer_rsrc((void*)g.Bt, 0, 0x7fffffff, 0x00020000);
    unsigned cAo = 0u, nAo = 0u;
    if constexpr (GATHER) mk_voff<true>(rl, lda, cur.pm, tid, voffA);
    else cAo = (unsigned)cur.pm * tstepA;
#define PG8_STAGE_A(bufoff, soff, h, OFFS) do { if constexpr (GATHER) PG8_STAGE(bufoff, rsA, soff, (OFFS)[h]); else PG8_STAGE(bufoff, rsA, (soff) + (h) * hstepA, voffA0); } while (0)
    unsigned cBo = (unsigned)S.brow(cur) * (unsigned)ldbB;
    const unsigned kstepu = (unsigned)kstep, hstepBu = (unsigned)hstepB;
    int cK0 = 0, cK1 = 0, nK0 = 0, nK1 = 0;
    if constexpr (BSPLIT) S.kb(cur, cK0, cK1);
#define PG8_BOFF(base, k0, k1, j) ((base) + (BSPLIT ? (unsigned)(((j) < 2 ? (k0) : (k1)) + ((j) & 1) * 128) : (unsigned)(j) * kstepu))
    { const unsigned p0 = PG8_BOFF(cBo, cK0, cK1, 0), p1 = PG8_BOFF(cBo, cK0, cK1, 1);
    PG8_STAGE(PG8_SB(0, 0), rsB, p0, voffB); PG8_STAGE(PG8_SB(0, 1), rsB, p0 + hstepBu, voffB); PG8_STAGE_A(PG8_SA(0, 0), cAo, 0, voffA); PG8_STAGE_A(PG8_SA(0, 1), cAo, 1, voffA);
    if (wr == 1) PG8_BAR;
    PG8_WAIT_V(2); PG8_BAR;
    PG8_STAGE(PG8_SB(1, 0), rsB, p1, voffB); PG8_STAGE_A(PG8_SA(1, 0), cAo + kstepu, 0, voffA); PG8_STAGE(PG8_SB(1, 1), rsB, p1 + hstepBu, voffB); }
    PG8_WAIT_V(6); PG8_BAR;
    for (;;) {
        const bool has_next = S.next(ui + 1, nxt);
        if constexpr (GATHER) {
            unsigned vn[2][2];
            if (has_next) mk_voff<true>(rl, lda, nxt.pm, tid, vn);
            else {
#pragma unroll
                for (int h = 0; h < 2; ++h)
#pragma unroll
                    for (int i = 0; i < 2; ++i) vn[h][i] = voffA[h][i]; }
            *xslot = (u32x4){vn[0][0], vn[0][1], vn[1][0], vn[1][1]};
        } else nAo = has_next ? (unsigned)nxt.pm * tstepA : cAo;
        const unsigned nBo = has_next ? (unsigned)S.brow(nxt) * (unsigned)ldbB : cBo;
        if constexpr (BSPLIT) { if (has_next) S.kb(nxt, nK0, nK1); else { nK0 = cK0; nK1 = cK1; } }
#pragma nounroll
        for (int t = 0; t < nt; t += 2) {
            const bool last = (t == nt - 2);
            if constexpr (Sched::WAITS) { if (last && has_next) S.a_ready(nxt); }
            const unsigned a1 = cAo + (unsigned)(t + 1) * kstepu;
            const unsigned a2 = last ? nAo : cAo + (unsigned)(t + 2) * kstepu, b2 = last ? PG8_BOFF(nBo, nK0, nK1, 0) : PG8_BOFF(cBo, cK0, cK1, t + 2);
            const unsigned a3 = a2 + kstepu, b3 = last ? PG8_BOFF(nBo, nK0, nK1, 1) : PG8_BOFF(cBo, cK0, cK1, t + 3);
            unsigned sl[2][2];
            if constexpr (GATHER) {
                if (last) { const u32x4 vn = *xslot; sl[0][0] = vn.x; sl[0][1] = vn.y; sl[1][0] = vn.z; sl[1][1] = vn.w; }
                else {
#pragma unroll
                    for (int h = 0; h < 2; ++h)
#pragma unroll
                        for (int i = 0; i < 2; ++i) sl[h][i] = voffA[h][i]; } }
            PG8_LDB(B0, 0, 0); PG8_LDB(B1, 0, 1); PG8_SCHED; PG8_LDA(At, 0, 0); PG8_STAGE_A(PG8_SA(1, 1), a1, 1, voffA);
            PG8_WAIT_V(8); PG8_WAIT_L(0); PG8_BAR; PG8_MMA(0, 0, At, B0); PG8_MMA(0, 1, At, B1); PG8_BAR; PG8_SCHED;
            PG8_LDA(At, 0, 1); PG8_STAGE(PG8_SB(0, 0), rsB, b2, voffB); PG8_STAGE(PG8_SB(0, 1), rsB, b2 + hstepBu, voffB); PG8_STAGE_A(PG8_SA(0, 0), a2, 0, sl);
            PG8_WAIT_V(8); PG8_WAIT_L(0); PG8_BAR; PG8_MMA(1, 0, At, B0); PG8_MMA(1, 1, At, B1); PG8_BAR; PG8_SCHED;
            PG8_LDB(B0, 1, 0); PG8_LDB(B1, 1, 1); PG8_SCHED; PG8_LDA(At, 1, 0); PG8_STAGE_A(PG8_SA(0, 1), a2, 1, sl);
            PG8_WAIT_V(8); PG8_WAIT_L(0); PG8_BAR; PG8_MMA(0, 0, At, B0); PG8_MMA(0, 1, At, B1); PG8_BAR; PG8_SCHED;
            PG8_LDA(At, 1, 1); PG8_STAGE(PG8_SB(1, 0), rsB, b3, voffB); PG8_STAGE(PG8_SB(1, 1), rsB, b3 + hstepBu, voffB); PG8_STAGE_A(PG8_SA(1, 0), a3, 0, sl);
            PG8_WAIT_V(8); PG8_WAIT_L(0); PG8_BAR; PG8_MMA(1, 0, At, B0); PG8_MMA(1, 1, At, B1); PG8_BAR; PG8_SCHED;
        }
        if constexpr (ALIGN_EPI) { if (wr == 0) PG8_BAR; }
        if constexpr (F8) asm volatile("s_nop 15\n\ts_nop 7" ::: "memory");
        E(acc, cur, wr, wc, fr, fq);
        if constexpr (Sched::SIGNALS) S.done(cur);
        if (!has_next) break;
#pragma unroll
        for (int a = 0; a < 2; ++a)
#pragma unroll
            for (int b = 0; b < 2; ++b)
#pragma unroll
                for (int m = 0; m < 4; ++m)
#pragma unroll
                    for (int n = 0; n < 2; ++n) acc[a][b][m][n] = (f32x4){0.f, 0.f, 0.f, 0.f};
        cur = nxt; cBo = nBo; cAo = nAo; cK0 = nK0; cK1 = nK1; ++ui;
        if constexpr (GATHER) { const u32x4 vn = *xslot; voffA[0][0] = vn.x; voffA[0][1] = vn.y; voffA[1][0] = vn.z; voffA[1][1] = vn.w; }
        if constexpr (ALIGN_EPI) { if (wr == 1) PG8_BAR; }
    }
    PG8_WAIT_V(0);
    if constexpr (!ALIGN_EPI) { if (wr == 0) PG8_BAR; }
    PG8_BAR;
#undef PG8_SA
#undef PG8_SB
#undef PG8_STAGE
#undef PG8_STAGE_A
#undef PG8_BOFF
#undef PG8_LDA
#undef PG8_LDB
#undef PG8_MMA
#undef PG8_LD8
#undef PG8_WAIT_V
#undef PG8_WAIT_L
#undef PG8_BAR
#undef PG8_SCHED
}
}
constexpr int NWAVES = 8;
constexpr int RING_OFF = 0, RING_BYTES = 131072;
constexpr int LDSCTL_OFF = RING_BYTES, MISC_OFF = LDSCTL_OFF + 320;
constexpr int LDS_BYTES = 147456;
static_assert(MISC_OFF + 128 <= LDS_BYTES, "LDS map");

struct Frame {
    LAS unsigned char* lds;
    volatile LAS unsigned* MISC;
    gu32* ctl;
    int tid, lane, wave;
    int vcu, G;
};
struct Args { const float* in[20]; float* out; unsigned char* ws; int ph_lo, ph_hi, li, pad; };

typedef float f32x16 __attribute__((ext_vector_type(16)));
typedef unsigned u32x2 __attribute__((ext_vector_type(2)));
__device__ __forceinline__ float bfl(unsigned w) { return __uint_as_float(w << 16); }
__device__ __forceinline__ float bfh(unsigned w) { return __uint_as_float(w & 0xffff0000u); }
#define LDS_BARRIER() do { asm volatile("s_waitcnt lgkmcnt(0)" ::: "memory"); __builtin_amdgcn_s_barrier(); asm volatile("" ::: "memory"); } while (0)
constexpr int NBK = 24, MAXPOS = 40960, MAXTILES = MAXPOS / 256;
constexpr size_t SORT_CNT = 0;
constexpr size_t SORT_SEG = 32768;
constexpr size_t SORT_TILEB = 33024;
constexpr size_t SORT_ROWLIST = 65536;
constexpr size_t SORT_CW = 262144;
constexpr int RB_ROWS = 128, NRB = T / RB_ROWS;
__device__ __forceinline__ int pair_id(int lo, int hi) { return (lo == 0 ? 0 : (lo == 1 ? 3 : 5)) + hi - lo - 1; }
__device__ __forceinline__ void pair_lohi(int pid, int& lo, int& hi) { lo = pid < 3 ? 0 : (pid < 5 ? 1 : 2); hi = pid < 3 ? pid + 1 : (pid < 5 ? pid - 1 : 3); }

__device__ __forceinline__ float wsum64(float v) {
#pragma unroll
    for (int o = 1; o < 64; o <<= 1) v += __shfl_xor(v, o);
    return v;
}

constexpr int R8_PITCH = 2064, R8_TILE = 0, R8_WT = 32 * R8_PITCH, R8_RED = R8_WT + 20 * R8_PITCH, R8_CNT = R8_RED + 8 * 32 * 20 * 4, R8_END = R8_CNT + 128;
static_assert(R8_END <= RING_BYTES, "p8 lds");
__device__ __forceinline__ void p8_h2_route(Frame& F0, const Args& args, const float* mod, unsigned char* A1) {
    Frame F = F0; { int t__ = threadIdx.x; asm volatile("" : "+v"(t__)); F.tid = t__; F.lane = t__ & 63; F.wave = __builtin_amdgcn_readfirstlane(t__ >> 6); }
    const bf16* x1 = (const bf16*)args.out; const float* g2 = args.in[11]; const float* w_group = args.in[12]; const float* b_group = args.in[13]; const float* w_router = args.in[14]; const float* b_router = args.in[15];
    int4* route = (int4*)(args.ws + WS_ROUTE); int* cnt = (int*)(args.ws + WS_SORT + SORT_CNT);
    LAS unsigned char* tile = F.lds + RING_OFF + R8_TILE; LAS unsigned char* wt = F.lds + RING_OFF + R8_WT; LAS float* red = (LAS float*)(F.lds + RING_OFF + R8_RED); LAS int* lcnt = (LAS int*)(F.lds + RING_OFF + R8_CNT);
    const int lane = F.lane, w = F.wave, vl = lane & 31, hh = lane >> 5;
    for (int d = F.tid; d < D; d += NWAVES * 64) {
        const f32x4 wg = *(const f32x4*)(w_group + (size_t)d * 4);
        *(LAS unsigned short*)(wt + 0 * R8_PITCH + d * 2) = (unsigned short)f2bf(wg.x); *(LAS unsigned short*)(wt + 1 * R8_PITCH + d * 2) = (unsigned short)f2bf(wg.y);
        *(LAS unsigned short*)(wt + 2 * R8_PITCH + d * 2) = (unsigned short)f2bf(wg.z); *(LAS unsigned short*)(wt + 3 * R8_PITCH + d * 2) = (unsigned short)f2bf(wg.w);
#pragma unroll
        for (int q = 0; q < 4; ++q) { const f32x4 w4 = *(const f32x4*)(w_router + (size_t)d * 16 + q * 4);
            *(LAS unsigned short*)(wt + (4 + q * 4 + 0) * R8_PITCH + d * 2) = (unsigned short)f2bf(w4.x); *(LAS unsigned short*)(wt + (4 + q * 4 + 1) * R8_PITCH + d * 2) = (unsigned short)f2bf(w4.y);
            *(LAS unsigned short*)(wt + (4 + q * 4 + 2) * R8_PITCH + d * 2) = (unsigned short)f2bf(w4.z); *(LAS unsigned short*)(wt + (4 + q * 4 + 3) * R8_PITCH + d * 2) = (unsigned short)f2bf(w4.w); }
    }
    __syncthreads();
    for (int rb = blockIdx.x; rb < NRB; rb += F.G) {
        const int b = (rb * RB_ROWS) / SEQ; const float* sh = mod + b * NMOD + 3 * D; const float* sc = mod + b * NMOD + 4 * D;
        f32x4 scl[4], sft[4];
#pragma unroll
        for (int j = 0; j < 2; ++j)
#pragma unroll
            for (int q = 0; q < 2; ++q) { const int c0 = lane * 8 + 512 * j + 4 * q; scl[2 * j + q] = *(const f32x4*)(g2 + c0) * (*(const f32x4*)(sc + c0) + 1.f); sft[2 * j + q] = *(const f32x4*)(sh + c0); }
        if (F.tid < NBK) lcnt[F.tid] = 0;
        for (int bt = 0; bt < 4; ++bt) {
            const int rbase = rb * RB_ROWS + bt * 32;
            v4u xr[4][2];
#pragma unroll
            for (int i = 0; i < 4; ++i)
#pragma unroll
                for (int j = 0; j < 2; ++j) xr[i][j] = *(const GAS v4u*)(x1 + (size_t)(rbase + w * 4 + i) * 2048 + lane * 8 + 512 * j);
#pragma unroll
            for (int i = 0; i < 4; ++i) {
                const int row = rbase + w * 4 + i;
                f32x4 v[4]; float s = 0.f;
#pragma unroll
                for (int j = 0; j < 2; ++j) { v[2 * j] = (f32x4){bfl(xr[i][j].x), bfh(xr[i][j].x), bfl(xr[i][j].y), bfh(xr[i][j].y)}; v[2 * j + 1] = (f32x4){bfl(xr[i][j].z), bfh(xr[i][j].z), bfl(xr[i][j].w), bfh(xr[i][j].w)}; }

#pragma unroll
                for (int q = 0; q < 4; ++q) s += (v[q].x * v[q].x + v[q].y * v[q].y) + (v[q].z * v[q].z + v[q].w * v[q].w);
                const float rstd = rsqrtf(wsum64(s) * (1.f / D) + EPS);
#pragma unroll
                for (int j = 0; j < 2; ++j) { const f32x4 y0 = v[2 * j] * rstd * scl[2 * j] + sft[2 * j], y1 = v[2 * j + 1] * rstd * scl[2 * j + 1] + sft[2 * j + 1];
                    const v4u o = {pg8::cvt_pk_bf16(y0.x, y0.y), pg8::cvt_pk_bf16(y0.z, y0.w), pg8::cvt_pk_bf16(y1.x, y1.y), pg8::cvt_pk_bf16(y1.z, y1.w)};
                    { int q0 = __builtin_amdgcn_cvt_pk_fp8_f32(y0.x, y0.y, 0, false); q0 = __builtin_amdgcn_cvt_pk_fp8_f32(y0.z, y0.w, q0, true);
                      int q1 = __builtin_amdgcn_cvt_pk_fp8_f32(y1.x, y1.y, 0, false); q1 = __builtin_amdgcn_cvt_pk_fp8_f32(y1.z, y1.w, q1, true);
                      *(GAS u32x2*)(A1 + (size_t)row * D + lane * 8 + 512 * j) = (u32x2){(unsigned)q0, (unsigned)q1}; }
                    *(LAS v4u*)(tile + (w * 4 + i) * R8_PITCH + (lane * 8 + 512 * j) * 2) = o; }
            }
            __syncthreads();
            {
                f32x16 acc = {0.f, 0.f, 0.f, 0.f, 0.f, 0.f, 0.f, 0.f, 0.f, 0.f, 0.f, 0.f, 0.f, 0.f, 0.f, 0.f};
                const int cr = vl < 20 ? vl : 19;
#pragma unroll
                for (int kk = 0; kk < 8; ++kk) { const bf16x8 a = *(const LAS bf16x8*)(tile + vl * R8_PITCH + (128 * w + 16 * kk + 8 * hh) * 2), bb = *(const LAS bf16x8*)(wt + cr * R8_PITCH + (128 * w + 16 * kk + 8 * hh) * 2);
                    acc = __builtin_amdgcn_mfma_f32_32x32x16_bf16(a, bb, acc, 0, 0, 0); }
                if (vl < 20) {
#pragma unroll
                    for (int r = 0; r < 16; ++r) red[(w * 32 + (r & 3) + 8 * (r >> 2) + 4 * hh) * 20 + vl] = acc[r]; }
            }
            __syncthreads();
            if (F.tid < 32) {
                const int row = rbase + F.tid;
                float lg[20];
#pragma unroll
                for (int c = 0; c < 20; ++c) { float a = 0.f;
#pragma unroll
                    for (int ww = 0; ww < 8; ++ww) a += red[(ww * 32 + F.tid) * 20 + c];
                    lg[c] = a; }
                float bg[4], br[16];
#pragma unroll
                for (int c = 0; c < 4; ++c) bg[c] = b_group[c];
#pragma unroll
                for (int c = 0; c < 16; ++c) br[c] = b_router[c];
                float gl[4]; int gi = 0;
#pragma unroll
                for (int c = 0; c < 4; ++c) gl[c] = lg[c] + bg[c];
                float gm = gl[0];
#pragma unroll
                for (int c = 1; c < 4; ++c) if (gl[c] > gm) { gm = gl[c]; gi = c; }
                float den = 0.f;
#pragma unroll
                for (int c = 0; c < 4; ++c) den += __expf(gl[c] - gm);
                const float gw = 1.f / den;
                float el[4];
#pragma unroll
                for (int c = 0; c < 4; ++c) { float vsel = lg[4 + c] + br[c];
#pragma unroll
                    for (int g = 1; g < 4; ++g) { const float cand = lg[4 + g * 4 + c] + br[g * 4 + c]; vsel = (gi == g) ? cand : vsel; }
                    el[c] = vsel; }
                int i0 = 0; float v0 = el[0];
#pragma unroll
                for (int c = 1; c < 4; ++c) if (el[c] > v0) { v0 = el[c]; i0 = c; }
                int i1 = -1; float v1 = -3.0e38f;
#pragma unroll
                for (int c = 0; c < 4; ++c) if (c != i0 && el[c] > v1) { v1 = el[c]; i1 = c; }
                const float p1 = __expf(v1 - v0), w0 = gw / (1.f + p1), w1 = gw * p1 / (1.f + p1);
                route[row] = make_int4(gi * 4 + i0, gi * 4 + i1, __float_as_int(w0), __float_as_int(w1));
                const int lo = i0 < i1 ? i0 : i1, hi = i0 < i1 ? i1 : i0;
                atomicAdd((int*)(lcnt + gi * 6 + pair_id(lo, hi)), 1);
            }
        }
        if (F.tid < 32) { asm volatile("s_waitcnt lgkmcnt(0)" ::: "memory"); if (F.tid < NBK) cnt[rb * NBK + F.tid] = lcnt[F.tid]; }
    }
}

__device__ __forceinline__ void p9_sort(Frame& F0, const Args& args) {
    Frame F = F0; { int t__ = threadIdx.x; asm volatile("" : "+v"(t__)); F.tid = t__; F.lane = t__ & 63; F.wave = __builtin_amdgcn_readfirstlane(t__ >> 6); }
    const int4* route = (const int4*)(args.ws + WS_ROUTE); const int* cnt = (const int*)(args.ws + WS_SORT + SORT_CNT);
    int* seg = (int*)(args.ws + WS_SORT + SORT_SEG); int* tileb = (int*)(args.ws + WS_SORT + SORT_TILEB); int* rowlist = (int*)(args.ws + WS_SORT + SORT_ROWLIST); float* cw = (float*)(args.ws + WS_SORT + SORT_CW);
    LAS int* scn = (LAS int*)(F.lds + RING_OFF);
    LAS int* sst = (LAS int*)(F.lds + RING_OFF + 24576);
    LAS int* sw0 = (LAS int*)(F.lds + RING_OFF + 24576 + 256);
    LAS int* sbase = (LAS int*)(F.lds + RING_OFF + 24576 + 384);
    for (int i = F.tid; i < NRB * NBK; i += NWAVES * 64) scn[i] = cnt[i];
    __syncthreads();
    if (F.tid < NBK) { int s = 0; for (int r = 0; r < NRB; ++r) s += scn[r * NBK + F.tid]; sst[32 + F.tid] = s; }
    __syncthreads();
    if (F.tid == 0) { int p = 0; for (int k = 0; k < NBK; ++k) { sst[k] = p; p += (sst[32 + k] + 255) & ~255; } sst[NBK] = p; }
    __syncthreads();
    if (blockIdx.x == 0) {
        if (F.tid <= NBK) seg[F.tid] = sst[F.tid];
        if (F.tid == 32) seg[32] = sst[NBK] / 256;
        for (int t = F.tid; t < sst[NBK] / 256; t += NWAVES * 64) { int k = 0;
#pragma unroll 1
            for (int q = 1; q < NBK; ++q) k += (t * 256 >= sst[q]) ? 1 : 0;
            while (k > 0 && sst[32 + k] == 0) --k;
            tileb[t] = k; }
    }
    if (blockIdx.x < NBK) {
        const int k = blockIdx.x, p0 = sst[k] + sst[32 + k], p1 = sst[k + 1];
        for (int p = p0 + F.tid; p < p1; p += NWAVES * 64) { rowlist[p] = -1; cw[2 * p] = 0.f; cw[2 * p + 1] = 0.f; }
    }
    for (int rb = blockIdx.x; rb < NRB; rb += F.G) {
        if (F.tid < NBK) { int s = 0; for (int r = 0; r < rb; ++r) s += scn[r * NBK + F.tid]; sbase[F.tid] = sst[F.tid] + s; }
        const bool act = F.tid < RB_ROWS;
        const int row = rb * RB_ROWS + (act ? F.tid : 0);
        int4 rt = make_int4(0, 0, 0, 0); int bk = -1, lo = 0;
        if (act) { rt = route[row]; const int a = rt.x & 3, c = rt.y & 3; lo = a < c ? a : c; const int hi = a < c ? c : a; bk = (rt.x >> 2) * 6 + pair_id(lo, hi); }
        const unsigned long long lt = (1ull << F.lane) - 1ull;
        int rank = 0, mycount = 0;
#pragma unroll 1
        for (int q = 0; q < NBK; ++q) { const unsigned long long mk = __ballot(bk == q); if (bk == q) rank = __popcll(mk & lt); if (F.lane == q) mycount = __popcll(mk); }
        if (F.wave == 0 && F.lane < NBK) sw0[F.lane] = mycount;
        __syncthreads();
        if (act) {
            if (F.wave == 1) rank += sw0[bk];
            const int pos = sbase[bk] + rank;
            const float w0 = __int_as_float(rt.z), w1 = __int_as_float(rt.w);
            const bool first_is_lo = (rt.x & 3) == lo;
            rowlist[pos] = row; cw[2 * pos] = first_is_lo ? w0 : w1; cw[2 * pos + 1] = first_is_lo ? w1 : w0;
        }
        __syncthreads();
    }
}

constexpr int CW_HIDCNT = 8192, HIDCNT_STRIDE = 16, HIDCNT_FULL = 32;
struct PairOrder10 {
    static constexpr bool WAITS = false, SIGNALS = true;
    const int* rl; const int* tileb; gu32* cnt; int nunits, G, c, r, bal;
    __device__ __forceinline__ void init(int nunits_, int G_, int c_) { nunits = nunits_; G = G_; c = c_; const int full = nunits / G; r = (nunits - full * G) >> 2; bal = (G % 4 == 0 && full == 2 && 3 * r <= (G >> 2)) ? 1 : 0; }
    __device__ __forceinline__ bool next(int i, pg8::Unit& u) const {
        if (!bal) { const int L = i * G + c; if (L >= nunits) return false; u.pm = L >> 2; u.pn = L & 3; return true; }
        const int q = c >> 2, nq = G >> 2; int tile;
        if (i == 0) tile = q;
        else if (q < r) { if (i == 1) tile = nq + q; else if (i == 2) tile = 2 * nq + q; else return false; }
        else if (q < 2 * r) return false;
        else if (q < 3 * r) { if (i == 1) tile = nq + q - r; else if (i == 2) tile = nq + q; else return false; }
        else { if (i == 1) tile = nq + q; else return false; }
        u.pm = tile; u.pn = c & 3; return true; }
    __device__ __forceinline__ int brow(const pg8::Unit& u) const { const int bk = __builtin_amdgcn_readfirstlane(tileb[u.pm]); int lo, hi; pair_lohi(bk % 6, lo, hi);
        return ((bk / 6) * 4 + ((u.pn >> 1) ? hi : lo)) * 512 + (u.pn & 1) * 256; }
    __device__ __forceinline__ const int* rowlist() const { return rl; }
    __device__ __forceinline__ void a_ready(const pg8::Unit&) const {}
    __device__ __forceinline__ void done(const pg8::Unit& u) const {
        asm volatile("s_waitcnt vmcnt(0)" ::: "memory");
        if ((threadIdx.x & 63) == 0) (void)__hip_atomic_fetch_add(cnt + u.pm * HIDCNT_STRIDE, 1u, RLX_AGENT);
    }
};
struct PairOrder11 {
    static constexpr bool WAITS = true, SIGNALS = false;
    const int* tileb; gu32* cnt; gu32* tmo; int nunits, G, c, full, R, off;
    __device__ __forceinline__ void init(int nunits_, int G_, int c_) { nunits = nunits_; G = G_; c = c_; full = nunits / G; R = nunits - full * G; off = (2 * R <= G) ? R : 0; }
    __device__ __forceinline__ bool next(int i, pg8::Unit& u) const { int L;
        if (i < full) L = i * G + c; else if (i == full && c >= off && c < off + R) L = full * G + (c - off); else return false;
        u.pm = L >> 2; u.pn = L & 3; return true; }
    __device__ __forceinline__ int brow(const pg8::Unit& u) const { const int bk = __builtin_amdgcn_readfirstlane(tileb[u.pm]); return (bk / 6) * 1024 + u.pn * 256; }
    __device__ __forceinline__ void kb(const pg8::Unit& u, int& k0, int& k1) const { const int bk = __builtin_amdgcn_readfirstlane(tileb[u.pm]); int lo, hi; pair_lohi(bk % 6, lo, hi); k0 = lo * 256; k1 = hi * 256; }
    __device__ __forceinline__ const int* rowlist() const { return nullptr; }
    __device__ __forceinline__ void a_ready(const pg8::Unit& u) const {
        if (threadIdx.x == 0) {
            gu32* w = cnt + u.pm * HIDCNT_STRIDE; unsigned sp = 0u;
            while (__hip_atomic_load(w, RLX_AGENT) < (unsigned)HIDCNT_FULL) { __builtin_amdgcn_s_sleep(1);
                if ((++sp & 255u) == 0u) { if (__hip_atomic_load(tmo, RLX_AGENT)) break; if (sp > XB_SPIN_CAP) { (void)__hip_atomic_fetch_add(tmo, 1u, RLX_AGENT); break; } } }
            __builtin_amdgcn_fence(__ATOMIC_ACQUIRE, "agent");
            asm volatile("s_waitcnt vmcnt(0)" ::: "memory");
        }
        __builtin_amdgcn_s_barrier(); asm volatile("" ::: "memory");
    }
    __device__ __forceinline__ void done(const pg8::Unit&) const {}
};
struct EpiHid {
    static constexpr bool PERM = true;
    unsigned char* H; const float* cw;
    __device__ __forceinline__ void operator()(const pg8::f32x4 (&acc)[2][2][4][2], const pg8::Unit& u, int wr_, int wc_, int fr_, int fq_) const {
        int t_ = threadIdx.x; asm volatile("" : "+v"(t_));
        const int wid_ = __builtin_amdgcn_readfirstlane(t_ >> 6), wr = wid_ >> 2, wc = wid_ & 3, fr = t_ & 15, fq = (t_ & 63) >> 4; (void)wr_; (void)wc_; (void)fr_; (void)fq_;
        const int sl = u.pn >> 1; const int col0 = sl * 256 + (u.pn & 1) * 128 + wc * 32 + 8 * fq;
#pragma unroll
        for (int ai = 0; ai < 2; ++ai)
#pragma unroll
            for (int m = 0; m < 4; ++m) { const int pos = u.pm * 256 + ai * 128 + wr * 64 + m * 16 + fr; const float w = cw[(size_t)pos * 2 + sl] * 16.f;
                const pg8::f32x4 g0 = acc[ai][0][m][0], g1 = acc[ai][0][m][1], u0 = acc[ai][1][m][0], u1 = acc[ai][1][m][1];
                float h[8];
#pragma unroll
                for (int j = 0; j < 4; ++j) { h[j] = g0[j] * __builtin_amdgcn_rcpf(1.f + __expf(-g0[j])) * u0[j] * w; h[4 + j] = g1[j] * __builtin_amdgcn_rcpf(1.f + __expf(-g1[j])) * u1[j] * w; }
                int q0 = __builtin_amdgcn_cvt_pk_fp8_f32(h[0], h[1], 0, false); q0 = __builtin_amdgcn_cvt_pk_fp8_f32(h[2], h[3], q0, true);
                int q1 = __builtin_amdgcn_cvt_pk_fp8_f32(h[4], h[5], 0, false); q1 = __builtin_amdgcn_cvt_pk_fp8_f32(h[6], h[7], q1, true);
                __hip_atomic_store((gu64*)(H + (size_t)pos * 512 + col0), ((unsigned long long)(unsigned)q1 << 32) | (unsigned long long)(unsigned)q0, RLX_AGENT); }
    }
};
constexpr size_t WS_XBUF = 5 * MiB, XBUF_BYTES = (size_t)MAXPOS * 4 * 8;
struct EpiFinal {
    static constexpr bool PERM = true;
    const int* rl; const float* gt; const pg8::bf16_t* x1; float* out; const float* gf; unsigned long long* xbuf; LAS unsigned char* xl;
    __device__ __forceinline__ void operator()(const pg8::f32x4 (&acc)[2][2][4][2], const pg8::Unit& u, int wr_, int wc_, int fr_, int fq_) const {
        int t_ = threadIdx.x; asm volatile("" : "+v"(t_));
        const int wid_ = __builtin_amdgcn_readfirstlane(t_ >> 6), wr = wid_ >> 2, wc = wid_ & 3, fr = t_ & 15, fq = (t_ & 63) >> 4; (void)wr_; (void)wc_; (void)fr_; (void)fq_;
        LAS float* Pl = (LAS float*)xl; LAS float* Sl = (LAS float*)(xl + 4096);
        const int col0 = u.pn * 256 + wc * 32 + 8 * fq;
        pg8::f32x4 v[2][2][4][2]; int tok[2][4];
#pragma unroll
        for (int ai = 0; ai < 2; ++ai) {
#pragma unroll
            for (int m = 0; m < 4; ++m) tok[ai][m] = rl[u.pm * 256 + ai * 128 + wr * 64 + m * 16 + fr];
#pragma unroll
            for (int m = 0; m < 4; ++m) { const int t = tok[ai][m]; float s = 0.f;
                if (t >= 0) { const float* g = gt + (size_t)(t / SEQ) * NMOD + col0; const pg8::bf16_t* o = x1 + (size_t)t * 2048 + col0;
#pragma unroll
                    for (int bj = 0; bj < 2; ++bj) { const pg8::f32x4 g0 = *(const pg8::f32x4*)(g + bj * 128), g1 = *(const pg8::f32x4*)(g + bj * 128 + 4); const pg8::u32x4 xv = *(const pg8::u32x4*)(o + bj * 128);
                        const pg8::f32x4 a0 = acc[ai][bj][m][0], a1 = acc[ai][bj][m][1];
                        const pg8::f32x4 y0 = {bfl(xv.x) + g0[0] * a0[0], bfh(xv.x) + g0[1] * a0[1], bfl(xv.y) + g0[2] * a0[2], bfh(xv.y) + g0[3] * a0[3]};
                        const pg8::f32x4 y1 = {bfl(xv.z) + g1[0] * a1[0], bfh(xv.z) + g1[1] * a1[1], bfl(xv.w) + g1[2] * a1[2], bfh(xv.w) + g1[3] * a1[3]};
                        v[ai][bj][m][0] = y0; v[ai][bj][m][1] = y1;
                        s += (y0[0] * y0[0] + y0[1] * y0[1]) + (y0[2] * y0[2] + y0[3] * y0[3]) + (y1[0] * y1[0] + y1[1] * y1[1]) + (y1[2] * y1[2] + y1[3] * y1[3]); } }
                else {
#pragma unroll
                    for (int bj = 0; bj < 2; ++bj) { v[ai][bj][m][0] = (pg8::f32x4){0.f, 0.f, 0.f, 0.f}; v[ai][bj][m][1] = (pg8::f32x4){0.f, 0.f, 0.f, 0.f}; } }
                s += __shfl_xor(s, 16); s += __shfl_xor(s, 32);
                if (fq == 0) Pl[(ai * 128 + wr * 64 + m * 16 + fr) * 4 + wc] = s; }
        }
        asm volatile("s_waitcnt lgkmcnt(0)" ::: "memory"); __builtin_amdgcn_s_barrier(); asm volatile("" ::: "memory");
        if (t_ < 256) {
            const float ps = (Pl[t_ * 4 + 0] + Pl[t_ * 4 + 1]) + (Pl[t_ * 4 + 2] + Pl[t_ * 4 + 3]);
            unsigned long long* slot = xbuf + (size_t)(u.pm * 256 + t_) * 4;
            __hip_atomic_store(slot + u.pn, (1ull << 32) | (unsigned long long)__float_as_uint(ps), __ATOMIC_RELAXED, __HIP_MEMORY_SCOPE_AGENT);
            float tot = 0.f;
            for (unsigned sp = 0; sp < (1u << 16); ++sp) {
                const unsigned long long g0 = __hip_atomic_load(slot + 0, __ATOMIC_RELAXED, __HIP_MEMORY_SCOPE_AGENT), g1 = __hip_atomic_load(slot + 1, __ATOMIC_RELAXED, __HIP_MEMORY_SCOPE_AGENT),
                                         g2 = __hip_atomic_load(slot + 2, __ATOMIC_RELAXED, __HIP_MEMORY_SCOPE_AGENT), g3 = __hip_atomic_load(slot + 3, __ATOMIC_RELAXED, __HIP_MEMORY_SCOPE_AGENT);
                tot = (__uint_as_float((unsigned)g0) + __uint_as_float((unsigned)g1)) + (__uint_as_float((unsigned)g2) + __uint_as_float((unsigned)g3));
                if (((g0 >> 32) & (g1 >> 32) & (g2 >> 32) & (g3 >> 32)) == 1ull) break;
                __builtin_amdgcn_s_sleep(2);
            }
            Sl[t_] = rsqrtf(tot * (1.f / D) + EPS);
        }
        asm volatile("s_waitcnt vmcnt(0) lgkmcnt(0)" ::: "memory"); __builtin_amdgcn_s_barrier(); asm volatile("" ::: "memory");
#pragma unroll
        for (int ai = 0; ai < 2; ++ai)
#pragma unroll
            for (int m = 0; m < 4; ++m) { const int t = tok[ai][m];
                if (t >= 0) { const float rstd = Sl[ai * 128 + wr * 64 + m * 16 + fr]; float* o = out + (size_t)t * D + col0;
#pragma unroll
                    for (int bj = 0; bj < 2; ++bj) { const pg8::f32x4 f0 = *(const pg8::f32x4*)(gf + col0 + bj * 128), f1 = *(const pg8::f32x4*)(gf + col0 + bj * 128 + 4);
                        *(pg8::f32x4*)(o + bj * 128) = v[ai][bj][m][0] * rstd * f0; *(pg8::f32x4*)(o + bj * 128 + 4) = v[ai][bj][m][1] * rstd * f1; } } }
        asm volatile("s_waitcnt lgkmcnt(0)" ::: "memory"); __builtin_amdgcn_s_barrier(); asm volatile("" ::: "memory");
    }
};
constexpr int SWA_KP = 144, SWA_VP = 520, SWA_OP = 144;
constexpr int SWA_KS = 0, SWA_VT = 256 * SWA_KP, SWA_OS = SWA_VT + 64 * SWA_VP, SWA_LDS = SWA_OS + 8 * 32 * SWA_OP;
static_assert(SWA_LDS <= RING_BYTES, "swa lds");
__device__ __forceinline__ float fast_sigmoid(float x) { return __builtin_amdgcn_rcpf(1.f + __expf(-x)); }

__device__ __forceinline__ void p6_swa_merge(Frame& F0, bf16* P, bf16* Mg, const bf16* OA, const float* sink) {
    Frame F = F0; { int t__ = threadIdx.x; asm volatile("" : "+v"(t__)); F.tid = t__; F.lane = t__ & 63; F.wave = __builtin_amdgcn_readfirstlane(t__ >> 6); }
    const int lane = F.lane, w = F.wave, q = lane & 31, h = lane >> 5, tid = F.tid;
    LAS unsigned char* Ks = F.lds + RING_OFF + SWA_KS;
    LAS unsigned char* Vt = F.lds + RING_OFF + SWA_VT;
    LAS unsigned char* Os = F.lds + RING_OFF + SWA_OS + w * (32 * SWA_OP);
    constexpr float L2E = 1.4426950408889634f, CS = 0.125f * L2E;
    for (int unit = blockIdx.x; unit < NB * 64 * 2; unit += F.G) {
        const int hk = unit & 1, qb = (unit >> 1) & 63, b = unit >> 7;
        const int t0 = qb * 128; const size_t rowbase = (size_t)b * SEQ;
        LDS_BARRIER();
        {
        {
            const int pc = tid & 7;
            v4u kv[4], vv[4];
#pragma unroll
            for (int i = 0; i < 4; ++i) { const int kr = (tid >> 3) + 64 * i; int tp = t0 - 128 + kr; tp = tp < 0 ? 0 : tp;
                const bf16* src = P + (rowbase + tp) * PWB;
                kv[i] = *(const v4u*)(src + PE_KB + hk * 64 + pc * 8); vv[i] = *(const v4u*)(src + PE_VB + hk * 64 + pc * 8); }
#pragma unroll
            for (int i = 0; i < 4; ++i) { const int kr = (tid >> 3) + 64 * i;
                *(LAS v4u*)(Ks + kr * SWA_KP + pc * 16) = kv[i];
                const unsigned wds[4] = {vv[i].x, vv[i].y, vv[i].z, vv[i].w};
#pragma unroll
                for (int e = 0; e < 4; ++e) { const int d = pc * 8 + e * 2;
                    *(LAS unsigned short*)(Vt + d * SWA_VP + kr * 2) = (unsigned short)(wds[e] & 0xffffu);
                    *(LAS unsigned short*)(Vt + (d + 1) * SWA_VP + kr * 2) = (unsigned short)(wds[e] >> 16); }
            }
        }
        }
        LDS_BARRIER();
        const int head = hk * 8 + w; const float snk = sink[head] * L2E;
        bf16x8 qf_n[4];
        { const bf16* qp = P + (rowbase + t0 + q) * PWB + PE_QB + head * 64 + 8 * h;
#pragma unroll
          for (int kk = 0; kk < 4; ++kk) qf_n[kk] = *(const bf16x8*)(qp + 16 * kk); }
        for (int sb = 0; sb < 4; ++sb) {
            const int q0 = t0 + 32 * sb;
            bf16x8 qf[4];
#pragma unroll
            for (int kk = 0; kk < 4; ++kk) qf[kk] = qf_n[kk];
            const int mq = lane >> 3, mp8 = lane & 7; const size_t mrow = rowbase + q0 + mq; const int mcol = head * 64 + 8 * mp8;
            u32x2 gav[4], gbv[4]; v4u oav[4];
#pragma unroll
            for (int i = 0; i < 4; ++i) { const size_t r = mrow + 8 * i;
                gav[i] = *(const u32x2*)((const unsigned char*)(P + r * PWB) + PC_GA + mcol); gbv[i] = *(const u32x2*)((const unsigned char*)(P + r * PWB) + PC_GB + mcol); oav[i] = *(const v4u*)(OA + r * D + mcol); }
            if (sb < 3) { const bf16* qp = P + (rowbase + q0 + 32 + q) * PWB + PE_QB + head * 64 + 8 * h;
#pragma unroll
                for (int kk = 0; kk < 4; ++kk) qf_n[kk] = *(const bf16x8*)(qp + 16 * kk); }
            f32x16 O0, O1; float inv;
            {
            f32x16 S[5];
#pragma unroll
            for (int kt = 0; kt < 5; ++kt) {
                f32x16 acc = {0.f, 0.f, 0.f, 0.f, 0.f, 0.f, 0.f, 0.f, 0.f, 0.f, 0.f, 0.f, 0.f, 0.f, 0.f, 0.f};
#pragma unroll
                for (int kk = 0; kk < 4; ++kk) { const bf16x8 a = *(const LAS bf16x8*)(Ks + (32 * (sb + kt) + q) * SWA_KP + (16 * kk + 8 * h) * 2);
                    acc = __builtin_amdgcn_mfma_f32_32x32x16_bf16(a, qf[kk], acc, 0, 0, 0); }
                S[kt] = acc;
            }
            float mx = snk;
#pragma unroll
            for (int kt = 0; kt < 5; ++kt)
#pragma unroll
                for (int r = 0; r < 16; ++r) { const int kin = (r & 3) + 8 * (r >> 2) + 4 * h;
                    bool ok = (q0 - 128 + 32 * kt + kin) >= 0;
                    if (kt == 0) ok = ok && (kin > q);
                    if (kt == 4) ok = ok && (kin <= q);
                    const float v = ok ? S[kt][r] * CS : -1.0e30f; S[kt][r] = v; mx = fmaxf(mx, v); }
            mx = fmaxf(mx, __shfl_xor(mx, 32));
            float sum = 0.f;
#pragma unroll
            for (int kt = 0; kt < 5; ++kt)
#pragma unroll
                for (int r = 0; r < 16; ++r) { const float p = __builtin_amdgcn_exp2f(S[kt][r] - mx); S[kt][r] = p; sum += p; }
            sum += __shfl_xor(sum, 32); sum += __builtin_amdgcn_exp2f(snk - mx);
            inv = 1.f / sum;
            O0 = (f32x16){0.f, 0.f, 0.f, 0.f, 0.f, 0.f, 0.f, 0.f, 0.f, 0.f, 0.f, 0.f, 0.f, 0.f, 0.f, 0.f}; O1 = O0;
#pragma unroll
            for (int kt = 0; kt < 5; ++kt)
#pragma unroll
                for (int s = 0; s < 2; ++s) {
                    v4u pw; pw.x = pg8::cvt_pk_bf16(S[kt][8 * s + 0], S[kt][8 * s + 1]); pw.y = pg8::cvt_pk_bf16(S[kt][8 * s + 2], S[kt][8 * s + 3]);
                    pw.z = pg8::cvt_pk_bf16(S[kt][8 * s + 4], S[kt][8 * s + 5]); pw.w = pg8::cvt_pk_bf16(S[kt][8 * s + 6], S[kt][8 * s + 7]);
                    const bf16x8 pf = __builtin_bit_cast(bf16x8, pw);
                    const int kidx = 32 * (sb + kt) + 16 * s + 4 * h;
                    const u32x2 a0l = *(const LAS u32x2*)(Vt + q * SWA_VP + kidx * 2), a0h = *(const LAS u32x2*)(Vt + q * SWA_VP + (kidx + 8) * 2);
                    const u32x2 a1l = *(const LAS u32x2*)(Vt + (q + 32) * SWA_VP + kidx * 2), a1h = *(const LAS u32x2*)(Vt + (q + 32) * SWA_VP + (kidx + 8) * 2);
                    const v4u a0 = {a0l.x, a0l.y, a0h.x, a0h.y}, a1 = {a1l.x, a1l.y, a1h.x, a1h.y};
                    O0 = __builtin_amdgcn_mfma_f32_32x32x16_bf16(__builtin_bit_cast(bf16x8, a0), pf, O0, 0, 0, 0);
                    O1 = __builtin_amdgcn_mfma_f32_32x32x16_bf16(__builtin_bit_cast(bf16x8, a1), pf, O1, 0, 0, 0);
                }
            asm volatile("" : "+v"(O0), "+v"(O1));
            }
#pragma unroll
            for (int g4 = 0; g4 < 4; ++g4) {
                u32x2 o0, o1;
                o0.x = pg8::cvt_pk_bf16(O0[4 * g4 + 0] * inv, O0[4 * g4 + 1] * inv); o0.y = pg8::cvt_pk_bf16(O0[4 * g4 + 2] * inv, O0[4 * g4 + 3] * inv);
                o1.x = pg8::cvt_pk_bf16(O1[4 * g4 + 0] * inv, O1[4 * g4 + 1] * inv); o1.y = pg8::cvt_pk_bf16(O1[4 * g4 + 2] * inv, O1[4 * g4 + 3] * inv);
                *(LAS u32x2*)(Os + q * SWA_OP + (8 * g4 + 4 * h) * 2) = o0;
                *(LAS u32x2*)(Os + q * SWA_OP + (32 + 8 * g4 + 4 * h) * 2) = o1;
            }
            asm volatile("s_waitcnt lgkmcnt(0)" ::: "memory");
            {
#pragma unroll
                for (int i = 0; i < 4; ++i) {
                    const v4u ob = *(const LAS v4u*)(Os + (mq + 8 * i) * SWA_OP + mp8 * 16), oa = oav[i]; const u32x2 ga = gav[i], gb = gbv[i];
                    float sa[8], sb[8]; constexpr float I255 = 1.f / 255.f;
#pragma unroll
                    for (int j = 0; j < 4; ++j) { sa[j] = (float)((ga.x >> (8 * j)) & 0xffu) * I255; sa[4 + j] = (float)((ga.y >> (8 * j)) & 0xffu) * I255;
                                                  sb[j] = (float)((gb.x >> (8 * j)) & 0xffu) * I255; sb[4 + j] = (float)((gb.y >> (8 * j)) & 0xffu) * I255; }
                    v4u o;
                    o.x = pg8::cvt_pk_bf16(sa[0] * bfl(oa.x) + sb[0] * bfl(ob.x), sa[1] * bfh(oa.x) + sb[1] * bfh(ob.x));
                    o.y = pg8::cvt_pk_bf16(sa[2] * bfl(oa.y) + sb[2] * bfl(ob.y), sa[3] * bfh(oa.y) + sb[3] * bfh(ob.y));
                    o.z = pg8::cvt_pk_bf16(sa[4] * bfl(oa.z) + sb[4] * bfl(ob.z), sa[5] * bfh(oa.z) + sb[5] * bfh(ob.z));
                    o.w = pg8::cvt_pk_bf16(sa[6] * bfl(oa.w) + sb[6] * bfl(ob.w), sa[7] * bfh(oa.w) + sb[7] * bfh(ob.w));
                    *(v4u*)(Mg + (mrow + 8 * i) * D + mcol) = o;
                }
            }
            asm volatile("s_waitcnt lgkmcnt(0)" ::: "memory");
        }
    }
}
constexpr int GLA_SC = 256, GLA_NSC = SEQ / GLA_SC, GLA_UNITS = NB * GLA_NSC * 4;
constexpr size_t OUT_ST = 0, OUT_DEC = 32 * MiB, OUT_OA = 64 * MiB;
constexpr int G3_ZT = 0, G3_KRAW = 2048, G3_TOT = G3_KRAW + 32 * 272, G3_BT = G3_TOT + 2048, G3_KTE = G3_BT + 16384, G3_VT = G3_KTE + 128 * 80, G3_DEC = G3_VT + 256 * 80, G3_END = G3_DEC + 512;
static_assert(G3_END <= RING_BYTES, "gla p3 lds");
constexpr int G5_KT = 0, G5_VT = 32 * 272, G5_OS = 32768, G5_ST = 32768, G5_END = G5_ST + 65536;
static_assert(G5_VT + 256 * 80 <= G5_OS && G5_OS + 8 * 32 * 144 <= G5_END && G5_END <= RING_BYTES, "gla p5 lds");

__device__ __forceinline__ unsigned pk_bf16(float lo, float hi) { return pg8::cvt_pk_bf16(lo, hi); }

__device__ __forceinline__ void p3_gla_upd(Frame& F0, bf16* P, const float* w_gk2, const float* b_gk, unsigned char* outb) {
    Frame F = F0; { int t__ = threadIdx.x; asm volatile("" : "+v"(t__)); F.tid = t__; F.lane = t__ & 63; F.wave = __builtin_amdgcn_readfirstlane(t__ >> 6); }
    const int tid = F.tid, lane = F.lane, w = F.wave;
    LAS unsigned char* L = F.lds + RING_OFF;
    LAS float* zt = (LAS float*)(L + G3_ZT); LAS unsigned char* kraw = L + G3_KRAW; LAS float* tot = (LAS float*)(L + G3_TOT); LAS float* bt = (LAS float*)(L + G3_BT);
    LAS unsigned char* kte = L + G3_KTE; LAS unsigned char* vt_ = L + G3_VT; LAS float* decl = (LAS float*)(L + G3_DEC);
    bf16* ST = (bf16*)(outb + OUT_ST); float* DEC = (float*)(outb + OUT_DEC);
    const int gk = tid & 127, gq = tid >> 7;
    const int rt = tid >> 4, rq = tid & 15;
    const int vp = tid & 127;
    const int ktile = w >> 1, vt0 = 4 * (w & 1), vl = lane & 31, hh = lane >> 5;
    constexpr float QS = 0.08838834764831845f;
    for (int unit = blockIdx.x; unit < GLA_UNITS; unit += F.G) {
        const int head = unit & 3, sc = (unit >> 2) & 31, b = unit >> 7;
        const size_t row0 = (size_t)b * SEQ + (size_t)sc * GLA_SC;
        float wreg[16];
#pragma unroll
        for (int r = 0; r < 16; ++r) wreg[r] = w_gk2[r * 512 + head * 128 + gk];
        const float bias = b_gk[head * 128 + gk];
        float carry = 0.f;
        f32x16 acc[4];
#pragma unroll
        for (int i = 0; i < 4; ++i) acc[i] = (f32x16){0.f, 0.f, 0.f, 0.f, 0.f, 0.f, 0.f, 0.f, 0.f, 0.f, 0.f, 0.f, 0.f, 0.f, 0.f, 0.f};
        v4u qraw_n, kr_n; unsigned short z_n; unsigned vraw_n[8];
        { const size_t trow = row0;
          qraw_n = *(const v4u*)(P + (trow + rt) * PWB + PE_QA + head * 128 + 8 * rq); kr_n = *(const v4u*)(P + (trow + rt) * PWB + PE_KA + head * 128 + 8 * rq);
          z_n = P[(trow + rt) * PWB + PE_Z + rq];
#pragma unroll
          for (int c = 0; c < 8; ++c) vraw_n[c] = *(const unsigned*)(P + (trow + 8 * gq + c) * PWB + PE_VA + head * 256 + 2 * vp); }
        for (int st = 0; st < 8; ++st) {
            const size_t trow = row0 + 32 * st;
            bf16* qptr = P + (trow + rt) * PWB + PE_QA + head * 128 + 8 * rq; bf16* kptr = P + (trow + rt) * PWB + PE_KA + head * 128 + 8 * rq;
            const v4u qraw = qraw_n, kr = kr_n;
            const float zval = __uint_as_float(((unsigned)z_n) << 16);
            unsigned vraw[8];
#pragma unroll
            for (int c = 0; c < 8; ++c) vraw[c] = vraw_n[c];
            if (st < 7) { const size_t nrow = trow + 32;
                qraw_n = *(const v4u*)(P + (nrow + rt) * PWB + PE_QA + head * 128 + 8 * rq); kr_n = *(const v4u*)(P + (nrow + rt) * PWB + PE_KA + head * 128 + 8 * rq);
                z_n = P[(nrow + rt) * PWB + PE_Z + rq];
#pragma unroll
                for (int c = 0; c < 8; ++c) vraw_n[c] = *(const unsigned*)(P + (nrow + 8 * gq + c) * PWB + PE_VA + head * 256 + 2 * vp); }
            LDS_BARRIER();
            *(LAS v4u*)(kraw + rt * 272 + rq * 16) = kr;
            zt[rt * 16 + rq] = zval;
            LDS_BARRIER();
            float cs[8]; float cum = 0.f;
#pragma unroll
            for (int c = 0; c < 8; ++c) { float x = bias; const LAS float* zr = zt + (8 * gq + c) * 16;
#pragma unroll
                for (int r = 0; r < 16; ++r) x += zr[r] * wreg[r];
                const float ls = fminf(x, 0.f) - __logf(1.f + __expf(-fabsf(x)));
                cum += ls * 0.0625f; cs[c] = cum; }
            tot[gq * 128 + gk] = cum;
            LDS_BARRIER();
            {
                const float t0 = tot[gk], t1 = tot[128 + gk], t2 = tot[256 + gk], t3 = tot[384 + gk];
                const float prefix = (gq > 0 ? t0 : 0.f) + (gq > 1 ? t1 : 0.f) + (gq > 2 ? t2 : 0.f), ttot = (t0 + t1) + (t2 + t3);
                float kv[8];
#pragma unroll
                for (int c = 0; c < 8; ++c) { const int t = 8 * gq + c; bt[t * 128 + gk] = carry + prefix + cs[c];
                    const float kx = __uint_as_float(((unsigned)*(const LAS unsigned short*)(kraw + t * 272 + gk * 2)) << 16);
                    kv[c] = kx * __expf(ttot - prefix - cs[c]); }
                v4u ko; ko.x = pk_bf16(kv[0], kv[1]); ko.y = pk_bf16(kv[2], kv[3]); ko.z = pk_bf16(kv[4], kv[5]); ko.w = pk_bf16(kv[6], kv[7]);
                *(LAS v4u*)(kte + gk * 80 + gq * 16) = ko;
                if (gq == 0) decl[gk] = __expf(ttot);
                carry += ttot;
                v4u v0, v1;
                v0.x = (vraw[0] & 0xffffu) | (vraw[1] << 16); v0.y = (vraw[2] & 0xffffu) | (vraw[3] << 16); v0.z = (vraw[4] & 0xffffu) | (vraw[5] << 16); v0.w = (vraw[6] & 0xffffu) | (vraw[7] << 16);
                v1.x = (vraw[0] >> 16) | (vraw[1] & 0xffff0000u); v1.y = (vraw[2] >> 16) | (vraw[3] & 0xffff0000u); v1.z = (vraw[4] >> 16) | (vraw[5] & 0xffff0000u); v1.w = (vraw[6] >> 16) | (vraw[7] & 0xffff0000u);
                *(LAS v4u*)(vt_ + (2 * vp) * 80 + gq * 16) = v0;
                *(LAS v4u*)(vt_ + (2 * vp + 1) * 80 + gq * 16) = v1;
            }
            LDS_BARRIER();
            {
#pragma unroll
                for (int g4 = 0; g4 < 4; ++g4) { const f32x4 d4 = *(const LAS f32x4*)(decl + 32 * ktile + 8 * g4 + 4 * hh);
#pragma unroll
                    for (int i = 0; i < 4; ++i) { acc[i][4 * g4 + 0] *= d4.x; acc[i][4 * g4 + 1] *= d4.y; acc[i][4 * g4 + 2] *= d4.z; acc[i][4 * g4 + 3] *= d4.w; } }
#pragma unroll
                for (int s = 0; s < 2; ++s) {
                    const bf16x8 a = *(const LAS bf16x8*)(kte + (32 * ktile + vl) * 80 + (16 * s + 8 * hh) * 2);
#pragma unroll
                    for (int i = 0; i < 4; ++i) { const bf16x8 bb = *(const LAS bf16x8*)(vt_ + (32 * (vt0 + i) + vl) * 80 + (16 * s + 8 * hh) * 2);
                        acc[i] = __builtin_amdgcn_mfma_f32_32x32x16_bf16(a, bb, acc[i], 0, 0, 0); }
                }
                const f32x4 b0 = *(const LAS f32x4*)(bt + rt * 128 + 8 * rq), b1 = *(const LAS f32x4*)(bt + rt * 128 + 8 * rq + 4);
                const float bb8[8] = {b0.x, b0.y, b0.z, b0.w, b1.x, b1.y, b1.z, b1.w};
                const unsigned qw[4] = {qraw.x, qraw.y, qraw.z, qraw.w}, kw[4] = {kr.x, kr.y, kr.z, kr.w};
                unsigned qo[4], ko[4];
#pragma unroll
                for (int e = 0; e < 4; ++e) {
                    qo[e] = pk_bf16(bfl(qw[e]) * QS * __expf(bb8[2 * e]), bfh(qw[e]) * QS * __expf(bb8[2 * e + 1]));
                    ko[e] = pk_bf16(bfl(kw[e]) * __expf(-bb8[2 * e]), bfh(kw[e]) * __expf(-bb8[2 * e + 1])); }
                *(v4u*)qptr = (v4u){qo[0], qo[1], qo[2], qo[3]};
                *(v4u*)kptr = (v4u){ko[0], ko[1], ko[2], ko[3]};
            }
        }
        bf16* stu = ST + (size_t)unit * 32768;
#pragma unroll
        for (int i = 0; i < 4; ++i)
#pragma unroll
            for (int g4 = 0; g4 < 4; ++g4) {
                const int kk = 2 * ktile + (g4 >> 1), fh = g4 & 1;
                u32x2 o; o.x = pk_bf16(acc[i][4 * g4 + 0], acc[i][4 * g4 + 1]); o.y = pk_bf16(acc[i][4 * g4 + 2], acc[i][4 * g4 + 3]);
                *(u32x2*)(stu + ((((vt0 + i) * 8 + kk) * 64 + fh * 32 + vl) * 8 + 4 * hh)) = o;
            }
        if (gq == 0) DEC[unit * 128 + gk] = __expf(carry);
    }
}

__device__ __forceinline__ void p4_gla_scan(Frame& F0, unsigned char* outb) {
    Frame F = F0; { int t__ = threadIdx.x; asm volatile("" : "+v"(t__)); F.tid = t__; F.lane = t__ & 63; F.wave = __builtin_amdgcn_readfirstlane(t__ >> 6); }
    bf16* ST = (bf16*)(outb + OUT_ST); const float* DEC = (const float*)(outb + OUT_DEC);
    for (int gt = blockIdx.x * (NWAVES * 64) + F.tid; gt < 16 * 8192; gt += F.G * NWAVES * 64) {
        const int pair = gt >> 13, e4 = gt & 8191, b = pair >> 2, head = pair & 3;
        const int Ln = (e4 >> 1) & 63, kk = (e4 >> 7) & 7, k0 = 16 * kk + 8 * (Ln >> 5) + 4 * (e4 & 1);
        const size_t ub0 = (size_t)(b * 32 * 4 + head);
        float s0 = 0.f, s1 = 0.f, s2 = 0.f, s3 = 0.f;
        u32x2 uq[4]; f32x4 dq[4];
#pragma unroll
        for (int i = 0; i < 4; ++i) { uq[i] = *(const u32x2*)(ST + (ub0 + 4 * i) * 32768 + 4 * e4); dq[i] = *(const f32x4*)(DEC + (ub0 + 4 * i) * 128 + k0); }
        for (int sc = 0; sc < GLA_NSC; sc += 4) {
#pragma unroll
            for (int i = 0; i < 4; ++i) {
                const size_t ub = ub0 + 4 * (sc + i);
                const u32x2 u = uq[i]; const f32x4 d = dq[i];
                if (sc + 4 < GLA_NSC) { uq[i] = *(const u32x2*)(ST + (ub + 16) * 32768 + 4 * e4); dq[i] = *(const f32x4*)(DEC + (ub + 16) * 128 + k0); }
                u32x2 o; o.x = pk_bf16(s0, s1); o.y = pk_bf16(s2, s3);
                *(u32x2*)(ST + ub * 32768 + 4 * e4) = o;
                s0 = d.x * s0 + bfl(u.x); s1 = d.y * s1 + bfh(u.x); s2 = d.z * s2 + bfl(u.y); s3 = d.w * s3 + bfh(u.y);
            }
        }
    }
}

__device__ __forceinline__ void p5_gla_out(Frame& F0, const bf16* P, const float* gng, unsigned char* outb) {
    Frame F = F0; { int t__ = threadIdx.x; asm volatile("" : "+v"(t__)); F.tid = t__; F.lane = t__ & 63; F.wave = __builtin_amdgcn_readfirstlane(t__ >> 6); }
    const int tid = F.tid, lane = F.lane, w = F.wave, vl = lane & 31, hh = lane >> 5;
    LAS unsigned char* L = F.lds + RING_OFF;
    LAS unsigned char* Kt = L + G5_KT; LAS unsigned char* Vt = L + G5_VT; LAS unsigned char* Os = L + G5_OS + w * (32 * 144);
    const bf16* ST = (const bf16*)(outb + OUT_ST); bf16* OA = (bf16*)(outb + OUT_OA);
    const int rt = tid >> 4, rq = tid & 15, vp = tid & 127, gq = tid >> 7;
    for (int unit = blockIdx.x; unit < GLA_UNITS; unit += F.G) {
        const int head = unit & 3, sc = (unit >> 2) & 31, b = unit >> 7;
        const size_t row0 = (size_t)b * SEQ + (size_t)sc * GLA_SC;
        bf16x8 qf[8];
        { const bf16* qp = P + (row0 + 32 * w + vl) * PWB + PE_QA + head * 128 + 8 * hh;
#pragma unroll
          for (int kk = 0; kk < 8; ++kk) qf[kk] = *(const bf16x8*)(qp + 16 * kk); }
        f32x16 acc[8];
        { const v4u* stg = (const v4u*)(ST + (size_t)unit * 32768) + tid; v4u sv[8];
#pragma unroll
          for (int i = 0; i < 8; ++i) sv[i] = stg[i * 512];
          LDS_BARRIER();
#pragma unroll
          for (int i = 0; i < 8; ++i) *(LAS v4u*)(L + G5_ST + (tid + i * 512) * 16) = sv[i];
          LDS_BARRIER();
#pragma unroll
          for (int vt = 0; vt < 8; ++vt) { f32x16 a16 = {0.f, 0.f, 0.f, 0.f, 0.f, 0.f, 0.f, 0.f, 0.f, 0.f, 0.f, 0.f, 0.f, 0.f, 0.f, 0.f};
#pragma unroll
              for (int kk = 0; kk < 8; ++kk) { const bf16x8 a = *(const LAS bf16x8*)(L + G5_ST + ((vt * 8 + kk) * 64 + lane) * 16); a16 = __builtin_amdgcn_mfma_f32_32x32x16_bf16(a, qf[kk], a16, 0, 0, 0); }
              acc[vt] = a16; } }
        v4u kr_n; unsigned vraw_n[8];
        { kr_n = *(const v4u*)(P + (row0 + rt) * PWB + PE_KA + head * 128 + 8 * rq);
#pragma unroll
          for (int c = 0; c < 8; ++c) vraw_n[c] = *(const unsigned*)(P + (row0 + 8 * gq + c) * PWB + PE_VA + head * 256 + 2 * vp); }
        for (int jt = 0; jt < 8; ++jt) {
            const v4u kr = kr_n; unsigned vraw[8];
#pragma unroll
            for (int c = 0; c < 8; ++c) vraw[c] = vraw_n[c];
            if (jt < 7) { const size_t nrow = row0 + 32 * (jt + 1);
                kr_n = *(const v4u*)(P + (nrow + rt) * PWB + PE_KA + head * 128 + 8 * rq);
#pragma unroll
                for (int c = 0; c < 8; ++c) vraw_n[c] = *(const unsigned*)(P + (nrow + 8 * gq + c) * PWB + PE_VA + head * 256 + 2 * vp); }
            LDS_BARRIER();
            *(LAS v4u*)(Kt + rt * 272 + rq * 16) = kr;
            { v4u v0, v1;
              v0.x = (vraw[0] & 0xffffu) | (vraw[1] << 16); v0.y = (vraw[2] & 0xffffu) | (vraw[3] << 16); v0.z = (vraw[4] & 0xffffu) | (vraw[5] << 16); v0.w = (vraw[6] & 0xffffu) | (vraw[7] << 16);
              v1.x = (vraw[0] >> 16) | (vraw[1] & 0xffff0000u); v1.y = (vraw[2] >> 16) | (vraw[3] & 0xffff0000u); v1.z = (vraw[4] >> 16) | (vraw[5] & 0xffff0000u); v1.w = (vraw[6] >> 16) | (vraw[7] & 0xffff0000u);
              *(LAS v4u*)(Vt + (2 * vp) * 80 + gq * 16) = v0; *(LAS v4u*)(Vt + (2 * vp + 1) * 80 + gq * 16) = v1; }
            LDS_BARRIER();
            if (w >= jt) {
                f32x16 X = {0.f, 0.f, 0.f, 0.f, 0.f, 0.f, 0.f, 0.f, 0.f, 0.f, 0.f, 0.f, 0.f, 0.f, 0.f, 0.f};
#pragma unroll
                for (int kk = 0; kk < 8; ++kk) { const bf16x8 a = *(const LAS bf16x8*)(Kt + vl * 272 + (16 * kk + 8 * hh) * 2); X = __builtin_amdgcn_mfma_f32_32x32x16_bf16(a, qf[kk], X, 0, 0, 0); }
                if (w == jt) {
#pragma unroll
                    for (int r = 0; r < 16; ++r) { const int j = (r & 3) + 8 * (r >> 2) + 4 * hh; X[r] = (j <= vl) ? X[r] : 0.f; }
                }
                bf16x8 pf[2];
#pragma unroll
                for (int s = 0; s < 2; ++s) { v4u pw; pw.x = pk_bf16(X[8 * s + 0], X[8 * s + 1]); pw.y = pk_bf16(X[8 * s + 2], X[8 * s + 3]); pw.z = pk_bf16(X[8 * s + 4], X[8 * s + 5]); pw.w = pk_bf16(X[8 * s + 6], X[8 * s + 7]);
                    pf[s] = __builtin_bit_cast(bf16x8, pw); }
#pragma unroll
                for (int vt = 0; vt < 8; ++vt)
#pragma unroll
                    for (int s = 0; s < 2; ++s) {
                        const u32x2 lo = *(const LAS u32x2*)(Vt + (32 * vt + vl) * 80 + (16 * s + 4 * hh) * 2), hi = *(const LAS u32x2*)(Vt + (32 * vt + vl) * 80 + (16 * s + 8 + 4 * hh) * 2);
                        const v4u av = {lo.x, lo.y, hi.x, hi.y};
                        acc[vt] = __builtin_amdgcn_mfma_f32_32x32x16_bf16(__builtin_bit_cast(bf16x8, av), pf[s], acc[vt], 0, 0, 0);
                    }
            }
        }
        float ssq = 0.f;
#pragma unroll
        for (int vt = 0; vt < 8; ++vt)
#pragma unroll
            for (int r = 0; r < 16; ++r) ssq += acc[vt][r] * acc[vt][r];
        ssq += __shfl_xor(ssq, 32);
        const float rstd = rsqrtf(ssq * (1.f / 256.f) + EPS);
        const int mq = lane >> 3, mp8 = lane & 7; const size_t orow = row0 + 32 * w + mq;
        u32x2 rv_n[4];
#pragma unroll
        for (int i = 0; i < 4; ++i) rv_n[i] = *(const u32x2*)((const unsigned char*)(P + (orow + 8 * i) * PWB) + head * 256 + 8 * mp8);
#pragma unroll
        for (int c = 0; c < 4; ++c) {
            u32x2 rvc[4];
#pragma unroll
            for (int i = 0; i < 4; ++i) rvc[i] = rv_n[i];
            if (c < 3) {
#pragma unroll
                for (int i = 0; i < 4; ++i) rv_n[i] = *(const u32x2*)((const unsigned char*)(P + (orow + 8 * i) * PWB) + head * 256 + 64 * (c + 1) + 8 * mp8); }
#pragma unroll
            for (int tl = 0; tl < 2; ++tl)
#pragma unroll
                for (int g4 = 0; g4 < 4; ++g4) { u32x2 o; const f32x16& A = acc[2 * c + tl];
                    o.x = pk_bf16(A[4 * g4 + 0] * rstd, A[4 * g4 + 1] * rstd); o.y = pk_bf16(A[4 * g4 + 2] * rstd, A[4 * g4 + 3] * rstd);
                    *(LAS u32x2*)(Os + vl * 144 + (32 * tl + 8 * g4 + 4 * hh) * 2) = o; }
            asm volatile("s_waitcnt lgkmcnt(0)" ::: "memory");
            const int col = head * 256 + 64 * c + 8 * mp8;
            const f32x4 g0 = *(const f32x4*)(gng + 64 * c + 8 * mp8), g1 = *(const f32x4*)(gng + 64 * c + 8 * mp8 + 4);
#pragma unroll
            for (int i = 0; i < 4; ++i) {
                const v4u ob = *(const LAS v4u*)(Os + (mq + 8 * i) * 144 + mp8 * 16); const u32x2 rv = rvc[i];
                float rr[8];
#pragma unroll
                for (int j = 0; j < 4; ++j) { rr[j] = ((float)((rv.x >> (8 * j)) & 0xffu) - 128.f) * 0.05f; rr[4 + j] = ((float)((rv.y >> (8 * j)) & 0xffu) - 128.f) * 0.05f; }
                v4u o;
                o.x = pk_bf16(bfl(ob.x) * g0.x * rr[0] * fast_sigmoid(rr[0]), bfh(ob.x) * g0.y * rr[1] * fast_sigmoid(rr[1]));
                o.y = pk_bf16(bfl(ob.y) * g0.z * rr[2] * fast_sigmoid(rr[2]), bfh(ob.y) * g0.w * rr[3] * fast_sigmoid(rr[3]));
                o.z = pk_bf16(bfl(ob.z) * g1.x * rr[4] * fast_sigmoid(rr[4]), bfh(ob.z) * g1.y * rr[5] * fast_sigmoid(rr[5]));
                o.w = pk_bf16(bfl(ob.w) * g1.z * rr[6] * fast_sigmoid(rr[6]), bfh(ob.w) * g1.w * rr[7] * fast_sigmoid(rr[7]));
                *(v4u*)(OA + (orow + 8 * i) * D + col) = o;
            }
            asm volatile("s_waitcnt lgkmcnt(0)" ::: "memory");
        }
    }
}
__device__ __forceinline__ void p0_mod_item(Frame& F0, const float* c, const float* w_ada, const float* b_ada, float* mod, int item) {
    Frame F = F0; { int t__ = threadIdx.x; asm volatile("" : "+v"(t__)); F.tid = t__; F.lane = t__ & 63; F.wave = __builtin_amdgcn_readfirstlane(t__ >> 6); }
    LAS float* sc = (LAS float*)(F.lds + RING_OFF);
    LAS float* red = (LAS float*)(F.lds + RING_OFF + 16384);
    for (int i = F.tid; i < NB * D; i += NWAVES * 64) { const float v = c[i]; sc[i] = v * __builtin_amdgcn_rcpf(1.f + __expf(-v)); }
    __syncthreads();
    const int cl = F.lane & 31, rh = F.lane >> 5, col = item * 32 + cl;
    float acc[NB] = {0.f, 0.f, 0.f, 0.f};
    const float* wp = w_ada + (size_t)(F.wave * 128 + rh) * NMOD + col;
#pragma unroll 32
    for (int i = 0; i < 64; ++i) { const float w = wp[(size_t)(2 * i) * NMOD];
#pragma unroll
        for (int b = 0; b < NB; ++b) acc[b] += sc[b * D + F.wave * 128 + 2 * i + rh] * w; }
#pragma unroll
    for (int b = 0; b < NB; ++b) { acc[b] += __shfl_xor(acc[b], 32); if (rh == 0) red[(F.wave * NB + b) * 32 + cl] = acc[b]; }
    __syncthreads();
    if (F.tid < 128) { const int b = F.tid >> 5, cc = F.tid & 31; float s = b_ada[item * 32 + cc];
#pragma unroll
        for (int w = 0; w < 8; ++w) s += red[(w * NB + b) * 32 + cc];
        mod[b * NMOD + item * 32 + cc] = s; }
    __syncthreads();
}
template <bool F8 = false>
__device__ __forceinline__ void tr_item(const float* W, int N, int k0, int n0, int nvalid, bf16* WT, size_t drow0, int dpitch, int dcol0, LAS float* scr, int lane, float wscale = 1.f) {
    const int nn = lane & 31;
    float tmp[32];
#pragma unroll
    for (int i = 0; i < 32; ++i) { const int kk = 2 * i + (lane >> 5); tmp[i] = (nn < nvalid) ? W[(size_t)(k0 + kk) * N + n0 + nn] : 0.f; }
#pragma unroll
    for (int i = 0; i < 32; ++i) { const int kk = 2 * i + (lane >> 5); scr[kk * 33 + nn] = tmp[i]; }
    LDS_WAIT(); asm volatile("" ::: "memory");
    const int c = lane & 7;
#pragma unroll
    for (int j = 0; j < 4; ++j) { const int n = (lane >> 3) + 8 * j; const LAS float* s = scr + (8 * c) * 33 + n;
        v4u o; o.x = pg8::cvt_pk_bf16(s[0 * 33], s[1 * 33]); o.y = pg8::cvt_pk_bf16(s[2 * 33], s[3 * 33]); o.z = pg8::cvt_pk_bf16(s[4 * 33], s[5 * 33]); o.w = pg8::cvt_pk_bf16(s[6 * 33], s[7 * 33]);
        if constexpr (F8) {
            int w0 = __builtin_amdgcn_cvt_pk_fp8_f32(s[0 * 33] * wscale, s[1 * 33] * wscale, 0, false); w0 = __builtin_amdgcn_cvt_pk_fp8_f32(s[2 * 33] * wscale, s[3 * 33] * wscale, w0, true);
            int w1 = __builtin_amdgcn_cvt_pk_fp8_f32(s[4 * 33] * wscale, s[5 * 33] * wscale, 0, false); w1 = __builtin_amdgcn_cvt_pk_fp8_f32(s[6 * 33] * wscale, s[7 * 33] * wscale, w1, true);
            if (n < nvalid) *(GAS u32x2*)((unsigned char*)WT + (drow0 + n) * (size_t)dpitch + dcol0 + k0 + 8 * c) = (u32x2){(unsigned)w0, (unsigned)w1};
        } else {
        if (n < nvalid) *(GAS v4u*)(WT + (drow0 + n) * (size_t)dpitch + dcol0 + k0 + 8 * c) = o; } }
    LDS_WAIT(); asm volatile("" ::: "memory");
}
__device__ __forceinline__ void p0_convert(Frame& F0, const Args& args, int part) {
    Frame F = F0; { int t__ = threadIdx.x; asm volatile("" : "+v"(t__)); F.tid = t__; F.lane = t__ & 63; F.wave = __builtin_amdgcn_readfirstlane(t__ >> 6); }
    unsigned char* ws = args.ws;
    bf16* WIN = (bf16*)(ws + WS_WIN); bf16* WO = (bf16*)(ws + WS_WO); bf16* WGU = (bf16*)(ws + WS_WGU); bf16* WD = (bf16*)(ws + WS_WD);
    const float* w_in = args.in[5]; const float* w_o = args.in[10]; const float* w_gate = args.in[16]; const float* w_up = args.in[17]; const float* w_down = args.in[18];
    LAS float* scr = (LAS float*)(F.lds + RING_OFF + 32768 + F.wave * 8704);
    const int gw = F.vcu * NWAVES + F.wave, NGW = F.G * NWAVES;
    constexpr int I0 = 16 * 201, I3 = 16 * 32, I4 = 16 * 128, I5 = 16 * 128, I6 = 16 * 128;
    constexpr int NITEMS = I0 + I3 + I4 + I5 + I6;
    bf16* WIN8 = (bf16*)(ws + WS_WIN8);
    const int it0 = part == 0 ? 0 : I0 + I3, it1 = part == 0 ? I0 + I3 : NITEMS;
    for (int it = it0 + gw; it < it1; it += NGW) {
        int r = it;
        if (r < I0) {
            const int kb = r / 201, cb = r % 201; int src, dst, nv = 32;
            if (cb < 16) { src = 32 * cb; dst = PC_QA + 32 * cb; }
            else if (cb < 32) { src = 512 + 32 * (cb - 16); dst = PC_KA + 32 * (cb - 16); }
            else if (cb < 64) { src = 1024 + 32 * (cb - 32); dst = PC_VA + 32 * (cb - 32); }
            else if (cb < 96) { src = 2048 + 32 * (cb - 64); dst = PC_RA + 32 * (cb - 64); }
            else if (cb < 97) { src = 3072; dst = PC_Z; nv = 16; }
            else if (cb < 129) { src = 3088 + 32 * (cb - 97); dst = PC_QB + 32 * (cb - 97); }
            else if (cb < 133) { src = 4112 + 32 * (cb - 129); dst = PC_KB + 32 * (cb - 129); }
            else if (cb < 137) { src = 4240 + 32 * (cb - 133); dst = PC_VB + 32 * (cb - 133); }
            else if (cb < 169) { src = 4368 + 32 * (cb - 137); dst = PC_GA + 32 * (cb - 137); }
            else { src = 5392 + 32 * (cb - 169); dst = PC_GB + 32 * (cb - 169); }
            if (dst < NF8 * 256) tr_item<true>(w_in, IN_TOTAL, 64 * kb, src, nv, WIN8, dst, D, 0, scr, F.lane, 32.f);
            else tr_item(w_in, IN_TOTAL, 64 * kb, src, nv, WIN, dst, D, 0, scr, F.lane);
            continue; } r -= I0;
        if (r < I3) { const int kb = r / 32, nb = r % 32; tr_item(w_o, D, 64 * kb, 32 * nb, 32, WO, 32 * nb, D, 0, scr, F.lane); continue; } r -= I3;
        if (r < I4 + I5) { const bool up = r >= I4; if (up) r -= I4; const int e = r / 128, q = r % 128, kb = q / 8, nb = q % 8, n0 = 32 * nb;
            tr_item<true>((up ? w_up : w_gate) + (size_t)e * D * 256, 256, 64 * kb, n0, 32, WGU, (size_t)e * 512 + (n0 >> 7) * 256 + (up ? 128 : 0) + (n0 & 127), D, 0, scr, F.lane, 32.f); continue; } r -= I4 + I5;
        { const int e = r / 128, q = r % 128, kb = q / 32, nb = q % 32;
            tr_item<true>(w_down + (size_t)e * 256 * D, D, 64 * kb, 32 * nb, 32, WD, (size_t)(e >> 2) * D + 32 * nb, D, (e & 3) * 256, scr, F.lane, 16.f); }
    }
    if (part == 0) { GAS v4u* z = (GAS v4u*)(WIN + (size_t)IN_TOTAL * D); const int n16 = (PW - IN_TOTAL) * D * 2 / 16; const v4u zero = {0u, 0u, 0u, 0u};
      for (int i = gw * 64 + F.lane; i < n16; i += NGW * 64) z[i] = zero; }
}
__device__ __forceinline__ void p1_h1(Frame& F0, const float* x, const float* g1, const float* mod, bf16* H1) {
    Frame F = F0; { int t__ = threadIdx.x; asm volatile("" : "+v"(t__)); F.tid = t__; F.lane = t__ & 63; F.wave = __builtin_amdgcn_readfirstlane(t__ >> 6); }
    const int gw = F.vcu * NWAVES + F.wave, NGW = F.G * NWAVES, c0 = F.lane * 8;
    f32x4 scl[4], sft[4]; int curb = -1;
    f32x4 nx[4];
    const int NIT = T / NGW;
    {
#pragma unroll
        for (int j = 0; j < 2; ++j) { nx[2 * j] = *(const GAS f32x4*)(x + (size_t)(NIT * gw) * D + c0 + 512 * j); nx[2 * j + 1] = *(const GAS f32x4*)(x + (size_t)(NIT * gw) * D + c0 + 512 * j + 4); } }
    for (int k = 0; k < NIT; ++k) {
        const int m = NIT * gw + k, mn = m + 1;
        const int b = m / SEQ;
        if (b != curb) { curb = b; const float* sh = mod + b * NMOD; const float* sc = sh + D;
#pragma unroll
            for (int q = 0; q < 4; ++q) { const int cc = c0 + 512 * (q >> 1) + 4 * (q & 1); scl[q] = *(const f32x4*)(g1 + cc) * (*(const f32x4*)(sc + cc) + 1.f); sft[q] = *(const f32x4*)(sh + cc); } }
        f32x4 v[4]; float s = 0.f;
#pragma unroll
        for (int q = 0; q < 4; ++q) v[q] = nx[q];
        if (k + 1 < NIT) {
#pragma unroll
            for (int j = 0; j < 2; ++j) { nx[2 * j] = *(const GAS f32x4*)(x + (size_t)mn * D + c0 + 512 * j); nx[2 * j + 1] = *(const GAS f32x4*)(x + (size_t)mn * D + c0 + 512 * j + 4); } }
#pragma unroll
        for (int q = 0; q < 4; ++q) s += (v[q].x * v[q].x + v[q].y * v[q].y) + (v[q].z * v[q].z + v[q].w * v[q].w);
#pragma unroll
        for (int o = 1; o < 64; o <<= 1) s += __shfl_xor(s, o);
        const float rstd = rsqrtf(s * (1.f / D) + EPS);
#pragma unroll
        for (int j = 0; j < 2; ++j) { const f32x4 y0 = v[2 * j] * rstd * scl[2 * j] + sft[2 * j], y1 = v[2 * j + 1] * rstd * scl[2 * j + 1] + sft[2 * j + 1];
            *(GAS v4u*)(H1 + (size_t)m * D + c0 + 512 * j) = (v4u){pg8::cvt_pk_bf16(y0.x, y0.y), pg8::cvt_pk_bf16(y0.z, y0.w), pg8::cvt_pk_bf16(y1.x, y1.y), pg8::cvt_pk_bf16(y1.z, y1.w)};
            if constexpr (NF8 > 0) { int q0 = __builtin_amdgcn_cvt_pk_fp8_f32(y0.x, y0.y, 0, false); q0 = __builtin_amdgcn_cvt_pk_fp8_f32(y0.z, y0.w, q0, true);
                int q1 = __builtin_amdgcn_cvt_pk_fp8_f32(y1.x, y1.y, 0, false); q1 = __builtin_amdgcn_cvt_pk_fp8_f32(y1.z, y1.w, q1, true);
                *(GAS u32x2*)((unsigned char*)H1 + 64 * MiB + (size_t)m * D + c0 + 512 * j) = (u32x2){(unsigned)q0, (unsigned)q1}; } }
    }
}

__global__ void __launch_bounds__(NWAVES * 64, 2) skel_fwd(Args args) {
    extern __shared__ __attribute__((aligned(16))) unsigned char lds[];
    Frame F;
    F.lds = (LAS unsigned char*)lds;
    F.MISC = (volatile LAS unsigned*)(F.lds + MISC_OFF);
    F.tid = threadIdx.x; F.lane = F.tid & 63; F.wave = __builtin_amdgcn_readfirstlane(F.tid >> 6);
    F.G = gridDim.x; { const int bx = blockIdx.x; F.vcu = (F.G % 8 == 0) ? (bx % 8) * (F.G / 8) + bx / 8 : bx; }
    unsigned char* ws = args.ws;
    F.ctl = (gu32*)(ws + WS_CTL);
    for (int u = F.tid; u < (LDS_BYTES - LDSCTL_OFF) / 4; u += NWAVES * 64) ((LAS unsigned*)(F.lds + LDSCTL_OFF))[u] = 0u;
    __syncthreads();
    XcdBarrier bar = xcd_barrier_post((unsigned*)(F.ctl + CW_BAR) + args.li * XCD_BAR_WORDS, F.MISC + 8);
    const int lo = args.ph_lo, hi = args.ph_hi;
#define IN(k) (lo <= (k) && (k) < hi)
#define BOTH(k) (IN(k) && IN((k) + 1))
#define GRID_BAR() xcd_barrier(bar)
#if defined(PROBE_LO)
    volatile LAS unsigned long long* tsl = (volatile LAS unsigned long long*)(F.lds + LDSCTL_OFF + 64);
#define STAMP(k) do { if (blockIdx.x == 0 && F.tid == 0) tsl[k] = rt(); } while (0)
#else
#define STAMP(k) do { } while (0)
#endif
#define REFRESH() do { int t__ = threadIdx.x; asm volatile("" : "+v"(t__)); F.tid = t__; F.lane = t__ & 63; F.wave = __builtin_amdgcn_readfirstlane(t__ >> 6); } while (0)
    float* mod = (float*)(ws + WS_MOD);
    bf16* P = (bf16*)(ws + WS_P);
    bf16* H1 = (bf16*)args.out;

    STAMP(0); if (IN(0)) {
        if (blockIdx.x < NMOD / 32) p0_mod_item(F, args.in[1], args.in[2], args.in[3], mod, blockIdx.x);
        p0_convert(F, args, 0);
        {
            GAS v4u* xz = (GAS v4u*)(ws + WS_XBUF); const v4u zero = {0u, 0u, 0u, 0u};
            for (int i = blockIdx.x * (NWAVES * 64) + F.tid; i < (int)(XBUF_BYTES / 16); i += F.G * NWAVES * 64) xz[i] = zero; }
        if (BOTH(0)) GRID_BAR();
    }
    STAMP(1); if (IN(1)) {
        p1_h1(F, args.in[0], args.in[4], mod, H1);
        if (BOTH(1)) GRID_BAR();
    }
    STAMP(2); if (IN(2)) {
        if constexpr (NF8 > 0) {
            pg8::Gemm g{(const unsigned char*)H1 + 64 * MiB, ws + WS_WIN8, D / 128, D, D, 0x7f7f7f7f, 0x7a7a7a7a}; pg8::StaticOrder S; S.init(T, NF8 * 256, F.G, (int)blockIdx.x);
            static_assert(NF8 == 0 || (NF8 == 12 && PC_RA == 0 && PC_GA == 1024 && PC_GB == 2048), "the byte-coded gate epilogue assumes the gate tiles come first");
            pg8::EpiGate E{P, PWB};
            pg8::gemm_phase<pg8::EpiGate, pg8::StaticOrder, false, true, true>(F.lds + RING_OFF, g, S, E);
        }
        {
            pg8::Gemm g{H1, ws + WS_WIN + (size_t)NF8 * 256 * D * 2, D / 64, D * 2, D * 2, 0, 0}; pg8::StaticOrder S; S.init(T, PW - NF8 * 256, F.G, (int)blockIdx.x);
            pg8::EpiBf16 E{P + NF8 * 256 - PBOFF, PWB};
            pg8::gemm_phase<pg8::EpiBf16, pg8::StaticOrder, false, true>(F.lds + RING_OFF, g, S, E);
        }
        if (BOTH(2)) GRID_BAR();
    }
    STAMP(3); if (IN(3)) { p3_gla_upd(F, P, args.in[6], args.in[7], (unsigned char*)args.out); if (BOTH(3)) GRID_BAR(); }
    STAMP(4); if (IN(4)) { p4_gla_scan(F, (unsigned char*)args.out); if (BOTH(4)) GRID_BAR(); }
    STAMP(5); if (IN(5)) { p5_gla_out(F, P, args.in[8], (unsigned char*)args.out); if (BOTH(5)) GRID_BAR(); }
    STAMP(6); if (IN(6)) {
        p6_swa_merge(F, P, (bf16*)(ws + WS_M), (const bf16*)((const unsigned char*)args.out + 64 * MiB), args.in[9]);
        if (BOTH(6)) GRID_BAR();
    }
    STAMP(7); if (IN(7)) {
        pg8::Gemm g{ws + WS_M, ws + WS_WO, D / 64, D * 2, D * 2, 0, 0}; pg8::StaticOrder S; S.init(T, D, F.G, (int)blockIdx.x);
        pg8::EpiX1 E{args.in[0], mod + 2 * D, (bf16*)args.out};
        pg8::gemm_phase<pg8::EpiX1, pg8::StaticOrder, false, true>(F.lds + RING_OFF, g, S, E);
        if (BOTH(7)) GRID_BAR();
    }
    STAMP(8); if (IN(8)) {
        p8_h2_route(F, args, mod, (unsigned char*)P);
        if (BOTH(8)) GRID_BAR();
    }
    STAMP(9); if (IN(9)) {
        p9_sort(F, args);
        p0_convert(F, args, 1);
        if (BOTH(9)) GRID_BAR();
    }
    const int* seg = (const int*)(ws + WS_SORT + SORT_SEG); const int* rowlist = (const int*)(ws + WS_SORT + SORT_ROWLIST); const int* tileb = (const int*)(ws + WS_SORT + SORT_TILEB);
    unsigned char* HID = (unsigned char*)P + 64 * MiB;
    STAMP(10); if (IN(10)) {
        const int ntile = __builtin_amdgcn_readfirstlane(seg[32]);
        PairOrder10 S; S.rl = rowlist; S.tileb = tileb; S.cnt = F.ctl + CW_HIDCNT; S.init(ntile * 4, F.G, F.vcu);
        pg8::Gemm g{P, ws + WS_WGU, D / 128, D, D, 0x7f7f7f7f, 0x7a7a7a7a};
        EpiHid E{HID, (const float*)(ws + WS_SORT + SORT_CW)};
        pg8::gemm_phase<EpiHid, PairOrder10, true, true, true>(F.lds + RING_OFF, g, S, E);
    }
    STAMP(11); if (IN(11)) {
        const int ntile = __builtin_amdgcn_readfirstlane(seg[32]);
        PairOrder11 S; S.tileb = tileb; S.cnt = F.ctl + CW_HIDCNT; S.tmo = F.ctl + CW_BAR + XB_TMO; S.init(ntile * 4, F.G, F.vcu);
        pg8::Gemm g{HID, ws + WS_WD, 4, 512, D, 0x7b7b7b7b, 0x7b7b7b7b};
        EpiFinal E{rowlist, mod + 5 * D, (const bf16*)args.out, args.out, args.in[19], (unsigned long long*)(ws + WS_XBUF), F.lds + 140288};
        pg8::gemm_phase<EpiFinal, PairOrder11, false, true, true, true>(F.lds + RING_OFF, g, S, E);
    }
    STAMP(12);
    STAMP(13);
#if defined(PROBE_LO)
    if (blockIdx.x == 0 && F.tid == 0) { const unsigned long long dt = (tsl[PROBE_HI] - tsl[PROBE_LO]) * PROBE_MULT, t0 = rt(); while (rt() - t0 < dt) __builtin_amdgcn_s_sleep(8); }
#endif
#undef IN
#undef BOTH
#undef GRID_BAR
#undef STAMP
#undef REFRESH
}

extern "C" void kernel_launch(void* const* d_in, const int* in_sizes, int n_in, void* d_out, int out_size, void* d_ws, size_t ws_size, hipStream_t stream) {
    static int grid = 0;
    if (grid == 0) {
        int dev = 0, cus = 0, per_cu = 0;
        if (hipGetDevice(&dev) != hipSuccess || hipDeviceGetAttribute(&cus, hipDeviceAttributeMultiprocessorCount, dev) != hipSuccess) { grid = -1; return; }
        if (hipFuncSetAttribute((const void*)skel_fwd, hipFuncAttributeMaxDynamicSharedMemorySize, LDS_BYTES) != hipSuccess) { grid = -1; return; }
        if (hipOccupancyMaxActiveBlocksPerMultiprocessor(&per_cu, (const void*)skel_fwd, NWAVES * 64, LDS_BYTES) != hipSuccess || per_cu < 1) per_cu = 1;
        (void)hipGetLastError();
        grid = cus;
        if (ws_size < WS_END) { fprintf(stderr, "kernel_launch: workspace too small (%zu < %zu)\n", ws_size, (size_t)WS_END); grid = -1; return; }
    }
    if (grid < 0) return;
    unsigned char* ws = (unsigned char*)d_ws; float* out = (float*)d_out;
    (void)hipMemsetAsync((char*)d_ws + WS_CTL, 0, CTL_ZERO_BYTES, stream);
    Args a{};
    for (int i = 0; i < 20; ++i) a.in[i] = (const float*)d_in[i];
    a.out = out; a.ws = ws;
    a.ph_lo = 0; a.ph_hi = 12; a.li = 0;
    hipLaunchKernelGGL(skel_fwd, dim3(grid), dim3(NWAVES * 64), LDS_BYTES, stream, a);
}
```

```cpp
#include <hip/hip_runtime.h>
#include <stdint.h>
#include <cstdio>

constexpr int D = 1024, NB = 4, SEQ = 8192, T = NB * SEQ;
constexpr int NMOD = 6 * D;
constexpr int IN_TOTAL = 6416;
constexpr int PW = 6656;
constexpr int PC_RA = 0, PC_GA = 1024, PC_GB = 2048, PC_KA = 3072, PC_VA = 3584, PC_KB = 4608, PC_VB = 4736, PC_QA = 4864, PC_QB = 5376, PC_Z = 6400;
constexpr int PWB = 5120, PBOFF = 1536;
constexpr int PE_KA = PC_KA - PBOFF, PE_VA = PC_VA - PBOFF, PE_KB = PC_KB - PBOFF, PE_VB = PC_VB - PBOFF, PE_QA = PC_QA - PBOFF, PE_QB = PC_QB - PBOFF, PE_Z = PC_Z - PBOFF;
#ifndef NF8_TILES
#define NF8_TILES 12
#endif
constexpr int NF8 = NF8_TILES;
constexpr float EPS = 1e-6f;
constexpr int PROWS = T + 1024;

constexpr size_t MiB = 1u << 20;
constexpr size_t WS_CTL = 0, CTL_ZERO_BYTES = 65536;
constexpr size_t WS_MOD = 1 * MiB;
constexpr size_t WS_ROUTE = 2 * MiB;
constexpr size_t WS_SORT = 3 * MiB;
constexpr size_t WS_WIN = 8 * MiB, WS_WO = 21 * MiB, WS_WGU = 23 * MiB, WS_WIN8 = 31 * MiB, WS_WD = 39 * MiB;
constexpr size_t WS_P = 48 * MiB;
constexpr size_t WS_M = WS_P + (size_t)PROWS * PWB * 2;
constexpr size_t WS_END = WS_M + (size_t)T * D * 2;
static_assert(WS_END <= 512 * MiB, "ws map");
constexpr int CW_BAR = 4096;
#define GAS __attribute__((address_space(1)))
#define LAS __attribute__((address_space(3)))
typedef unsigned short bf16;
typedef unsigned v4u __attribute__((ext_vector_type(4)));
typedef float f32x4 __attribute__((ext_vector_type(4)));
typedef short bf16x8 __attribute__((ext_vector_type(8)));
typedef GAS unsigned gu32;
typedef GAS unsigned long long gu64;
#define RLX_AGENT __ATOMIC_RELAXED, __HIP_MEMORY_SCOPE_AGENT
#define LDS_WAIT() asm volatile("s_waitcnt lgkmcnt(0)" ::: "memory")
#define VM_WAIT() asm volatile("s_waitcnt vmcnt(0)" ::: "memory")
__device__ __forceinline__ unsigned long long rt() { return __builtin_amdgcn_s_memrealtime(); }
__device__ __forceinline__ unsigned f2bf(float f) { unsigned u = __builtin_bit_cast(unsigned, f); return (u + 0x7fffu + ((u >> 16) & 1u)) >> 16; }
__device__ __forceinline__ unsigned pk2(float lo, float hi) { return f2bf(lo) | (f2bf(hi) << 16); }

#define XB_TMO      128
#define XB_XCNT(j)  (256  + 64 * (j))
#define XB_XSUB(j)  (1280 + 64 * (j))
#define XB_XGEN(j)  (2304 + 64 * (j))
#define XB_TOP      3328
#define XB_TOPGEN   3392
#define XCD_BAR_WORDS 3456
#define XB_SPIN_CAP (1u << 18)

__device__ __forceinline__ unsigned xb_ld(unsigned* p)              { return __hip_atomic_load(p, __ATOMIC_RELAXED, __HIP_MEMORY_SCOPE_AGENT); }
__device__ __forceinline__ unsigned xb_add(unsigned* p, unsigned v) { return __hip_atomic_fetch_add(p, v, __ATOMIC_RELAXED, __HIP_MEMORY_SCOPE_AGENT); }
__device__ __forceinline__ unsigned xb_xcc_id() { return (unsigned)__builtin_amdgcn_s_getreg((3 << 11) | 20) & 0xFu; }
#define XB_SPIN(cond, bar) do { unsigned _sp = 0; while (cond) { __builtin_amdgcn_s_sleep(1); \
    if ((++_sp & 255u) == 0u) { if (xb_ld(&(bar)[XB_TMO])) break; if (_sp > XB_SPIN_CAP) { atomicAdd(&(bar)[XB_TMO], 1u); break; } } } } while (0)

struct XcdBarrier {
    unsigned* bar; unsigned x;
    volatile LAS unsigned* st;
};

__device__ __forceinline__ XcdBarrier xcd_barrier_post(unsigned* bar, volatile LAS unsigned* st) {
    XcdBarrier b; b.bar = bar; b.x = xb_xcc_id(); b.st = st;
    if (threadIdx.x == 0) (void)xb_add(&bar[XB_XCNT(b.x)], 1u);
    return b;
}
__device__ __forceinline__ void xcd_barrier_complete(unsigned* bar, unsigned x, unsigned& nloc, unsigned& nx) {
    const unsigned G = gridDim.x * gridDim.y * gridDim.z;
    unsigned sum, cnt, mine, sp = 0u;
    for (;;) {
        sum = 0u; cnt = 0u; mine = 0u;
#pragma unroll
        for (unsigned j = 0; j < 16; ++j) { const unsigned c = xb_ld(&bar[XB_XCNT(j)]); sum += c; cnt += (c > 0u) ? 1u : 0u; mine = (j == x) ? c : mine; }
        if (sum == G) break;
        __builtin_amdgcn_s_sleep(1);
        if ((++sp & 255u) == 0u) { if (xb_ld(&bar[XB_TMO])) break; if (sp > XB_SPIN_CAP) { atomicAdd(&bar[XB_TMO], 1u); break; } }
    }
    nloc = mine > 0u ? mine : 1u; nx = cnt > 0u ? cnt : 1u;
}

__device__ __forceinline__ void xcd_barrier(const XcdBarrier& b) {
    asm volatile("s_waitcnt vmcnt(0)" ::: "memory");
    __syncthreads();
    if (threadIdx.x == 0) {
        unsigned* bar = b.bar;
        __builtin_amdgcn_s_waitcnt(0);
        unsigned nloc = b.st[0], nx = b.st[1];
        if (nloc == 0u) { xcd_barrier_complete(bar, b.x, nloc, nx); b.st[0] = nloc; b.st[1] = nx; }
        const unsigned old = xb_add(&bar[XB_XSUB(b.x)], 1u);
        const unsigned gen = old / nloc;
        if (old + 1u == (gen + 1u) * nloc) {
            __builtin_amdgcn_fence(__ATOMIC_RELEASE, "agent");
            asm volatile("s_waitcnt vmcnt(0)" ::: "memory");
            const unsigned og = xb_add(&bar[XB_TOP], 1u);
            const unsigned tg = og / nx;
            if (og + 1u == (tg + 1u) * nx) xb_add(&bar[XB_TOPGEN], 1u);
            else XB_SPIN(xb_ld(&bar[XB_TOPGEN]) == tg, bar);
            __builtin_amdgcn_fence(__ATOMIC_ACQUIRE, "agent");
            xb_add(&bar[XB_XGEN(b.x)], 1u);
            asm volatile("s_waitcnt vmcnt(0)" ::: "memory");
        } else {
            XB_SPIN(xb_ld(&bar[XB_XGEN(b.x)]) == gen, bar);
            __builtin_amdgcn_fence(__ATOMIC_ACQUIRE, "agent");
            asm volatile("s_waitcnt vmcnt(0)" ::: "memory");
        }
    }
    __syncthreads();
}
namespace pg8 {
#define PG8_LAS __attribute__((address_space(3)))
typedef unsigned short bf16_t;
typedef short bf16x8 __attribute__((ext_vector_type(8)));
typedef float f32x4 __attribute__((ext_vector_type(4)));
typedef unsigned u32x4 __attribute__((ext_vector_type(4)));
constexpr int BM = 256, BK = 64, HALF = 128, HTB = HALF * BK * 2  , STAGE_BYTES = 8 * HTB, NXCD = 8, WGM = 4;

__host__ __device__ __forceinline__ int lds_byte(int r, int c) { const int st = (r >> 4) * 2 + (c >> 5), rr = r & 15, cc = c & 31, ob = rr * 64 + cc * 2; return st * 1024 + (ob ^ (((ob >> 9) & 1) << 5)); }
__host__ __device__ __forceinline__ void stage_rc(int b, int& R, int& C) { const int st = b / 1024, sb = b % 1024, swz = sb ^ (((sb >> 9) & 1) << 5); R = (st >> 1) * 16 + swz / 64; C = (st & 1) * 32 + (swz % 64) / 2; }
__host__ __device__ __forceinline__ int perm32(int rho) { const int n = rho >> 4, i = rho & 15; return 8 * (i >> 2) + 4 * n + (i & 3); }

struct Unit { int pm, pn; };
struct Gemm { const void* A; const void* Bt; int nt, ldaB, ldbB; int sa, sb; };
typedef int v8i __attribute__((ext_vector_type(8)));

struct StaticOrder {
    int nM, nN, nwg, G, c;
    __host__ __device__ void init(int M, int N, int G_, int c_) { nM = M / BM; nN = N / BM; nwg = nM * nN; G = G_; c = c_; }
    __host__ __device__ bool next(int i, Unit& u) const {
        const long L = (long)i * G + c; if (L >= nwg) return false;
        int wgid = (int)L; { const int q = nwg / NXCD, r = nwg % NXCD, xcd = wgid % NXCD, off = wgid / NXCD; wgid = (xcd < r ? xcd * (q + 1) : r * (q + 1) + (xcd - r) * q) + off; }
        const int nig = WGM * nN, gid = wgid / nig, fm = gid * WGM, gsz = (nM - fm) < WGM ? (nM - fm) : WGM;
        u.pm = fm + ((wgid % nig) % gsz); u.pn = (wgid % nig) / gsz; return true;
    }
    __device__ __forceinline__ int brow(const Unit& u) const { return u.pn * BM; }
    __device__ __forceinline__ const int* rowlist() const { return nullptr; }
    static constexpr bool WAITS = false, SIGNALS = false;
    __device__ __forceinline__ void a_ready(const Unit&) const {}
    __device__ __forceinline__ void done(const Unit&) const {}
};

__device__ __forceinline__ unsigned cvt_pk_bf16(float lo, float hi) { unsigned r; asm volatile("v_cvt_pk_bf16_f32 %0, %1, %2" : "=v"(r) : "v"(lo), "v"(hi)); return r; }

struct EpiBf16 {
    static constexpr bool PERM = true;
    bf16_t* O; int ldc;
    __device__ __forceinline__ void operator()(const f32x4 (&acc)[2][2][4][2], const Unit& u, int wr_, int wc_, int fr_, int fq_) const {
        int t_ = threadIdx.x; asm volatile("" : "+v"(t_));
        const int wid_ = __builtin_amdgcn_readfirstlane(t_ >> 6), wr = wid_ >> 2, wc = wid_ & 3, fr = t_ & 15, fq = (t_ & 63) >> 4; (void)wr_; (void)wc_; (void)fr_; (void)fq_;
        const int row0 = u.pm * BM + wr * 64 + fr; const int col0 = u.pn * BM + wc * 32 + 8 * fq;
#pragma unroll
        for (int ai = 0; ai < 2; ++ai)
#pragma unroll
            for (int m = 0; m < 4; ++m) { bf16_t* rowp = O + (size_t)(row0 + ai * HALF + m * 16) * ldc + col0;
#pragma unroll
                for (int bj = 0; bj < 2; ++bj) { const f32x4 v0 = acc[ai][bj][m][0], v1 = acc[ai][bj][m][1];
                    u32x4 w; w.x = cvt_pk_bf16(v0[0], v0[1]); w.y = cvt_pk_bf16(v0[2], v0[3]); w.z = cvt_pk_bf16(v1[0], v1[1]); w.w = cvt_pk_bf16(v1[2], v1[3]);
                    *(u32x4*)(rowp + bj * HALF) = w; } }
    }
};
struct EpiGate {
    static constexpr bool PERM = true;
    bf16_t* P; int ldp;
    __device__ __forceinline__ void operator()(const f32x4 (&acc)[2][2][4][2], const Unit& u, int wr_, int wc_, int fr_, int fq_) const {
        int t_ = threadIdx.x; asm volatile("" : "+v"(t_));
        const int wid_ = __builtin_amdgcn_readfirstlane(t_ >> 6), wr = wid_ >> 2, wc = wid_ & 3, fr = t_ & 15, fq = (t_ & 63) >> 4; (void)wr_; (void)wc_; (void)fr_; (void)fq_;
        const int row0 = u.pm * BM + wr * 64 + fr; const int col0 = u.pn * BM + wc * 32 + 8 * fq;
        const bool sig = u.pn >= 4;
#pragma unroll
        for (int ai = 0; ai < 2; ++ai)
#pragma unroll
            for (int m = 0; m < 4; ++m) { unsigned char* rowp = (unsigned char*)(P + (size_t)(row0 + ai * HALF + m * 16) * ldp) + col0;
#pragma unroll
                for (int bj = 0; bj < 2; ++bj) { const f32x4 v0 = acc[ai][bj][m][0], v1 = acc[ai][bj][m][1];
                    float e[8] = {v0[0], v0[1], v0[2], v0[3], v1[0], v1[1], v1[2], v1[3]};
#pragma unroll
                    for (int j = 0; j < 8; ++j) e[j] = __builtin_rintf(sig ? 255.f * __builtin_amdgcn_rcpf(1.f + __expf(-e[j])) : e[j] * 20.f + 128.f);
                    unsigned w0 = 0u, w1 = 0u;
                    w0 = __builtin_amdgcn_cvt_pk_u8_f32(e[0], 0, w0); w0 = __builtin_amdgcn_cvt_pk_u8_f32(e[1], 1, w0); w0 = __builtin_amdgcn_cvt_pk_u8_f32(e[2], 2, w0); w0 = __builtin_amdgcn_cvt_pk_u8_f32(e[3], 3, w0);
                    w1 = __builtin_amdgcn_cvt_pk_u8_f32(e[4], 0, w1); w1 = __builtin_amdgcn_cvt_pk_u8_f32(e[5], 1, w1); w1 = __builtin_amdgcn_cvt_pk_u8_f32(e[6], 2, w1); w1 = __builtin_amdgcn_cvt_pk_u8_f32(e[7], 3, w1);
                    typedef unsigned u32x2_ __attribute__((ext_vector_type(2)));
                    *(u32x2_*)(rowp + bj * HALF) = (u32x2_){w0, w1}; } }
    }
};
struct EpiX1 {
    static constexpr bool PERM = true;
    const float* x; const float* gt; bf16_t* xo;
    __device__ __forceinline__ void operator()(const f32x4 (&acc)[2][2][4][2], const Unit& u, int wr_, int wc_, int fr_, int fq_) const {
        int t_ = threadIdx.x; asm volatile("" : "+v"(t_));
        const int wid_ = __builtin_amdgcn_readfirstlane(t_ >> 6), wr = wid_ >> 2, wc = wid_ & 3, fr = t_ & 15, fq = (t_ & 63) >> 4; (void)wr_; (void)wc_; (void)fr_; (void)fq_;
        const int b = (u.pm * BM) / SEQ; const float* g = gt + (size_t)b * NMOD;
        const int col0 = u.pn * BM + wc * 32 + 8 * fq;
        f32x4 gv[2][2];
#pragma unroll
        for (int bj = 0; bj < 2; ++bj)
#pragma unroll
            for (int n = 0; n < 2; ++n) gv[bj][n] = *(const f32x4*)(g + col0 + bj * HALF + n * 4);
#pragma unroll
        for (int ai = 0; ai < 2; ++ai)
#pragma unroll
            for (int m = 0; m < 4; ++m) { const size_t row = (size_t)(u.pm * BM + ai * HALF + wr * 64 + m * 16 + fr);
#pragma unroll
                for (int bj = 0; bj < 2; ++bj) {
                    const f32x4 x0 = *(const f32x4*)(x + row * D + col0 + bj * HALF), x1 = *(const f32x4*)(x + row * D + col0 + bj * HALF + 4);
                    const f32x4 v0 = x0 + gv[bj][0] * acc[ai][bj][m][0], v1 = x1 + gv[bj][1] * acc[ai][bj][m][1];
                    u32x4 w; w.x = cvt_pk_bf16(v0[0], v0[1]); w.y = cvt_pk_bf16(v0[2], v0[3]); w.z = cvt_pk_bf16(v1[0], v1[1]); w.w = cvt_pk_bf16(v1[2], v1[3]);
                    *(u32x4*)(xo + row * 2048 + col0 + bj * HALF) = w; } }
    }
};

template <bool GATHER>
__device__ __forceinline__ void mk_voff(const int* rowlist, int ldaB, int pm, int tid, unsigned (&o)[2][2]) {
#pragma unroll
    for (int h = 0; h < 2; ++h)
#pragma unroll
        for (int i = 0; i < 2; ++i) {
            int R, C; stage_rc(tid * 16 + i * 8192, R, C);
            int row = pm * BM + h * HALF + R;
            if (GATHER) { row = rowlist[row]; row = row < 0 ? 0 : row; }
            o[h][i] = (unsigned)(row * ldaB + C * 2);
        }
}

template <class Epi, class Sched, bool GATHER, bool ALIGN_EPI, bool F8 = false, bool BSPLIT = false>
__device__ __forceinline__ void gemm_phase(PG8_LAS unsigned char* lds, const Gemm g, const Sched& S, const Epi& E) {
    int tid_ = threadIdx.x; asm volatile("" : "+v"(tid_));
    const int tid = tid_, wid = __builtin_amdgcn_readfirstlane(tid >> 6), lane = tid & 63, wr = wid >> 2, wc = wid & 3, fr = lane & 15, fq = lane >> 4;
    const int nt = g.nt, lda = g.ldaB, ldbB = g.ldbB;
    const int* rl = S.rowlist();
    unsigned voffB[2], voffA0[2];
#pragma unroll
    for (int i = 0; i < 2; ++i) { int R, C; stage_rc(tid * 16 + i * 8192, R, C); const int Rb = Epi::PERM ? ((R & ~31) + perm32(R & 31)) : R;
        voffB[i] = (unsigned)(Rb * ldbB + C * 2); voffA0[i] = (unsigned)(R * lda + C * 2); }
    PG8_LAS u32x4* const xslot = (PG8_LAS u32x4*)(lds + 132096 + tid * 16);
    const size_t kstep = (size_t)(BK * 2);
    const size_t hstepB = (size_t)HALF * ldbB;
    const unsigned ldsw = (unsigned)wid * 1024u;
    const int aoff = lds_byte(wr * 64 + fr, fq * 8), boff = lds_byte(wc * 32 + fr, fq * 8);
#define PG8_SA(b, h) (((b) * 2 + (h)) * HTB)
#define PG8_SB(b, h) ((4 + (b) * 2 + (h)) * HTB)
#define PG8_STAGE(bufoff, RS, soff, voff) do { _Pragma("unroll") for (int _i = 0; _i < 2; ++_i) \
        __builtin_amdgcn_raw_ptr_buffer_load_lds(RS, (PG8_LAS unsigned*)(lds + (bufoff) + ldsw + _i * 8192), 16, (int)(voff)[_i], (int)(soff), 0, 0); } while (0)
#define PG8_LD8(p) __builtin_bit_cast(v8i, __builtin_shufflevector(*(const PG8_LAS u32x4*)(p), *(const PG8_LAS u32x4*)((p) + 1024), 0, 1, 2, 3, 4, 5, 6, 7))
#define PG8_LDA(dst, b, h) do { _Pragma("unroll") for (int m = 0; m < 4; ++m) { if constexpr (F8) dst##8[m] = PG8_LD8(lds + PG8_SA(b, h) + aoff + m * 2048); else { _Pragma("unroll") for (int k = 0; k < 2; ++k) dst[m][k] = *(const PG8_LAS bf16x8*)(lds + PG8_SA(b, h) + aoff + m * 2048 + k * 1024); } } } while (0)
#define PG8_LDB(dst, b, h) do { _Pragma("unroll") for (int n = 0; n < 2; ++n) { if constexpr (F8) dst##8[n] = PG8_LD8(lds + PG8_SB(b, h) + boff + n * 2048); else { _Pragma("unroll") for (int k = 0; k < 2; ++k) dst[n][k] = *(const PG8_LAS bf16x8*)(lds + PG8_SB(b, h) + boff + n * 2048 + k * 1024); } } } while (0)
#define PG8_MMA(ai, bj, At, Bt) do { __builtin_amdgcn_s_setprio(1); _Pragma("unroll") for (int m = 0; m < 4; ++m) _Pragma("unroll") for (int n = 0; n < 2; ++n) { \
        if constexpr (F8) asm volatile("v_mfma_scale_f32_16x16x128_f8f6f4 %0, %1, %2, %0, %3, %4 op_sel_hi:[0,0,0]" : "+v"(acc[ai][bj][m][n]) : "v"(Bt##8[n]), "v"(At##8[m]), "v"(SCALE_B), "v"(SCALE_A)); \
        else { _Pragma("unroll") for (int k = 0; k < 2; ++k) acc[ai][bj][m][n] = __builtin_amdgcn_mfma_f32_16x16x32_bf16(Bt[n][k], At[m][k], acc[ai][bj][m][n], 0, 0, 0); } } \
        __builtin_amdgcn_s_setprio(0); } while (0)
#define PG8_WAIT_V(n) asm volatile("s_waitcnt vmcnt(" #n ")" ::: "memory")
#define PG8_WAIT_L(n) asm volatile("s_waitcnt lgkmcnt(" #n ")" ::: "memory")
#define PG8_BAR __builtin_amdgcn_s_barrier()
#define PG8_SCHED __builtin_amdgcn_sched_barrier(0)
    const int SCALE_A = g.sa, SCALE_B = g.sb;
    Unit cur, nxt; int ui = 0;
    if (!S.next(0, cur)) return;
    if constexpr (Sched::WAITS) S.a_ready(cur);
    f32x4 acc[2][2][4][2];
#pragma unroll
    for (int a = 0; a < 2; ++a)
#pragma unroll
        for (int b = 0; b < 2; ++b)
#pragma unroll
            for (int m = 0; m < 4; ++m)
#pragma unroll
                for (int n = 0; n < 2; ++n) acc[a][b][m][n] = (f32x4){0.f, 0.f, 0.f, 0.f};
    bf16x8 At[4][2], B0[2][2], B1[2][2]; v8i At8[4], B08[2], B18[2];
    unsigned voffA[2][2];
    const unsigned hstepA = (unsigned)HALF * (unsigned)lda, tstepA = 2u * hstepA;
    const __amdgpu_buffer_rsrc_t rsA = __builtin_amdgcn_make_buffer_rsrc((void*)g.A, 0, 0x7fffffff, 0x00020000), rsB = __builtin_amdgcn_make_buffer_rsrc((void*)g.Bt, 0, 0x7fffffff, 0x00020000);
    unsigned cAo = 0u, nAo = 0u;
    if constexpr (GATHER) mk_voff<true>(rl, lda, cur.pm, tid, voffA);
    else cAo = (unsigned)cur.pm * tstepA;
#define PG8_STAGE_A(bufoff, soff, h, OFFS) do { if constexpr (GATHER) PG8_STAGE(bufoff, rsA, soff, (OFFS)[h]); else PG8_STAGE(bufoff, rsA, (soff) + (h) * hstepA, voffA0); } while (0)
    unsigned cBo = (unsigned)S.brow(cur) * (unsigned)ldbB;
    const unsigned kstepu = (unsigned)kstep, hstepBu = (unsigned)hstepB;
    int cK0 = 0, cK1 = 0, nK0 = 0, nK1 = 0;
    if constexpr (BSPLIT) S.kb(cur, cK0, cK1);
#define PG8_BOFF(base, k0, k1, j) ((base) + (BSPLIT ? (unsigned)(((j) < 2 ? (k0) : (k1)) + ((j) & 1) * 128) : (unsigned)(j) * kstepu))
    { const unsigned p0 = PG8_BOFF(cBo, cK0, cK1, 0), p1 = PG8_BOFF(cBo, cK0, cK1, 1);
    PG8_STAGE(PG8_SB(0, 0), rsB, p0, voffB); PG8_STAGE(PG8_SB(0, 1), rsB, p0 + hstepBu, voffB); PG8_STAGE_A(PG8_SA(0, 0), cAo, 0, voffA); PG8_STAGE_A(PG8_SA(0, 1), cAo, 1, voffA);
    if (wr == 1) PG8_BAR;
    PG8_WAIT_V(2); PG8_BAR;
    PG8_STAGE(PG8_SB(1, 0), rsB, p1, voffB); PG8_STAGE_A(PG8_SA(1, 0), cAo + kstepu, 0, voffA); PG8_STAGE(PG8_SB(1, 1), rsB, p1 + hstepBu, voffB); }
    PG8_WAIT_V(6); PG8_BAR;
    for (;;) {
        const bool has_next = S.next(ui + 1, nxt);
        if constexpr (GATHER) {
            unsigned vn[2][2];
            if (has_next) mk_voff<true>(rl, lda, nxt.pm, tid, vn);
            else {
#pragma unroll
                for (int h = 0; h < 2; ++h)
#pragma unroll
                    for (int i = 0; i < 2; ++i) vn[h][i] = voffA[h][i]; }
            *xslot = (u32x4){vn[0][0], vn[0][1], vn[1][0], vn[1][1]};
        } else nAo = has_next ? (unsigned)nxt.pm * tstepA : cAo;
        const unsigned nBo = has_next ? (unsigned)S.brow(nxt) * (unsigned)ldbB : cBo;
        if constexpr (BSPLIT) { if (has_next) S.kb(nxt, nK0, nK1); else { nK0 = cK0; nK1 = cK1; } }
#pragma nounroll
        for (int t = 0; t < nt; t += 2) {
            const bool last = (t == nt - 2);
            if constexpr (Sched::WAITS) { if (last && has_next) S.a_ready(nxt); }
            const unsigned a1 = cAo + (unsigned)(t + 1) * kstepu;
            const unsigned a2 = last ? nAo : cAo + (unsigned)(t + 2) * kstepu, b2 = last ? PG8_BOFF(nBo, nK0, nK1, 0) : PG8_BOFF(cBo, cK0, cK1, t + 2);
            const unsigned a3 = a2 + kstepu, b3 = last ? PG8_BOFF(nBo, nK0, nK1, 1) : PG8_BOFF(cBo, cK0, cK1, t + 3);
            unsigned sl[2][2];
            if constexpr (GATHER) {
                if (last) { const u32x4 vn = *xslot; sl[0][0] = vn.x; sl[0][1] = vn.y; sl[1][0] = vn.z; sl[1][1] = vn.w; }
                else {
#pragma unroll
                    for (int h = 0; h < 2; ++h)
#pragma unroll
                        for (int i = 0; i < 2; ++i) sl[h][i] = voffA[h][i]; } }
            PG8_LDB(B0, 0, 0); PG8_LDB(B1, 0, 1); PG8_SCHED; PG8_LDA(At, 0, 0); PG8_STAGE_A(PG8_SA(1, 1), a1, 1, voffA);
            PG8_WAIT_V(8); PG8_WAIT_L(0); PG8_BAR; PG8_MMA(0, 0, At, B0); PG8_MMA(0, 1, At, B1); PG8_BAR; PG8_SCHED;
            PG8_LDA(At, 0, 1); PG8_STAGE(PG8_SB(0, 0), rsB, b2, voffB); PG8_STAGE(PG8_SB(0, 1), rsB, b2 + hstepBu, voffB); PG8_STAGE_A(PG8_SA(0, 0), a2, 0, sl);
            PG8_WAIT_V(8); PG8_WAIT_L(0); PG8_BAR; PG8_MMA(1, 0, At, B0); PG8_MMA(1, 1, At, B1); PG8_BAR; PG8_SCHED;
            PG8_LDB(B0, 1, 0); PG8_LDB(B1, 1, 1); PG8_SCHED; PG8_LDA(At, 1, 0); PG8_STAGE_A(PG8_SA(0, 1), a2, 1, sl);
            PG8_WAIT_V(8); PG8_WAIT_L(0); PG8_BAR; PG8_MMA(0, 0, At, B0); PG8_MMA(0, 1, At, B1); PG8_BAR; PG8_SCHED;
            PG8_LDA(At, 1, 1); PG8_STAGE(PG8_SB(1, 0), rsB, b3, voffB); PG8_STAGE(PG8_SB(1, 1), rsB, b3 + hstepBu, voffB); PG8_STAGE_A(PG8_SA(1, 0), a3, 0, sl);
            PG8_WAIT_V(8); PG8_WAIT_L(0); PG8_BAR; PG8_MMA(1, 0, At, B0); PG8_MMA(1, 1, At, B1); PG8_BAR; PG8_SCHED;
        }
        if constexpr (ALIGN_EPI) { if (wr == 0) PG8_BAR; }
        if constexpr (F8) asm volatile("s_nop 15\n\ts_nop 7" ::: "memory");
        E(acc, cur, wr, wc, fr, fq);
        if constexpr (Sched::SIGNALS) S.done(cur);
        if (!has_next) break;
#pragma unroll
        for (int a = 0; a < 2; ++a)
#pragma unroll
            for (int b = 0; b < 2; ++b)
#pragma unroll
                for (int m = 0; m < 4; ++m)
#pragma unroll
                    for (int n = 0; n < 2; ++n) acc[a][b][m][n] = (f32x4){0.f, 0.f, 0.f, 0.f};
        cur = nxt; cBo = nBo; cAo = nAo; cK0 = nK0; cK1 = nK1; ++ui;
        if constexpr (GATHER) { const u32x4 vn = *xslot; voffA[0][0] = vn.x; voffA[0][1] = vn.y; voffA[1][0] = vn.z; voffA[1][1] = vn.w; }
        if constexpr (ALIGN_EPI) { if (wr == 1) PG8_BAR; }
    }
    PG8_WAIT_V(0);
    if constexpr (!ALIGN_EPI) { if (wr == 0) PG8_BAR; }
    PG8_BAR;
#undef PG8_SA
#undef PG8_SB
#undef PG8_STAGE
#undef PG8_STAGE_A
#undef PG8_BOFF
#undef PG8_LDA
#undef PG8_LDB
#undef PG8_MMA
#undef PG8_LD8
#undef PG8_WAIT_V
#undef PG8_WAIT_L
#undef PG8_BAR
#undef PG8_SCHED
}
}
constexpr int NWAVES = 8;
constexpr int RING_OFF = 0, RING_BYTES = 131072;
constexpr int LDSCTL_OFF = RING_BYTES, MISC_OFF = LDSCTL_OFF + 320;
constexpr int LDS_BYTES = 147456;
static_assert(MISC_OFF + 128 <= LDS_BYTES, "LDS map");

struct Frame {
    LAS unsigned char* lds;
    volatile LAS unsigned* MISC;
    gu32* ctl;
    int tid, lane, wave;
    int vcu, G;
};
struct Args { const float* in[20]; float* out; unsigned char* ws; int ph_lo, ph_hi, li, pad; };

typedef float f32x16 __attribute__((ext_vector_type(16)));
typedef unsigned u32x2 __attribute__((ext_vector_type(2)));
__device__ __forceinline__ float bfl(unsigned w) { return __uint_as_float(w << 16); }
__device__ __forceinline__ float bfh(unsigned w) { return __uint_as_float(w & 0xffff0000u); }
#define LDS_BARRIER() do { asm volatile("s_waitcnt lgkmcnt(0)" ::: "memory"); __builtin_amdgcn_s_barrier(); asm volatile("" ::: "memory"); } while (0)
constexpr int NBK = 24, MAXPOS = 40960, MAXTILES = MAXPOS / 256;
constexpr size_t SORT_CNT = 0;
constexpr size_t SORT_SEG = 32768;
constexpr size_t SORT_TILEB = 33024;
constexpr size_t SORT_ROWLIST = 65536;
constexpr size_t SORT_CW = 262144;
constexpr int RB_ROWS = 128, NRB = T / RB_ROWS;
__device__ __forceinline__ int pair_id(int lo, int hi) { return (lo == 0 ? 0 : (lo == 1 ? 3 : 5)) + hi - lo - 1; }
__device__ __forceinline__ void pair_lohi(int pid, int& lo, int& hi) { lo = pid < 3 ? 0 : (pid < 5 ? 1 : 2); hi = pid < 3 ? pid + 1 : (pid < 5 ? pid - 1 : 3); }

__device__ __forceinline__ float wsum64(float v) {
#pragma unroll
    for (int o = 1; o < 64; o <<= 1) v += __shfl_xor(v, o);
    return v;
}

constexpr int R8_PITCH = 2064, R8_TILE = 0, R8_WT = 32 * R8_PITCH, R8_RED = R8_WT + 20 * R8_PITCH, R8_CNT = R8_RED + 8 * 32 * 20 * 4, R8_END = R8_CNT + 128;
static_assert(R8_END <= RING_BYTES, "p8 lds");
__device__ __forceinline__ void p8_h2_route(Frame& F0, const Args& args, const float* mod, unsigned char* A1) {
    Frame F = F0; { int t__ = threadIdx.x; asm volatile("" : "+v"(t__)); F.tid = t__; F.lane = t__ & 63; F.wave = __builtin_amdgcn_readfirstlane(t__ >> 6); }
    const bf16* x1 = (const bf16*)args.out; const float* g2 = args.in[11]; const float* w_group = args.in[12]; const float* b_group = args.in[13]; const float* w_router = args.in[14]; const float* b_router = args.in[15];
    int4* route = (int4*)(args.ws + WS_ROUTE); int* cnt = (int*)(args.ws + WS_SORT + SORT_CNT);
    LAS unsigned char* tile = F.lds + RING_OFF + R8_TILE; LAS unsigned char* wt = F.lds + RING_OFF + R8_WT; LAS float* red = (LAS float*)(F.lds + RING_OFF + R8_RED); LAS int* lcnt = (LAS int*)(F.lds + RING_OFF + R8_CNT);
    const int lane = F.lane, w = F.wave, vl = lane & 31, hh = lane >> 5;
    for (int d = F.tid; d < D; d += NWAVES * 64) {
        const f32x4 wg = *(const f32x4*)(w_group + (size_t)d * 4);
        *(LAS unsigned short*)(wt + 0 * R8_PITCH + d * 2) = (unsigned short)f2bf(wg.x); *(LAS unsigned short*)(wt + 1 * R8_PITCH + d * 2) = (unsigned short)f2bf(wg.y);
        *(LAS unsigned short*)(wt + 2 * R8_PITCH + d * 2) = (unsigned short)f2bf(wg.z); *(LAS unsigned short*)(wt + 3 * R8_PITCH + d * 2) = (unsigned short)f2bf(wg.w);
#pragma unroll
        for (int q = 0; q < 4; ++q) { const f32x4 w4 = *(const f32x4*)(w_router + (size_t)d * 16 + q * 4);
            *(LAS unsigned short*)(wt + (4 + q * 4 + 0) * R8_PITCH + d * 2) = (unsigned short)f2bf(w4.x); *(LAS unsigned short*)(wt + (4 + q * 4 + 1) * R8_PITCH + d * 2) = (unsigned short)f2bf(w4.y);
            *(LAS unsigned short*)(wt + (4 + q * 4 + 2) * R8_PITCH + d * 2) = (unsigned short)f2bf(w4.z); *(LAS unsigned short*)(wt + (4 + q * 4 + 3) * R8_PITCH + d * 2) = (unsigned short)f2bf(w4.w); }
    }
    __syncthreads();
    for (int rb = blockIdx.x; rb < NRB; rb += F.G) {
        const int b = (rb * RB_ROWS) / SEQ; const float* sh = mod + b * NMOD + 3 * D; const float* sc = mod + b * NMOD + 4 * D;
        f32x4 scl[4], sft[4];
#pragma unroll
        for (int j = 0; j < 2; ++j)
#pragma unroll
            for (int q = 0; q < 2; ++q) { const int c0 = lane * 8 + 512 * j + 4 * q; scl[2 * j + q] = *(const f32x4*)(g2 + c0) * (*(const f32x4*)(sc + c0) + 1.f); sft[2 * j + q] = *(const f32x4*)(sh + c0); }
        if (F.tid < NBK) lcnt[F.tid] = 0;
        for (int bt = 0; bt < 4; ++bt) {
            const int rbase = rb * RB_ROWS + bt * 32;
            v4u xr[4][2];
#pragma unroll
            for (int i = 0; i < 4; ++i)
#pragma unroll
                for (int j = 0; j < 2; ++j) xr[i][j] = *(const GAS v4u*)(x1 + (size_t)(rbase + w * 4 + i) * 2048 + lane * 8 + 512 * j);
#pragma unroll
            for (int i = 0; i < 4; ++i) {
                const int row = rbase + w * 4 + i;
                f32x4 v[4]; float s = 0.f;
#pragma unroll
                for (int j = 0; j < 2; ++j) { v[2 * j] = (f32x4){bfl(xr[i][j].x), bfh(xr[i][j].x), bfl(xr[i][j].y), bfh(xr[i][j].y)}; v[2 * j + 1] = (f32x4){bfl(xr[i][j].z), bfh(xr[i][j].z), bfl(xr[i][j].w), bfh(xr[i][j].w)}; }

#pragma unroll
                for (int q = 0; q < 4; ++q) s += (v[q].x * v[q].x + v[q].y * v[q].y) + (v[q].z * v[q].z + v[q].w * v[q].w);
                const float rstd = rsqrtf(wsum64(s) * (1.f / D) + EPS);
#pragma unroll
                for (int j = 0; j < 2; ++j) { const f32x4 y0 = v[2 * j] * rstd * scl[2 * j] + sft[2 * j], y1 = v[2 * j + 1] * rstd * scl[2 * j + 1] + sft[2 * j + 1];
                    const v4u o = {pg8::cvt_pk_bf16(y0.x, y0.y), pg8::cvt_pk_bf16(y0.z, y0.w), pg8::cvt_pk_bf16(y1.x, y1.y), pg8::cvt_pk_bf16(y1.z, y1.w)};
                    { int q0 = __builtin_amdgcn_cvt_pk_fp8_f32(y0.x, y0.y, 0, false); q0 = __builtin_amdgcn_cvt_pk_fp8_f32(y0.z, y0.w, q0, true);
                      int q1 = __builtin_amdgcn_cvt_pk_fp8_f32(y1.x, y1.y, 0, false); q1 = __builtin_amdgcn_cvt_pk_fp8_f32(y1.z, y1.w, q1, true);
                      *(GAS u32x2*)(A1 + (size_t)row * D + lane * 8 + 512 * j) = (u32x2){(unsigned)q0, (unsigned)q1}; }
                    *(LAS v4u*)(tile + (w * 4 + i) * R8_PITCH + (lane * 8 + 512 * j) * 2) = o; }
            }
            __syncthreads();
            {
                f32x16 acc = {0.f, 0.f, 0.f, 0.f, 0.f, 0.f, 0.f, 0.f, 0.f, 0.f, 0.f, 0.f, 0.f, 0.f, 0.f, 0.f};
                const int cr = vl < 20 ? vl : 19;
#pragma unroll
                for (int kk = 0; kk < 8; ++kk) { const bf16x8 a = *(const LAS bf16x8*)(tile + vl * R8_PITCH + (128 * w + 16 * kk + 8 * hh) * 2), bb = *(const LAS bf16x8*)(wt + cr * R8_PITCH + (128 * w + 16 * kk + 8 * hh) * 2);
                    acc = __builtin_amdgcn_mfma_f32_32x32x16_bf16(a, bb, acc, 0, 0, 0); }
                if (vl < 20) {
#pragma unroll
                    for (int r = 0; r < 16; ++r) red[(w * 32 + (r & 3) + 8 * (r >> 2) + 4 * hh) * 20 + vl] = acc[r]; }
            }
            __syncthreads();
            if (F.tid < 32) {
                const int row = rbase + F.tid;
                float lg[20];
#pragma unroll
                for (int c = 0; c < 20; ++c) { float a = 0.f;
#pragma unroll
                    for (int ww = 0; ww < 8; ++ww) a += red[(ww * 32 + F.tid) * 20 + c];
                    lg[c] = a; }
                float bg[4], br[16];
#pragma unroll
                for (int c = 0; c < 4; ++c) bg[c] = b_group[c];
#pragma unroll
                for (int c = 0; c < 16; ++c) br[c] = b_router[c];
                float gl[4]; int gi = 0;
#pragma unroll
                for (int c = 0; c < 4; ++c) gl[c] = lg[c] + bg[c];
                float gm = gl[0];
#pragma unroll
                for (int c = 1; c < 4; ++c) if (gl[c] > gm) { gm = gl[c]; gi = c; }
                float den = 0.f;
#pragma unroll
                for (int c = 0; c < 4; ++c) den += __expf(gl[c] - gm);
                const float gw = 1.f / den;
                float el[4];
#pragma unroll
                for (int c = 0; c < 4; ++c) { float vsel = lg[4 + c] + br[c];
#pragma unroll
                    for (int g = 1; g < 4; ++g) { const float cand = lg[4 + g * 4 + c] + br[g * 4 + c]; vsel = (gi == g) ? cand : vsel; }
                    el[c] = vsel; }
                int i0 = 0; float v0 = el[0];
#pragma unroll
                for (int c = 1; c < 4; ++c) if (el[c] > v0) { v0 = el[c]; i0 = c; }
                int i1 = -1; float v1 = -3.0e38f;
#pragma unroll
                for (int c = 0; c < 4; ++c) if (c != i0 && el[c] > v1) { v1 = el[c]; i1 = c; }
                const float p1 = __expf(v1 - v0), w0 = gw / (1.f + p1), w1 = gw * p1 / (1.f + p1);
                route[row] = make_int4(gi * 4 + i0, gi * 4 + i1, __float_as_int(w0), __float_as_int(w1));
                const int lo = i0 < i1 ? i0 : i1, hi = i0 < i1 ? i1 : i0;
                atomicAdd((int*)(lcnt + gi * 6 + pair_id(lo, hi)), 1);
            }
        }
        if (F.tid < 32) { asm volatile("s_waitcnt lgkmcnt(0)" ::: "memory"); if (F.tid < NBK) cnt[rb * NBK + F.tid] = lcnt[F.tid]; }
    }
}

__device__ __forceinline__ void p9_sort(Frame& F0, const Args& args) {
    Frame F = F0; { int t__ = threadIdx.x; asm volatile("" : "+v"(t__)); F.tid = t__; F.lane = t__ & 63; F.wave = __builtin_amdgcn_readfirstlane(t__ >> 6); }
    const int4* route = (const int4*)(args.ws + WS_ROUTE); const int* cnt = (const int*)(args.ws + WS_SORT + SORT_CNT);
    int* seg = (int*)(args.ws + WS_SORT + SORT_SEG); int* tileb = (int*)(args.ws + WS_SORT + SORT_TILEB); int* rowlist = (int*)(args.ws + WS_SORT + SORT_ROWLIST); float* cw = (float*)(args.ws + WS_SORT + SORT_CW);
    LAS int* scn = (LAS int*)(F.lds + RING_OFF);
    LAS int* sst = (LAS int*)(F.lds + RING_OFF + 24576);
    LAS int* sw0 = (LAS int*)(F.lds + RING_OFF + 24576 + 256);
    LAS int* sbase = (LAS int*)(F.lds + RING_OFF + 24576 + 384);
    for (int i = F.tid; i < NRB * NBK; i += NWAVES * 64) scn[i] = cnt[i];
    __syncthreads();
    if (F.tid < NBK) { int s = 0; for (int r = 0; r < NRB; ++r) s += scn[r * NBK + F.tid]; sst[32 + F.tid] = s; }
    __syncthreads();
    if (F.tid == 0) { int p = 0; for (int k = 0; k < NBK; ++k) { sst[k] = p; p += (sst[32 + k] + 255) & ~255; } sst[NBK] = p; }
    __syncthreads();
    if (blockIdx.x == 0) {
        if (F.tid <= NBK) seg[F.tid] = sst[F.tid];
        if (F.tid == 32) seg[32] = sst[NBK] / 256;
        for (int t = F.tid; t < sst[NBK] / 256; t += NWAVES * 64) { int k = 0;
#pragma unroll 1
            for (int q = 1; q < NBK; ++q) k += (t * 256 >= sst[q]) ? 1 : 0;
            while (k > 0 && sst[32 + k] == 0) --k;
            tileb[t] = k; }
    }
    if (blockIdx.x < NBK) {
        const int k = blockIdx.x, p0 = sst[k] + sst[32 + k], p1 = sst[k + 1];
        for (int p = p0 + F.tid; p < p1; p += NWAVES * 64) { rowlist[p] = -1; cw[2 * p] = 0.f; cw[2 * p + 1] = 0.f; }
    }
    for (int rb = blockIdx.x; rb < NRB; rb += F.G) {
        if (F.tid < NBK) { int s = 0; for (int r = 0; r < rb; ++r) s += scn[r * NBK + F.tid]; sbase[F.tid] = sst[F.tid] + s; }
        const bool act = F.tid < RB_ROWS;
        const int row = rb * RB_ROWS + (act ? F.tid : 0);
        int4 rt = make_int4(0, 0, 0, 0); int bk = -1, lo = 0;
        if (act) { rt = route[row]; const int a = rt.x & 3, c = rt.y & 3; lo = a < c ? a : c; const int hi = a < c ? c : a; bk = (rt.x >> 2) * 6 + pair_id(lo, hi); }
        const unsigned long long lt = (1ull << F.lane) - 1ull;
        int rank = 0, mycount = 0;
#pragma unroll 1
        for (int q = 0; q < NBK; ++q) { const unsigned long long mk = __ballot(bk == q); if (bk == q) rank = __popcll(mk & lt); if (F.lane == q) mycount = __popcll(mk); }
        if (F.wave == 0 && F.lane < NBK) sw0[F.lane] = mycount;
        __syncthreads();
        if (act) {
            if (F.wave == 1) rank += sw0[bk];
            const int pos = sbase[bk] + rank;
            const float w0 = __int_as_float(rt.z), w1 = __int_as_float(rt.w);
            const bool first_is_lo = (rt.x & 3) == lo;
            rowlist[pos] = row; cw[2 * pos] = first_is_lo ? w0 : w1; cw[2 * pos + 1] = first_is_lo ? w1 : w0;
        }
        __syncthreads();
    }
}

constexpr int CW_HIDCNT = 8192, HIDCNT_STRIDE = 16, HIDCNT_FULL = 32;
struct PairOrder10 {
    static constexpr bool WAITS = false, SIGNALS = true;
    const int* rl; const int* tileb; gu32* cnt; int nunits, G, c, r, bal;
    __device__ __forceinline__ void init(int nunits_, int G_, int c_) { nunits = nunits_; G = G_; c = c_; const int full = nunits / G; r = (nunits - full * G) >> 2; bal = (G % 4 == 0 && full == 2 && 3 * r <= (G >> 2)) ? 1 : 0; }
    __device__ __forceinline__ bool next(int i, pg8::Unit& u) const {
        if (!bal) { const int L = i * G + c; if (L >= nunits) return false; u.pm = L >> 2; u.pn = L & 3; return true; }
        const int q = c >> 2, nq = G >> 2; int tile;
        if (i == 0) tile = q;
        else if (q < r) { if (i == 1) tile = nq + q; else if (i == 2) tile = 2 * nq + q; else return false; }
        else if (q < 2 * r) return false;
        else if (q < 3 * r) { if (i == 1) tile = nq + q - r; else if (i == 2) tile = nq + q; else return false; }
        else { if (i == 1) tile = nq + q; else return false; }
        u.pm = tile; u.pn = c & 3; return true; }
    __device__ __forceinline__ int brow(const pg8::Unit& u) const { const int bk = __builtin_amdgcn_readfirstlane(tileb[u.pm]); int lo, hi; pair_lohi(bk % 6, lo, hi);
        return ((bk / 6) * 4 + ((u.pn >> 1) ? hi : lo)) * 512 + (u.pn & 1) * 256; }
    __device__ __forceinline__ const int* rowlist() const { return rl; }
    __device__ __forceinline__ void a_ready(const pg8::Unit&) const {}
    __device__ __forceinline__ void done(const pg8::Unit& u) const {
        asm volatile("s_waitcnt vmcnt(0)" ::: "memory");
        if ((threadIdx.x & 63) == 0) (void)__hip_atomic_fetch_add(cnt + u.pm * HIDCNT_STRIDE, 1u, RLX_AGENT);
    }
};
struct PairOrder11 {
    static constexpr bool WAITS = true, SIGNALS = false;
    const int* tileb; gu32* cnt; gu32* tmo; int nunits, G, c, full, R, off;
    __device__ __forceinline__ void init(int nunits_, int G_, int c_) { nunits = nunits_; G = G_; c = c_; full = nunits / G; R = nunits - full * G; off = (2 * R <= G) ? R : 0; }
    __device__ __forceinline__ bool next(int i, pg8::Unit& u) const { int L;
        if (i < full) L = i * G + c; else if (i == full && c >= off && c < off + R) L = full * G + (c - off); else return false;
        u.pm = L >> 2; u.pn = L & 3; return true; }
    __device__ __forceinline__ int brow(const pg8::Unit& u) const { const int bk = __builtin_amdgcn_readfirstlane(tileb[u.pm]); return (bk / 6) * 1024 + u.pn * 256; }
    __device__ __forceinline__ void kb(const pg8::Unit& u, int& k0, int& k1) const { const int bk = __builtin_amdgcn_readfirstlane(tileb[u.pm]); int lo, hi; pair_lohi(bk % 6, lo, hi); k0 = lo * 256; k1 = hi * 256; }
    __device__ __forceinline__ const int* rowlist() const { return nullptr; }
    __device__ __forceinline__ void a_ready(const pg8::Unit& u) const {
        if (threadIdx.x == 0) {
            gu32* w = cnt + u.pm * HIDCNT_STRIDE; unsigned sp = 0u;
            while (__hip_atomic_load(w, RLX_AGENT) < (unsigned)HIDCNT_FULL) { __builtin_amdgcn_s_sleep(1);
                if ((++sp & 255u) == 0u) { if (__hip_atomic_load(tmo, RLX_AGENT)) break; if (sp > XB_SPIN_CAP) { (void)__hip_atomic_fetch_add(tmo, 1u, RLX_AGENT); break; } } }
            __builtin_amdgcn_fence(__ATOMIC_ACQUIRE, "agent");
            asm volatile("s_waitcnt vmcnt(0)" ::: "memory");
        }
        __builtin_amdgcn_s_barrier(); asm volatile("" ::: "memory");
    }
    __device__ __forceinline__ void done(const pg8::Unit&) const {}
};
struct EpiHid {
    static constexpr bool PERM = true;
    unsigned char* H; const float* cw;
    __device__ __forceinline__ void operator()(const pg8::f32x4 (&acc)[2][2][4][2], const pg8::Unit& u, int wr_, int wc_, int fr_, int fq_) const {
        int t_ = threadIdx.x; asm volatile("" : "+v"(t_));
        const int wid_ = __builtin_amdgcn_readfirstlane(t_ >> 6), wr = wid_ >> 2, wc = wid_ & 3, fr = t_ & 15, fq = (t_ & 63) >> 4; (void)wr_; (void)wc_; (void)fr_; (void)fq_;
        const int sl = u.pn >> 1; const int col0 = sl * 256 + (u.pn & 1) * 128 + wc * 32 + 8 * fq;
#pragma unroll
        for (int ai = 0; ai < 2; ++ai)
#pragma unroll
            for (int m = 0; m < 4; ++m) { const int pos = u.pm * 256 + ai * 128 + wr * 64 + m * 16 + fr; const float w = cw[(size_t)pos * 2 + sl] * 16.f;
                const pg8::f32x4 g0 = acc[ai][0][m][0], g1 = acc[ai][0][m][1], u0 = acc[ai][1][m][0], u1 = acc[ai][1][m][1];
                float h[8];
#pragma unroll
                for (int j = 0; j < 4; ++j) { h[j] = g0[j] * __builtin_amdgcn_rcpf(1.f + __expf(-g0[j])) * u0[j] * w; h[4 + j] = g1[j] * __builtin_amdgcn_rcpf(1.f + __expf(-g1[j])) * u1[j] * w; }
                int q0 = __builtin_amdgcn_cvt_pk_fp8_f32(h[0], h[1], 0, false); q0 = __builtin_amdgcn_cvt_pk_fp8_f32(h[2], h[3], q0, true);
                int q1 = __builtin_amdgcn_cvt_pk_fp8_f32(h[4], h[5], 0, false); q1 = __builtin_amdgcn_cvt_pk_fp8_f32(h[6], h[7], q1, true);
                __hip_atomic_store((gu64*)(H + (size_t)pos * 512 + col0), ((unsigned long long)(unsigned)q1 << 32) | (unsigned long long)(unsigned)q0, RLX_AGENT); }
    }
};
constexpr size_t WS_XBUF = 5 * MiB, XBUF_BYTES = (size_t)MAXPOS * 4 * 8;
struct EpiFinal {
    static constexpr bool PERM = true;
    const int* rl; const float* gt; const pg8::bf16_t* x1; float* out; const float* gf; unsigned long long* xbuf; LAS unsigned char* xl;
    __device__ __forceinline__ void operator()(const pg8::f32x4 (&acc)[2][2][4][2], const pg8::Unit& u, int wr_, int wc_, int fr_, int fq_) const {
        int t_ = threadIdx.x; asm volatile("" : "+v"(t_));
        const int wid_ = __builtin_amdgcn_readfirstlane(t_ >> 6), wr = wid_ >> 2, wc = wid_ & 3, fr = t_ & 15, fq = (t_ & 63) >> 4; (void)wr_; (void)wc_; (void)fr_; (void)fq_;
        LAS float* Pl = (LAS float*)xl; LAS float* Sl = (LAS float*)(xl + 4096);
        const int col0 = u.pn * 256 + wc * 32 + 8 * fq;
        pg8::f32x4 v[2][2][4][2]; int tok[2][4];
#pragma unroll
        for (int ai = 0; ai < 2; ++ai) {
#pragma unroll
            for (int m = 0; m < 4; ++m) tok[ai][m] = rl[u.pm * 256 + ai * 128 + wr * 64 + m * 16 + fr];
#pragma unroll
            for (int m = 0; m < 4; ++m) { const int t = tok[ai][m]; float s = 0.f;
                if (t >= 0) { const float* g = gt + (size_t)(t / SEQ) * NMOD + col0; const pg8::bf16_t* o = x1 + (size_t)t * 2048 + col0;
#pragma unroll
                    for (int bj = 0; bj < 2; ++bj) { const pg8::f32x4 g0 = *(const pg8::f32x4*)(g + bj * 128), g1 = *(const pg8::f32x4*)(g + bj * 128 + 4); const pg8::u32x4 xv = *(const pg8::u32x4*)(o + bj * 128);
                        const pg8::f32x4 a0 = acc[ai][bj][m][0], a1 = acc[ai][bj][m][1];
                        const pg8::f32x4 y0 = {bfl(xv.x) + g0[0] * a0[0], bfh(xv.x) + g0[1] * a0[1], bfl(xv.y) + g0[2] * a0[2], bfh(xv.y) + g0[3] * a0[3]};
                        const pg8::f32x4 y1 = {bfl(xv.z) + g1[0] * a1[0], bfh(xv.z) + g1[1] * a1[1], bfl(xv.w) + g1[2] * a1[2], bfh(xv.w) + g1[3] * a1[3]};
                        v[ai][bj][m][0] = y0; v[ai][bj][m][1] = y1;
                        s += (y0[0] * y0[0] + y0[1] * y0[1]) + (y0[2] * y0[2] + y0[3] * y0[3]) + (y1[0] * y1[0] + y1[1] * y1[1]) + (y1[2] * y1[2] + y1[3] * y1[3]); } }
                else {
#pragma unroll
                    for (int bj = 0; bj < 2; ++bj) { v[ai][bj][m][0] = (pg8::f32x4){0.f, 0.f, 0.f, 0.f}; v[ai][bj][m][1] = (pg8::f32x4){0.f, 0.f, 0.f, 0.f}; } }
                s += __shfl_xor(s, 16); s += __shfl_xor(s, 32);
                if (fq == 0) Pl[(ai * 128 + wr * 64 + m * 16 + fr) * 4 + wc] = s; }
        }
        asm volatile("s_waitcnt lgkmcnt(0)" ::: "memory"); __builtin_amdgcn_s_barrier(); asm volatile("" ::: "memory");
        if (t_ < 256) {
            const float ps = (Pl[t_ * 4 + 0] + Pl[t_ * 4 + 1]) + (Pl[t_ * 4 + 2] + Pl[t_ * 4 + 3]);
            unsigned long long* slot = xbuf + (size_t)(u.pm * 256 + t_) * 4;
            __hip_atomic_store(slot + u.pn, (1ull << 32) | (unsigned long long)__float_as_uint(ps), __ATOMIC_RELAXED, __HIP_MEMORY_SCOPE_AGENT);
            float tot = 0.f;
            for (unsigned sp = 0; sp < (1u << 16); ++sp) {
                const unsigned long long g0 = __hip_atomic_load(slot + 0, __ATOMIC_RELAXED, __HIP_MEMORY_SCOPE_AGENT), g1 = __hip_atomic_load(slot + 1, __ATOMIC_RELAXED, __HIP_MEMORY_SCOPE_AGENT),
                                         g2 = __hip_atomic_load(slot + 2, __ATOMIC_RELAXED, __HIP_MEMORY_SCOPE_AGENT), g3 = __hip_atomic_load(slot + 3, __ATOMIC_RELAXED, __HIP_MEMORY_SCOPE_AGENT);
                tot = (__uint_as_float((unsigned)g0) + __uint_as_float((unsigned)g1)) + (__uint_as_float((unsigned)g2) + __uint_as_float((unsigned)g3));
                if (((g0 >> 32) & (g1 >> 32) & (g2 >> 32) & (g3 >> 32)) == 1ull) break;
                __builtin_amdgcn_s_sleep(2);
            }
            Sl[t_] = rsqrtf(tot * (1.f / D) + EPS);
        }
        asm volatile("s_waitcnt vmcnt(0) lgkmcnt(0)" ::: "memory"); __builtin_amdgcn_s_barrier(); asm volatile("" ::: "memory");
#pragma unroll
        for (int ai = 0; ai < 2; ++ai)
#pragma unroll
            for (int m = 0; m < 4; ++m) { const int t = tok[ai][m];
                if (t >= 0) { const float rstd = Sl[ai * 128 + wr * 64 + m * 16 + fr]; float* o = out + (size_t)t * D + col0;
#pragma unroll
                    for (int bj = 0; bj < 2; ++bj) { const pg8::f32x4 f0 = *(const pg8::f32x4*)(gf + col0 + bj * 128), f1 = *(const pg8::f32x4*)(gf + col0 + bj * 128 + 4);
                        *(pg8::f32x4*)(o + bj * 128) = v[ai][bj][m][0] * rstd * f0; *(pg8::f32x4*)(o + bj * 128 + 4) = v[ai][bj][m][1] * rstd * f1; } } }
        asm volatile("s_waitcnt lgkmcnt(0)" ::: "memory"); __builtin_amdgcn_s_barrier(); asm volatile("" ::: "memory");
    }
};
constexpr int SWA_KP = 144, SWA_VP = 520, SWA_OP = 144;
constexpr int SWA_KS = 0, SWA_VT = 256 * SWA_KP, SWA_OS = SWA_VT + 64 * SWA_VP, SWA_LDS = SWA_OS + 8 * 32 * SWA_OP;
static_assert(SWA_LDS <= RING_BYTES, "swa lds");
__device__ __forceinline__ float fast_sigmoid(float x) { return __builtin_amdgcn_rcpf(1.f + __expf(-x)); }

__device__ __forceinline__ void p6_swa_merge(Frame& F0, bf16* P, bf16* Mg, const bf16* OA, const float* sink) {
    Frame F = F0; { int t__ = threadIdx.x; asm volatile("" : "+v"(t__)); F.tid = t__; F.lane = t__ & 63; F.wave = __builtin_amdgcn_readfirstlane(t__ >> 6); }
    const int lane = F.lane, w = F.wave, q = lane & 31, h = lane >> 5, tid = F.tid;
    LAS unsigned char* Ks = F.lds + RING_OFF + SWA_KS;
    LAS unsigned char* Vt = F.lds + RING_OFF + SWA_VT;
    LAS unsigned char* Os = F.lds + RING_OFF + SWA_OS + w * (32 * SWA_OP);
    constexpr float L2E = 1.4426950408889634f, CS = 0.125f * L2E;
    for (int unit = blockIdx.x; unit < NB * 64 * 2; unit += F.G) {
        const int hk = unit & 1, qb = (unit >> 1) & 63, b = unit >> 7;
        const int t0 = qb * 128; const size_t rowbase = (size_t)b * SEQ;
        LDS_BARRIER();
        {
        {
            const int pc = tid & 7;
            v4u kv[4], vv[4];
#pragma unroll
            for (int i = 0; i < 4; ++i) { const int kr = (tid >> 3) + 64 * i; int tp = t0 - 128 + kr; tp = tp < 0 ? 0 : tp;
                const bf16* src = P + (rowbase + tp) * PWB;
                kv[i] = *(const v4u*)(src + PE_KB + hk * 64 + pc * 8); vv[i] = *(const v4u*)(src + PE_VB + hk * 64 + pc * 8); }
#pragma unroll
            for (int i = 0; i < 4; ++i) { const int kr = (tid >> 3) + 64 * i;
                *(LAS v4u*)(Ks + kr * SWA_KP + pc * 16) = kv[i];
                const unsigned wds[4] = {vv[i].x, vv[i].y, vv[i].z, vv[i].w};
#pragma unroll
                for (int e = 0; e < 4; ++e) { const int d = pc * 8 + e * 2;
                    *(LAS unsigned short*)(Vt + d * SWA_VP + kr * 2) = (unsigned short)(wds[e] & 0xffffu);
                    *(LAS unsigned short*)(Vt + (d + 1) * SWA_VP + kr * 2) = (unsigned short)(wds[e] >> 16); }
            }
        }
        }
        LDS_BARRIER();
        const int head = hk * 8 + w; const float snk = sink[head] * L2E;
        bf16x8 qf_n[4];
        { const bf16* qp = P + (rowbase + t0 + q) * PWB + PE_QB + head * 64 + 8 * h;
#pragma unroll
          for (int kk = 0; kk < 4; ++kk) qf_n[kk] = *(const bf16x8*)(qp + 16 * kk); }
        for (int sb = 0; sb < 4; ++sb) {
            const int q0 = t0 + 32 * sb;
            bf16x8 qf[4];
#pragma unroll
            for (int kk = 0; kk < 4; ++kk) qf[kk] = qf_n[kk];
            const int mq = lane >> 3, mp8 = lane & 7; const size_t mrow = rowbase + q0 + mq; const int mcol = head * 64 + 8 * mp8;
            u32x2 gav[4], gbv[4]; v4u oav[4];
#pragma unroll
            for (int i = 0; i < 4; ++i) { const size_t r = mrow + 8 * i;
                gav[i] = *(const u32x2*)((const unsigned char*)(P + r * PWB) + PC_GA + mcol); gbv[i] = *(const u32x2*)((const unsigned char*)(P + r * PWB) + PC_GB + mcol); oav[i] = *(const v4u*)(OA + r * D + mcol); }
            if (sb < 3) { const bf16* qp = P + (rowbase + q0 + 32 + q) * PWB + PE_QB + head * 64 + 8 * h;
#pragma unroll
                for (int kk = 0; kk < 4; ++kk) qf_n[kk] = *(const bf16x8*)(qp + 16 * kk); }
            f32x16 O0, O1; float inv;
            {
            f32x16 S[5];
#pragma unroll
            for (int kt = 0; kt < 5; ++kt) {
                f32x16 acc = {0.f, 0.f, 0.f, 0.f, 0.f, 0.f, 0.f, 0.f, 0.f, 0.f, 0.f, 0.f, 0.f, 0.f, 0.f, 0.f};
#pragma unroll
                for (int kk = 0; kk < 4; ++kk) { const bf16x8 a = *(const LAS bf16x8*)(Ks + (32 * (sb + kt) + q) * SWA_KP + (16 * kk + 8 * h) * 2);
                    acc = __builtin_amdgcn_mfma_f32_32x32x16_bf16(a, qf[kk], acc, 0, 0, 0); }
                S[kt] = acc;
            }
            float mx = snk;
#pragma unroll
            for (int kt = 0; kt < 5; ++kt)
#pragma unroll
                for (int r = 0; r < 16; ++r) { const int kin = (r & 3) + 8 * (r >> 2) + 4 * h;
                    bool ok = (q0 - 128 + 32 * kt + kin) >= 0;
                    if (kt == 0) ok = ok && (kin > q);
                    if (kt == 4) ok = ok && (kin <= q);
                    const float v = ok ? S[kt][r] * CS : -1.0e30f; S[kt][r] = v; mx = fmaxf(mx, v); }
            mx = fmaxf(mx, __shfl_xor(mx, 32));
            float sum = 0.f;
#pragma unroll
            for (int kt = 0; kt < 5; ++kt)
#pragma unroll
                for (int r = 0; r < 16; ++r) { const float p = __builtin_amdgcn_exp2f(S[kt][r] - mx); S[kt][r] = p; sum += p; }
            sum += __shfl_xor(sum, 32); sum += __builtin_amdgcn_exp2f(snk - mx);
            inv = 1.f / sum;
            O0 = (f32x16){0.f, 0.f, 0.f, 0.f, 0.f, 0.f, 0.f, 0.f, 0.f, 0.f, 0.f, 0.f, 0.f, 0.f, 0.f, 0.f}; O1 = O0;
#pragma unroll
            for (int kt = 0; kt < 5; ++kt)
#pragma unroll
                for (int s = 0; s < 2; ++s) {
                    v4u pw; pw.x = pg8::cvt_pk_bf16(S[kt][8 * s + 0], S[kt][8 * s + 1]); pw.y = pg8::cvt_pk_bf16(S[kt][8 * s + 2], S[kt][8 * s + 3]);
                    pw.z = pg8::cvt_pk_bf16(S[kt][8 * s + 4], S[kt][8 * s + 5]); pw.w = pg8::cvt_pk_bf16(S[kt][8 * s + 6], S[kt][8 * s + 7]);
                    const bf16x8 pf = __builtin_bit_cast(bf16x8, pw);
                    const int kidx = 32 * (sb + kt) + 16 * s + 4 * h;
                    const u32x2 a0l = *(const LAS u32x2*)(Vt + q * SWA_VP + kidx * 2), a0h = *(const LAS u32x2*)(Vt + q * SWA_VP + (kidx + 8) * 2);
                    const u32x2 a1l = *(const LAS u32x2*)(Vt + (q + 32) * SWA_VP + kidx * 2), a1h = *(const LAS u32x2*)(Vt + (q + 32) * SWA_VP + (kidx + 8) * 2);
                    const v4u a0 = {a0l.x, a0l.y, a0h.x, a0h.y}, a1 = {a1l.x, a1l.y, a1h.x, a1h.y};
                    O0 = __builtin_amdgcn_mfma_f32_32x32x16_bf16(__builtin_bit_cast(bf16x8, a0), pf, O0, 0, 0, 0);
                    O1 = __builtin_amdgcn_mfma_f32_32x32x16_bf16(__builtin_bit_cast(bf16x8, a1), pf, O1, 0, 0, 0);
                }
            asm volatile("" : "+v"(O0), "+v"(O1));
            }
#pragma unroll
            for (int g4 = 0; g4 < 4; ++g4) {
                u32x2 o0, o1;
                o0.x = pg8::cvt_pk_bf16(O0[4 * g4 + 0] * inv, O0[4 * g4 + 1] * inv); o0.y = pg8::cvt_pk_bf16(O0[4 * g4 + 2] * inv, O0[4 * g4 + 3] * inv);
                o1.x = pg8::cvt_pk_bf16(O1[4 * g4 + 0] * inv, O1[4 * g4 + 1] * inv); o1.y = pg8::cvt_pk_bf16(O1[4 * g4 + 2] * inv, O1[4 * g4 + 3] * inv);
                *(LAS u32x2*)(Os + q * SWA_OP + (8 * g4 + 4 * h) * 2) = o0;
                *(LAS u32x2*)(Os + q * SWA_OP + (32 + 8 * g4 + 4 * h) * 2) = o1;
            }
            asm volatile("s_waitcnt lgkmcnt(0)" ::: "memory");
            {
#pragma unroll
                for (int i = 0; i < 4; ++i) {
                    const v4u ob = *(const LAS v4u*)(Os + (mq + 8 * i) * SWA_OP + mp8 * 16), oa = oav[i]; const u32x2 ga = gav[i], gb = gbv[i];
                    float sa[8], sb[8]; constexpr float I255 = 1.f / 255.f;
#pragma unroll
                    for (int j = 0; j < 4; ++j) { sa[j] = (float)((ga.x >> (8 * j)) & 0xffu) * I255; sa[4 + j] = (float)((ga.y >> (8 * j)) & 0xffu) * I255;
                                                  sb[j] = (float)((gb.x >> (8 * j)) & 0xffu) * I255; sb[4 + j] = (float)((gb.y >> (8 * j)) & 0xffu) * I255; }
                    v4u o;
                    o.x = pg8::cvt_pk_bf16(sa[0] * bfl(oa.x) + sb[0] * bfl(ob.x), sa[1] * bfh(oa.x) + sb[1] * bfh(ob.x));
                    o.y = pg8::cvt_pk_bf16(sa[2] * bfl(oa.y) + sb[2] * bfl(ob.y), sa[3] * bfh(oa.y) + sb[3] * bfh(ob.y));
                    o.z = pg8::cvt_pk_bf16(sa[4] * bfl(oa.z) + sb[4] * bfl(ob.z), sa[5] * bfh(oa.z) + sb[5] * bfh(ob.z));
                    o.w = pg8::cvt_pk_bf16(sa[6] * bfl(oa.w) + sb[6] * bfl(ob.w), sa[7] * bfh(oa.w) + sb[7] * bfh(ob.w));
                    *(v4u*)(Mg + (mrow + 8 * i) * D + mcol) = o;
                }
            }
            asm volatile("s_waitcnt lgkmcnt(0)" ::: "memory");
        }
    }
}
constexpr int GLA_SC = 256, GLA_NSC = SEQ / GLA_SC, GLA_UNITS = NB * GLA_NSC * 4;
constexpr size_t OUT_ST = 0, OUT_DEC = 32 * MiB, OUT_OA = 64 * MiB;
constexpr int G3_ZT = 0, G3_KRAW = 2048, G3_TOT = G3_KRAW + 32 * 272, G3_BT = G3_TOT + 2048, G3_KTE = G3_BT + 16384, G3_VT = G3_KTE + 128 * 80, G3_DEC = G3_VT + 256 * 80, G3_END = G3_DEC + 512;
static_assert(G3_END <= RING_BYTES, "gla p3 lds");
constexpr int G5_KT = 0, G5_VT = 32 * 272, G5_OS = 32768, G5_ST = 32768, G5_END = G5_ST + 65536;
static_assert(G5_VT + 256 * 80 <= G5_OS && G5_OS + 8 * 32 * 144 <= G5_END && G5_END <= RING_BYTES, "gla p5 lds");

__device__ __forceinline__ unsigned pk_bf16(float lo, float hi) { return pg8::cvt_pk_bf16(lo, hi); }

__device__ __forceinline__ void p3_gla_upd(Frame& F0, bf16* P, const float* w_gk2, const float* b_gk, unsigned char* outb) {
    Frame F = F0; { int t__ = threadIdx.x; asm volatile("" : "+v"(t__)); F.tid = t__; F.lane = t__ & 63; F.wave = __builtin_amdgcn_readfirstlane(t__ >> 6); }
    const int tid = F.tid, lane = F.lane, w = F.wave;
    LAS unsigned char* L = F.lds + RING_OFF;
    LAS float* zt = (LAS float*)(L + G3_ZT); LAS unsigned char* kraw = L + G3_KRAW; LAS float* tot = (LAS float*)(L + G3_TOT); LAS float* bt = (LAS float*)(L + G3_BT);
    LAS unsigned char* kte = L + G3_KTE; LAS unsigned char* vt_ = L + G3_VT; LAS float* decl = (LAS float*)(L + G3_DEC);
    bf16* ST = (bf16*)(outb + OUT_ST); float* DEC = (float*)(outb + OUT_DEC);
    const int gk = tid & 127, gq = tid >> 7;
    const int rt = tid >> 4, rq = tid & 15;
    const int vp = tid & 127;
    const int ktile = w >> 1, vt0 = 4 * (w & 1), vl = lane & 31, hh = lane >> 5;
    constexpr float QS = 0.08838834764831845f;
    for (int unit = blockIdx.x; unit < GLA_UNITS; unit += F.G) {
        const int head = unit & 3, sc = (unit >> 2) & 31, b = unit >> 7;
        const size_t row0 = (size_t)b * SEQ + (size_t)sc * GLA_SC;
        float wreg[16];
#pragma unroll
        for (int r = 0; r < 16; ++r) wreg[r] = w_gk2[r * 512 + head * 128 + gk];
        const float bias = b_gk[head * 128 + gk];
        float carry = 0.f;
        f32x16 acc[4];
#pragma unroll
        for (int i = 0; i < 4; ++i) acc[i] = (f32x16){0.f, 0.f, 0.f, 0.f, 0.f, 0.f, 0.f, 0.f, 0.f, 0.f, 0.f, 0.f, 0.f, 0.f, 0.f, 0.f};
        v4u qraw_n, kr_n; unsigned short z_n; unsigned vraw_n[8];
        { const size_t trow = row0;
          qraw_n = *(const v4u*)(P + (trow + rt) * PWB + PE_QA + head * 128 + 8 * rq); kr_n = *(const v4u*)(P + (trow + rt) * PWB + PE_KA + head * 128 + 8 * rq);
          z_n = P[(trow + rt) * PWB + PE_Z + rq];
#pragma unroll
          for (int c = 0; c < 8; ++c) vraw_n[c] = *(const unsigned*)(P + (trow + 8 * gq + c) * PWB + PE_VA + head * 256 + 2 * vp); }
        for (int st = 0; st < 8; ++st) {
            const size_t trow = row0 + 32 * st;
            bf16* qptr = P + (trow + rt) * PWB + PE_QA + head * 128 + 8 * rq; bf16* kptr = P + (trow + rt) * PWB + PE_KA + head * 128 + 8 * rq;
            const v4u qraw = qraw_n, kr = kr_n;
            const float zval = __uint_as_float(((unsigned)z_n) << 16);
            unsigned vraw[8];
#pragma unroll
            for (int c = 0; c < 8; ++c) vraw[c] = vraw_n[c];
            if (st < 7) { const size_t nrow = trow + 32;
                qraw_n = *(const v4u*)(P + (nrow + rt) * PWB + PE_QA + head * 128 + 8 * rq); kr_n = *(const v4u*)(P + (nrow + rt) * PWB + PE_KA + head * 128 + 8 * rq);
                z_n = P[(nrow + rt) * PWB + PE_Z + rq];
#pragma unroll
                for (int c = 0; c < 8; ++c) vraw_n[c] = *(const unsigned*)(P + (nrow + 8 * gq + c) * PWB + PE_VA + head * 256 + 2 * vp); }
            LDS_BARRIER();
            *(LAS v4u*)(kraw + rt * 272 + rq * 16) = kr;
            zt[rt * 16 + rq] = zval;
            LDS_BARRIER();
            float cs[8]; float cum = 0.f;
#pragma unroll
            for (int c = 0; c < 8; ++c) { float x = bias; const LAS float* zr = zt + (8 * gq + c) * 16;
#pragma unroll
                for (int r = 0; r < 16; ++r) x += zr[r] * wreg[r];
                const float ls = fminf(x, 0.f) - __logf(1.f + __expf(-fabsf(x)));
                cum += ls * 0.0625f; cs[c] = cum; }
            tot[gq * 128 + gk] = cum;
            LDS_BARRIER();
            {
                const float t0 = tot[gk], t1 = tot[128 + gk], t2 = tot[256 + gk], t3 = tot[384 + gk];
                const float prefix = (gq > 0 ? t0 : 0.f) + (gq > 1 ? t1 : 0.f) + (gq > 2 ? t2 : 0.f), ttot = (t0 + t1) + (t2 + t3);
                float kv[8];
#pragma unroll
                for (int c = 0; c < 8; ++c) { const int t = 8 * gq + c; bt[t * 128 + gk] = carry + prefix + cs[c];
                    const float kx = __uint_as_float(((unsigned)*(const LAS unsigned short*)(kraw + t * 272 + gk * 2)) << 16);
                    kv[c] = kx * __expf(ttot - prefix - cs[c]); }
                v4u ko; ko.x = pk_bf16(kv[0], kv[1]); ko.y = pk_bf16(kv[2], kv[3]); ko.z = pk_bf16(kv[4], kv[5]); ko.w = pk_bf16(kv[6], kv[7]);
                *(LAS v4u*)(kte + gk * 80 + gq * 16) = ko;
                if (gq == 0) decl[gk] = __expf(ttot);
                carry += ttot;
                v4u v0, v1;
                v0.x = (vraw[0] & 0xffffu) | (vraw[1] << 16); v0.y = (vraw[2] & 0xffffu) | (vraw[3] << 16); v0.z = (vraw[4] & 0xffffu) | (vraw[5] << 16); v0.w = (vraw[6] & 0xffffu) | (vraw[7] << 16);
                v1.x = (vraw[0] >> 16) | (vraw[1] & 0xffff0000u); v1.y = (vraw[2] >> 16) | (vraw[3] & 0xffff0000u); v1.z = (vraw[4] >> 16) | (vraw[5] & 0xffff0000u); v1.w = (vraw[6] >> 16) | (vraw[7] & 0xffff0000u);
                *(LAS v4u*)(vt_ + (2 * vp) * 80 + gq * 16) = v0;
                *(LAS v4u*)(vt_ + (2 * vp + 1) * 80 + gq * 16) = v1;
            }
            LDS_BARRIER();
            {
#pragma unroll
                for (int g4 = 0; g4 < 4; ++g4) { const f32x4 d4 = *(const LAS f32x4*)(decl + 32 * ktile + 8 * g4 + 4 * hh);
#pragma unroll
                    for (int i = 0; i < 4; ++i) { acc[i][4 * g4 + 0] *= d4.x; acc[i][4 * g4 + 1] *= d4.y; acc[i][4 * g4 + 2] *= d4.z; acc[i][4 * g4 + 3] *= d4.w; } }
#pragma unroll
                for (int s = 0; s < 2; ++s) {
                    const bf16x8 a = *(const LAS bf16x8*)(kte + (32 * ktile + vl) * 80 + (16 * s + 8 * hh) * 2);
#pragma unroll
                    for (int i = 0; i < 4; ++i) { const bf16x8 bb = *(const LAS bf16x8*)(vt_ + (32 * (vt0 + i) + vl) * 80 + (16 * s + 8 * hh) * 2);
                        acc[i] = __builtin_amdgcn_mfma_f32_32x32x16_bf16(a, bb, acc[i], 0, 0, 0); }
                }
                const f32x4 b0 = *(const LAS f32x4*)(bt + rt * 128 + 8 * rq), b1 = *(const LAS f32x4*)(bt + rt * 128 + 8 * rq + 4);
                const float bb8[8] = {b0.x, b0.y, b0.z, b0.w, b1.x, b1.y, b1.z, b1.w};
                const unsigned qw[4] = {qraw.x, qraw.y, qraw.z, qraw.w}, kw[4] = {kr.x, kr.y, kr.z, kr.w};
                unsigned qo[4], ko[4];
#pragma unroll
                for (int e = 0; e < 4; ++e) {
                    qo[e] = pk_bf16(bfl(qw[e]) * QS * __expf(bb8[2 * e]), bfh(qw[e]) * QS * __expf(bb8[2 * e + 1]));
                    ko[e] = pk_bf16(bfl(kw[e]) * __expf(-bb8[2 * e]), bfh(kw[e]) * __expf(-bb8[2 * e + 1])); }
                *(v4u*)qptr = (v4u){qo[0], qo[1], qo[2], qo[3]};
                *(v4u*)kptr = (v4u){ko[0], ko[1], ko[2], ko[3]};
            }
        }
        bf16* stu = ST + (size_t)unit * 32768;
#pragma unroll
        for (int i = 0; i < 4; ++i)
#pragma unroll
            for (int g4 = 0; g4 < 4; ++g4) {
                const int kk = 2 * ktile + (g4 >> 1), fh = g4 & 1;
                u32x2 o; o.x = pk_bf16(acc[i][4 * g4 + 0], acc[i][4 * g4 + 1]); o.y = pk_bf16(acc[i][4 * g4 + 2], acc[i][4 * g4 + 3]);
                *(u32x2*)(stu + ((((vt0 + i) * 8 + kk) * 64 + fh * 32 + vl) * 8 + 4 * hh)) = o;
            }
        if (gq == 0) DEC[unit * 128 + gk] = __expf(carry);
    }
}

__device__ __forceinline__ void p4_gla_scan(Frame& F0, unsigned char* outb) {
    Frame F = F0; { int t__ = threadIdx.x; asm volatile("" : "+v"(t__)); F.tid = t__; F.lane = t__ & 63; F.wave = __builtin_amdgcn_readfirstlane(t__ >> 6); }
    bf16* ST = (bf16*)(outb + OUT_ST); const float* DEC = (const float*)(outb + OUT_DEC);
    for (int gt = blockIdx.x * (NWAVES * 64) + F.tid; gt < 16 * 8192; gt += F.G * NWAVES * 64) {
        const int pair = gt >> 13, e4 = gt & 8191, b = pair >> 2, head = pair & 3;
        const int Ln = (e4 >> 1) & 63, kk = (e4 >> 7) & 7, k0 = 16 * kk + 8 * (Ln >> 5) + 4 * (e4 & 1);
        const size_t ub0 = (size_t)(b * 32 * 4 + head);
        float s0 = 0.f, s1 = 0.f, s2 = 0.f, s3 = 0.f;
        u32x2 uq[4]; f32x4 dq[4];
#pragma unroll
        for (int i = 0; i < 4; ++i) { uq[i] = *(const u32x2*)(ST + (ub0 + 4 * i) * 32768 + 4 * e4); dq[i] = *(const f32x4*)(DEC + (ub0 + 4 * i) * 128 + k0); }
        for (int sc = 0; sc < GLA_NSC; sc += 4) {
#pragma unroll
            for (int i = 0; i < 4; ++i) {
                const size_t ub = ub0 + 4 * (sc + i);
                const u32x2 u = uq[i]; const f32x4 d = dq[i];
                if (sc + 4 < GLA_NSC) { uq[i] = *(const u32x2*)(ST + (ub + 16) * 32768 + 4 * e4); dq[i] = *(const f32x4*)(DEC + (ub + 16) * 128 + k0); }
                u32x2 o; o.x = pk_bf16(s0, s1); o.y = pk_bf16(s2, s3);
                *(u32x2*)(ST + ub * 32768 + 4 * e4) = o;
                s0 = d.x * s0 + bfl(u.x); s1 = d.y * s1 + bfh(u.x); s2 = d.z * s2 + bfl(u.y); s3 = d.w * s3 + bfh(u.y);
            }
        }
    }
}

__device__ __forceinline__ void p5_gla_out(Frame& F0, const bf16* P, const float* gng, unsigned char* outb) {
    Frame F = F0; { int t__ = threadIdx.x; asm volatile("" : "+v"(t__)); F.tid = t__; F.lane = t__ & 63; F.wave = __builtin_amdgcn_readfirstlane(t__ >> 6); }
    const int tid = F.tid, lane = F.lane, w = F.wave, vl = lane & 31, hh = lane >> 5;
    LAS unsigned char* L = F.lds + RING_OFF;
    LAS unsigned char* Kt = L + G5_KT; LAS unsigned char* Vt = L + G5_VT; LAS unsigned char* Os = L + G5_OS + w * (32 * 144);
    const bf16* ST = (const bf16*)(outb + OUT_ST); bf16* OA = (bf16*)(outb + OUT_OA);
    const int rt = tid >> 4, rq = tid & 15, vp = tid & 127, gq = tid >> 7;
    for (int unit = blockIdx.x; unit < GLA_UNITS; unit += F.G) {
        const int head = unit & 3, sc = (unit >> 2) & 31, b = unit >> 7;
        const size_t row0 = (size_t)b * SEQ + (size_t)sc * GLA_SC;
        bf16x8 qf[8];
        { const bf16* qp = P + (row0 + 32 * w + vl) * PWB + PE_QA + head * 128 + 8 * hh;
#pragma unroll
          for (int kk = 0; kk < 8; ++kk) qf[kk] = *(const bf16x8*)(qp + 16 * kk); }
        f32x16 acc[8];
        { const v4u* stg = (const v4u*)(ST + (size_t)unit * 32768) + tid; v4u sv[8];
#pragma unroll
          for (int i = 0; i < 8; ++i) sv[i] = stg[i * 512];
          LDS_BARRIER();
#pragma unroll
          for (int i = 0; i < 8; ++i) *(LAS v4u*)(L + G5_ST + (tid + i * 512) * 16) = sv[i];
          LDS_BARRIER();
#pragma unroll
          for (int vt = 0; vt < 8; ++vt) { f32x16 a16 = {0.f, 0.f, 0.f, 0.f, 0.f, 0.f, 0.f, 0.f, 0.f, 0.f, 0.f, 0.f, 0.f, 0.f, 0.f, 0.f};
#pragma unroll
              for (int kk = 0; kk < 8; ++kk) { const bf16x8 a = *(const LAS bf16x8*)(L + G5_ST + ((vt * 8 + kk) * 64 + lane) * 16); a16 = __builtin_amdgcn_mfma_f32_32x32x16_bf16(a, qf[kk], a16, 0, 0, 0); }
              acc[vt] = a16; } }
        v4u kr_n; unsigned vraw_n[8];
        { kr_n = *(const v4u*)(P + (row0 + rt) * PWB + PE_KA + head * 128 + 8 * rq);
#pragma unroll
          for (int c = 0; c < 8; ++c) vraw_n[c] = *(const unsigned*)(P + (row0 + 8 * gq + c) * PWB + PE_VA + head * 256 + 2 * vp); }
        for (int jt = 0; jt < 8; ++jt) {
            const v4u kr = kr_n; unsigned vraw[8];
#pragma unroll
            for (int c = 0; c < 8; ++c) vraw[c] = vraw_n[c];
            if (jt < 7) { const size_t nrow = row0 + 32 * (jt + 1);
                kr_n = *(const v4u*)(P + (nrow + rt) * PWB + PE_KA + head * 128 + 8 * rq);
#pragma unroll
                for (int c = 0; c < 8; ++c) vraw_n[c] = *(const unsigned*)(P + (nrow + 8 * gq + c) * PWB + PE_VA + head * 256 + 2 * vp); }
            LDS_BARRIER();
            *(LAS v4u*)(Kt + rt * 272 + rq * 16) = kr;
            { v4u v0, v1;
              v0.x = (vraw[0] & 0xffffu) | (vraw[1] << 16); v0.y = (vraw[2] & 0xffffu) | (vraw[3] << 16); v0.z = (vraw[4] & 0xffffu) | (vraw[5] << 16); v0.w = (vraw[6] & 0xffffu) | (vraw[7] << 16);
              v1.x = (vraw[0] >> 16) | (vraw[1] & 0xffff0000u); v1.y = (vraw[2] >> 16) | (vraw[3] & 0xffff0000u); v1.z = (vraw[4] >> 16) | (vraw[5] & 0xffff0000u); v1.w = (vraw[6] >> 16) | (vraw[7] & 0xffff0000u);
              *(LAS v4u*)(Vt + (2 * vp) * 80 + gq * 16) = v0; *(LAS v4u*)(Vt + (2 * vp + 1) * 80 + gq * 16) = v1; }
            LDS_BARRIER();
            if (w >= jt) {
                f32x16 X = {0.f, 0.f, 0.f, 0.f, 0.f, 0.f, 0.f, 0.f, 0.f, 0.f, 0.f, 0.f, 0.f, 0.f, 0.f, 0.f};
#pragma unroll
                for (int kk = 0; kk < 8; ++kk) { const bf16x8 a = *(const LAS bf16x8*)(Kt + vl * 272 + (16 * kk + 8 * hh) * 2); X = __builtin_amdgcn_mfma_f32_32x32x16_bf16(a, qf[kk], X, 0, 0, 0); }
                if (w == jt) {
#pragma unroll
                    for (int r = 0; r < 16; ++r) { const int j = (r & 3) + 8 * (r >> 2) + 4 * hh; X[r] = (j <= vl) ? X[r] : 0.f; }
                }
                bf16x8 pf[2];
#pragma unroll
                for (int s = 0; s < 2; ++s) { v4u pw; pw.x = pk_bf16(X[8 * s + 0], X[8 * s + 1]); pw.y = pk_bf16(X[8 * s + 2], X[8 * s + 3]); pw.z = pk_bf16(X[8 * s + 4], X[8 * s + 5]); pw.w = pk_bf16(X[8 * s + 6], X[8 * s + 7]);
                    pf[s] = __builtin_bit_cast(bf16x8, pw); }
#pragma unroll
                for (int vt = 0; vt < 8; ++vt)
#pragma unroll
                    for (int s = 0; s < 2; ++s) {
                        const u32x2 lo = *(const LAS u32x2*)(Vt + (32 * vt + vl) * 80 + (16 * s + 4 * hh) * 2), hi = *(const LAS u32x2*)(Vt + (32 * vt + vl) * 80 + (16 * s + 8 + 4 * hh) * 2);
                        const v4u av = {lo.x, lo.y, hi.x, hi.y};
                        acc[vt] = __builtin_amdgcn_mfma_f32_32x32x16_bf16(__builtin_bit_cast(bf16x8, av), pf[s], acc[vt], 0, 0, 0);
                    }
            }
        }
        float ssq = 0.f;
#pragma unroll
        for (int vt = 0; vt < 8; ++vt)
#pragma unroll
            for (int r = 0; r < 16; ++r) ssq += acc[vt][r] * acc[vt][r];
        ssq += __shfl_xor(ssq, 32);
        const float rstd = rsqrtf(ssq * (1.f / 256.f) + EPS);
        const int mq = lane >> 3, mp8 = lane & 7; const size_t orow = row0 + 32 * w + mq;
        u32x2 rv_n[4];
#pragma unroll
        for (int i = 0; i < 4; ++i) rv_n[i] = *(const u32x2*)((const unsigned char*)(P + (orow + 8 * i) * PWB) + head * 256 + 8 * mp8);
#pragma unroll
        for (int c = 0; c < 4; ++c) {
            u32x2 rvc[4];
#pragma unroll
            for (int i = 0; i < 4; ++i) rvc[i] = rv_n[i];
            if (c < 3) {
#pragma unroll
                for (int i = 0; i < 4; ++i) rv_n[i] = *(const u32x2*)((const unsigned char*)(P + (orow + 8 * i) * PWB) + head * 256 + 64 * (c + 1) + 8 * mp8); }
#pragma unroll
            for (int tl = 0; tl < 2; ++tl)
#pragma unroll
                for (int g4 = 0; g4 < 4; ++g4) { u32x2 o; const f32x16& A = acc[2 * c + tl];
                    o.x = pk_bf16(A[4 * g4 + 0] * rstd, A[4 * g4 + 1] * rstd); o.y = pk_bf16(A[4 * g4 + 2] * rstd, A[4 * g4 + 3] * rstd);
                    *(LAS u32x2*)(Os + vl * 144 + (32 * tl + 8 * g4 + 4 * hh) * 2) = o; }
            asm volatile("s_waitcnt lgkmcnt(0)" ::: "memory");
            const int col = head * 256 + 64 * c + 8 * mp8;
            const f32x4 g0 = *(const f32x4*)(gng + 64 * c + 8 * mp8), g1 = *(const f32x4*)(gng + 64 * c + 8 * mp8 + 4);
#pragma unroll
            for (int i = 0; i < 4; ++i) {
                const v4u ob = *(const LAS v4u*)(Os + (mq + 8 * i) * 144 + mp8 * 16); const u32x2 rv = rvc[i];
                float rr[8];
#pragma unroll
                for (int j = 0; j < 4; ++j) { rr[j] = ((float)((rv.x >> (8 * j)) & 0xffu) - 128.f) * 0.05f; rr[4 + j] = ((float)((rv.y >> (8 * j)) & 0xffu) - 128.f) * 0.05f; }
                v4u o;
                o.x = pk_bf16(bfl(ob.x) * g0.x * rr[0] * fast_sigmoid(rr[0]), bfh(ob.x) * g0.y * rr[1] * fast_sigmoid(rr[1]));
                o.y = pk_bf16(bfl(ob.y) * g0.z * rr[2] * fast_sigmoid(rr[2]), bfh(ob.y) * g0.w * rr[3] * fast_sigmoid(rr[3]));
                o.z = pk_bf16(bfl(ob.z) * g1.x * rr[4] * fast_sigmoid(rr[4]), bfh(ob.z) * g1.y * rr[5] * fast_sigmoid(rr[5]));
                o.w = pk_bf16(bfl(ob.w) * g1.z * rr[6] * fast_sigmoid(rr[6]), bfh(ob.w) * g1.w * rr[7] * fast_sigmoid(rr[7]));
                *(v4u*)(OA + (orow + 8 * i) * D + col) = o;
            }
            asm volatile("s_waitcnt lgkmcnt(0)" ::: "memory");
        }
    }
}
__device__ __forceinline__ void p0_mod_item(Frame& F0, const float* c, const float* w_ada, const float* b_ada, float* mod, int item) {
    Frame F = F0; { int t__ = threadIdx.x; asm volatile("" : "+v"(t__)); F.tid = t__; F.lane = t__ & 63; F.wave = __builtin_amdgcn_readfirstlane(t__ >> 6); }
    LAS float* sc = (LAS float*)(F.lds + RING_OFF);
    LAS float* red = (LAS float*)(F.lds + RING_OFF + 16384);
    for (int i = F.tid; i < NB * D; i += NWAVES * 64) { const float v = c[i]; sc[i] = v * __builtin_amdgcn_rcpf(1.f + __expf(-v)); }
    __syncthreads();
    const int cl = F.lane & 31, rh = F.lane >> 5, col = item * 32 + cl;
    float acc[NB] = {0.f, 0.f, 0.f, 0.f};
    const float* wp = w_ada + (size_t)(F.wave * 128 + rh) * NMOD + col;
#pragma unroll 32
    for (int i = 0; i < 64; ++i) { const float w = wp[(size_t)(2 * i) * NMOD];
#pragma unroll
        for (int b = 0; b < NB; ++b) acc[b] += sc[b * D + F.wave * 128 + 2 * i + rh] * w; }
#pragma unroll
    for (int b = 0; b < NB; ++b) { acc[b] += __shfl_xor(acc[b], 32); if (rh == 0) red[(F.wave * NB + b) * 32 + cl] = acc[b]; }
    __syncthreads();
    if (F.tid < 128) { const int b = F.tid >> 5, cc = F.tid & 31; float s = b_ada[item * 32 + cc];
#pragma unroll
        for (int w = 0; w < 8; ++w) s += red[(w * NB + b) * 32 + cc];
        mod[b * NMOD + item * 32 + cc] = s; }
    __syncthreads();
}
template <bool F8 = false>
__device__ __forceinline__ void tr_item(const float* W, int N, int k0, int n0, int nvalid, bf16* WT, size_t drow0, int dpitch, int dcol0, LAS float* scr, int lane, float wscale = 1.f) {
    const int nn = lane & 31;
    float tmp[32];
#pragma unroll
    for (int i = 0; i < 32; ++i) { const int kk = 2 * i + (lane >> 5); tmp[i] = (nn < nvalid) ? W[(size_t)(k0 + kk) * N + n0 + nn] : 0.f; }
#pragma unroll
    for (int i = 0; i < 32; ++i) { const int kk = 2 * i + (lane >> 5); scr[kk * 33 + nn] = tmp[i]; }
    LDS_WAIT(); asm volatile("" ::: "memory");
    const int c = lane & 7;
#pragma unroll
    for (int j = 0; j < 4; ++j) { const int n = (lane >> 3) + 8 * j; const LAS float* s = scr + (8 * c) * 33 + n;
        v4u o; o.x = pg8::cvt_pk_bf16(s[0 * 33], s[1 * 33]); o.y = pg8::cvt_pk_bf16(s[2 * 33], s[3 * 33]); o.z = pg8::cvt_pk_bf16(s[4 * 33], s[5 * 33]); o.w = pg8::cvt_pk_bf16(s[6 * 33], s[7 * 33]);
        if constexpr (F8) {
            int w0 = __builtin_amdgcn_cvt_pk_fp8_f32(s[0 * 33] * wscale, s[1 * 33] * wscale, 0, false); w0 = __builtin_amdgcn_cvt_pk_fp8_f32(s[2 * 33] * wscale, s[3 * 33] * wscale, w0, true);
            int w1 = __builtin_amdgcn_cvt_pk_fp8_f32(s[4 * 33] * wscale, s[5 * 33] * wscale, 0, false); w1 = __builtin_amdgcn_cvt_pk_fp8_f32(s[6 * 33] * wscale, s[7 * 33] * wscale, w1, true);
            if (n < nvalid) *(GAS u32x2*)((unsigned char*)WT + (drow0 + n) * (size_t)dpitch + dcol0 + k0 + 8 * c) = (u32x2){(unsigned)w0, (unsigned)w1};
        } else {
        if (n < nvalid) *(GAS v4u*)(WT + (drow0 + n) * (size_t)dpitch + dcol0 + k0 + 8 * c) = o; } }
    LDS_WAIT(); asm volatile("" ::: "memory");
}
__device__ __forceinline__ void p0_convert(Frame& F0, const Args& args, int part) {
    Frame F = F0; { int t__ = threadIdx.x; asm volatile("" : "+v"(t__)); F.tid = t__; F.lane = t__ & 63; F.wave = __builtin_amdgcn_readfirstlane(t__ >> 6); }
    unsigned char* ws = args.ws;
    bf16* WIN = (bf16*)(ws + WS_WIN); bf16* WO = (bf16*)(ws + WS_WO); bf16* WGU = (bf16*)(ws + WS_WGU); bf16* WD = (bf16*)(ws + WS_WD);
    const float* w_in = args.in[5]; const float* w_o = args.in[10]; const float* w_gate = args.in[16]; const float* w_up = args.in[17]; const float* w_down = args.in[18];
    LAS float* scr = (LAS float*)(F.lds + RING_OFF + 32768 + F.wave * 8704);
    const int gw = F.vcu * NWAVES + F.wave, NGW = F.G * NWAVES;
    constexpr int I0 = 16 * 201, I3 = 16 * 32, I4 = 16 * 128, I5 = 16 * 128, I6 = 16 * 128;
    constexpr int NITEMS = I0 + I3 + I4 + I5 + I6;
    bf16* WIN8 = (bf16*)(ws + WS_WIN8);
    const int it0 = part == 0 ? 0 : I0 + I3, it1 = part == 0 ? I0 + I3 : NITEMS;
    for (int it = it0 + gw; it < it1; it += NGW) {
        int r = it;
        if (r < I0) {
            const int kb = r / 201, cb = r % 201; int src, dst, nv = 32;
            if (cb < 16) { src = 32 * cb; dst = PC_QA + 32 * cb; }
            else if (cb < 32) { src = 512 + 32 * (cb - 16); dst = PC_KA + 32 * (cb - 16); }
            else if (cb < 64) { src = 1024 + 32 * (cb - 32); dst = PC_VA + 32 * (cb - 32); }
            else if (cb < 96) { src = 2048 + 32 * (cb - 64); dst = PC_RA + 32 * (cb - 64); }
            else if (cb < 97) { src = 3072; dst = PC_Z; nv = 16; }
            else if (cb < 129) { src = 3088 + 32 * (cb - 97); dst = PC_QB + 32 * (cb - 97); }
            else if (cb < 133) { src = 4112 + 32 * (cb - 129); dst = PC_KB + 32 * (cb - 129); }
            else if (cb < 137) { src = 4240 + 32 * (cb - 133); dst = PC_VB + 32 * (cb - 133); }
            else if (cb < 169) { src = 4368 + 32 * (cb - 137); dst = PC_GA + 32 * (cb - 137); }
            else { src = 5392 + 32 * (cb - 169); dst = PC_GB + 32 * (cb - 169); }
            if (dst < NF8 * 256) tr_item<true>(w_in, IN_TOTAL, 64 * kb, src, nv, WIN8, dst, D, 0, scr, F.lane, 32.f);
            else tr_item(w_in, IN_TOTAL, 64 * kb, src, nv, WIN, dst, D, 0, scr, F.lane);
            continue; } r -= I0;
        if (r < I3) { const int kb = r / 32, nb = r % 32; tr_item(w_o, D, 64 * kb, 32 * nb, 32, WO, 32 * nb, D, 0, scr, F.lane); continue; } r -= I3;
        if (r < I4 + I5) { const bool up = r >= I4; if (up) r -= I4; const int e = r / 128, q = r % 128, kb = q / 8, nb = q % 8, n0 = 32 * nb;
            tr_item<true>((up ? w_up : w_gate) + (size_t)e * D * 256, 256, 64 * kb, n0, 32, WGU, (size_t)e * 512 + (n0 >> 7) * 256 + (up ? 128 : 0) + (n0 & 127), D, 0, scr, F.lane, 32.f); continue; } r -= I4 + I5;
        { const int e = r / 128, q = r % 128, kb = q / 32, nb = q % 32;
            tr_item<true>(w_down + (size_t)e * 256 * D, D, 64 * kb, 32 * nb, 32, WD, (size_t)(e >> 2) * D + 32 * nb, D, (e & 3) * 256, scr, F.lane, 16.f); }
    }
    if (part == 0) { GAS v4u* z = (GAS v4u*)(WIN + (size_t)IN_TOTAL * D); const int n16 = (PW - IN_TOTAL) * D * 2 / 16; const v4u zero = {0u, 0u, 0u, 0u};
      for (int i = gw * 64 + F.lane; i < n16; i += NGW * 64) z[i] = zero; }
}
__device__ __forceinline__ void p1_h1(Frame& F0, const float* x, const float* g1, const float* mod, bf16* H1) {
    Frame F = F0; { int t__ = threadIdx.x; asm volatile("" : "+v"(t__)); F.tid = t__; F.lane = t__ & 63; F.wave = __builtin_amdgcn_readfirstlane(t__ >> 6); }
    const int gw = F.vcu * NWAVES + F.wave, NGW = F.G * NWAVES, c0 = F.lane * 8;
    f32x4 scl[4], sft[4]; int curb = -1;
    f32x4 nx[4];
    const int NIT = T / NGW;
    {
#pragma unroll
        for (int j = 0; j < 2; ++j) { nx[2 * j] = *(const GAS f32x4*)(x + (size_t)(NIT * gw) * D + c0 + 512 * j); nx[2 * j + 1] = *(const GAS f32x4*)(x + (size_t)(NIT * gw) * D + c0 + 512 * j + 4); } }
    for (int k = 0; k < NIT; ++k) {
        const int m = NIT * gw + k, mn = m + 1;
        const int b = m / SEQ;
        if (b != curb) { curb = b; const float* sh = mod + b * NMOD; const float* sc = sh + D;
#pragma unroll
            for (int q = 0; q < 4; ++q) { const int cc = c0 + 512 * (q >> 1) + 4 * (q & 1); scl[q] = *(const f32x4*)(g1 + cc) * (*(const f32x4*)(sc + cc) + 1.f); sft[q] = *(const f32x4*)(sh + cc); } }
        f32x4 v[4]; float s = 0.f;
#pragma unroll
        for (int q = 0; q < 4; ++q) v[q] = nx[q];
        if (k + 1 < NIT) {
#pragma unroll
            for (int j = 0; j < 2; ++j) { nx[2 * j] = *(const GAS f32x4*)(x + (size_t)mn * D + c0 + 512 * j); nx[2 * j + 1] = *(const GAS f32x4*)(x + (size_t)mn * D + c0 + 512 * j + 4); } }
#pragma unroll
        for (int q = 0; q < 4; ++q) s += (v[q].x * v[q].x + v[q].y * v[q].y) + (v[q].z * v[q].z + v[q].w * v[q].w);
#pragma unroll
        for (int o = 1; o < 64; o <<= 1) s += __shfl_xor(s, o);
        const float rstd = rsqrtf(s * (1.f / D) + EPS);
#pragma unroll
        for (int j = 0; j < 2; ++j) { const f32x4 y0 = v[2 * j] * rstd * scl[2 * j] + sft[2 * j], y1 = v[2 * j + 1] * rstd * scl[2 * j + 1] + sft[2 * j + 1];
            *(GAS v4u*)(H1 + (size_t)m * D + c0 + 512 * j) = (v4u){pg8::cvt_pk_bf16(y0.x, y0.y), pg8::cvt_pk_bf16(y0.z, y0.w), pg8::cvt_pk_bf16(y1.x, y1.y), pg8::cvt_pk_bf16(y1.z, y1.w)};
            if constexpr (NF8 > 0) { int q0 = __builtin_amdgcn_cvt_pk_fp8_f32(y0.x, y0.y, 0, false); q0 = __builtin_amdgcn_cvt_pk_fp8_f32(y0.z, y0.w, q0, true);
                int q1 = __builtin_amdgcn_cvt_pk_fp8_f32(y1.x, y1.y, 0, false); q1 = __builtin_amdgcn_cvt_pk_fp8_f32(y1.z, y1.w, q1, true);
                *(GAS u32x2*)((unsigned char*)H1 + 64 * MiB + (size_t)m * D + c0 + 512 * j) = (u32x2){(unsigned)q0, (unsigned)q1}; } }
    }
}

__global__ void __launch_bounds__(NWAVES * 64, 2) skel_fwd(Args args) {
    extern __shared__ __attribute__((aligned(16))) unsigned char lds[];
    Frame F;
    F.lds = (LAS unsigned char*)lds;
    F.MISC = (volatile LAS unsigned*)(F.lds + MISC_OFF);
    F.tid = threadIdx.x; F.lane = F.tid & 63; F.wave = __builtin_amdgcn_readfirstlane(F.tid >> 6);
    F.G = gridDim.x; { const int bx = blockIdx.x; F.vcu = (F.G % 8 == 0) ? (bx % 8) * (F.G / 8) + bx / 8 : bx; }
    unsigned char* ws = args.ws;
    F.ctl = (gu32*)(ws + WS_CTL);
    for (int u = F.tid; u < (LDS_BYTES - LDSCTL_OFF) / 4; u += NWAVES * 64) ((LAS unsigned*)(F.lds + LDSCTL_OFF))[u] = 0u;
    __syncthreads();
    XcdBarrier bar = xcd_barrier_post((unsigned*)(F.ctl + CW_BAR) + args.li * XCD_BAR_WORDS, F.MISC + 8);
    const int lo = args.ph_lo, hi = args.ph_hi;
#define IN(k) (lo <= (k) && (k) < hi)
#define BOTH(k) (IN(k) && IN((k) + 1))
#define GRID_BAR() xcd_barrier(bar)
#if defined(PROBE_LO)
    volatile LAS unsigned long long* tsl = (volatile LAS unsigned long long*)(F.lds + LDSCTL_OFF + 64);
#define STAMP(k) do { if (blockIdx.x == 0 && F.tid == 0) tsl[k] = rt(); } while (0)
#else
#define STAMP(k) do { } while (0)
#endif
#define REFRESH() do { int t__ = threadIdx.x; asm volatile("" : "+v"(t__)); F.tid = t__; F.lane = t__ & 63; F.wave = __builtin_amdgcn_readfirstlane(t__ >> 6); } while (0)
    float* mod = (float*)(ws + WS_MOD);
    bf16* P = (bf16*)(ws + WS_P);
    bf16* H1 = (bf16*)args.out;

    STAMP(0); if (IN(0)) {
        if (blockIdx.x < NMOD / 32) p0_mod_item(F, args.in[1], args.in[2], args.in[3], mod, blockIdx.x);
        p0_convert(F, args, 0);
        {
            GAS v4u* xz = (GAS v4u*)(ws + WS_XBUF); const v4u zero = {0u, 0u, 0u, 0u};
            for (int i = blockIdx.x * (NWAVES * 64) + F.tid; i < (int)(XBUF_BYTES / 16); i += F.G * NWAVES * 64) xz[i] = zero; }
        if (BOTH(0)) GRID_BAR();
    }
    STAMP(1); if (IN(1)) {
        p1_h1(F, args.in[0], args.in[4], mod, H1);
        if (BOTH(1)) GRID_BAR();
    }
    STAMP(2); if (IN(2)) {
        const bool bf_first = (NF8 > 0) && ((blockIdx.x & 7) >= 4);
#pragma nounroll
        for (int pass = 0; pass < 2; ++pass) {
        if ((pass == 0) != bf_first) {
        if constexpr (NF8 > 0) {
            pg8::Gemm g{(const unsigned char*)H1 + 64 * MiB, ws + WS_WIN8, D / 128, D, D, 0x7f7f7f7f, 0x7a7a7a7a}; pg8::StaticOrder S; S.init(T, NF8 * 256, F.G, (int)blockIdx.x);
            static_assert(NF8 == 0 || (NF8 == 12 && PC_RA == 0 && PC_GA == 1024 && PC_GB == 2048), "the byte-coded gate epilogue assumes the gate tiles come first");
            pg8::EpiGate E{P, PWB};
            pg8::gemm_phase<pg8::EpiGate, pg8::StaticOrder, false, true, true>(F.lds + RING_OFF, g, S, E);
        }
        } else {
            pg8::Gemm g{H1, ws + WS_WIN + (size_t)NF8 * 256 * D * 2, D / 64, D * 2, D * 2, 0, 0}; pg8::StaticOrder S; S.init(T, PW - NF8 * 256, F.G, (int)blockIdx.x);
            pg8::EpiBf16 E{P + NF8 * 256 - PBOFF, PWB};
            pg8::gemm_phase<pg8::EpiBf16, pg8::StaticOrder, false, true>(F.lds + RING_OFF, g, S, E);
        }
        if (pass == 0) { p0_convert(F, args, 1); __syncthreads(); }
        }
        if (BOTH(2)) GRID_BAR();
    }
    STAMP(3); if (IN(3)) { p3_gla_upd(F, P, args.in[6], args.in[7], (unsigned char*)args.out); if (BOTH(3)) GRID_BAR(); }
    STAMP(4); if (IN(4)) { p4_gla_scan(F, (unsigned char*)args.out); if (BOTH(4)) GRID_BAR(); }
    STAMP(5); if (IN(5)) { p5_gla_out(F, P, args.in[8], (unsigned char*)args.out); if (BOTH(5)) GRID_BAR(); }
    STAMP(6); if (IN(6)) {
        p6_swa_merge(F, P, (bf16*)(ws + WS_M), (const bf16*)((const unsigned char*)args.out + 64 * MiB), args.in[9]);
        if (BOTH(6)) GRID_BAR();
    }
    STAMP(7); if (IN(7)) {
        pg8::Gemm g{ws + WS_M, ws + WS_WO, D / 64, D * 2, D * 2, 0, 0}; pg8::StaticOrder S; S.init(T, D, F.G, (int)blockIdx.x);
        pg8::EpiX1 E{args.in[0], mod + 2 * D, (bf16*)args.out};
        pg8::gemm_phase<pg8::EpiX1, pg8::StaticOrder, false, true>(F.lds + RING_OFF, g, S, E);
        if (BOTH(7)) GRID_BAR();
    }
    STAMP(8); if (IN(8)) {
        p8_h2_route(F, args, mod, (unsigned char*)P);
        if (BOTH(8)) GRID_BAR();
    }
    STAMP(9); if (IN(9)) {
        p9_sort(F, args);
        if (BOTH(9)) GRID_BAR();
    }
    const int* seg = (const int*)(ws + WS_SORT + SORT_SEG); const int* rowlist = (const int*)(ws + WS_SORT + SORT_ROWLIST); const int* tileb = (const int*)(ws + WS_SORT + SORT_TILEB);
    unsigned char* HID = (unsigned char*)P + 64 * MiB;
    STAMP(10); if (IN(10)) {
        const int ntile = __builtin_amdgcn_readfirstlane(seg[32]);
        PairOrder10 S; S.rl = rowlist; S.tileb = tileb; S.cnt = F.ctl + CW_HIDCNT; S.init(ntile * 4, F.G, F.vcu);
        pg8::Gemm g{P, ws + WS_WGU, D / 128, D, D, 0x7f7f7f7f, 0x7a7a7a7a};
        EpiHid E{HID, (const float*)(ws + WS_SORT + SORT_CW)};
        pg8::gemm_phase<EpiHid, PairOrder10, true, true, true>(F.lds + RING_OFF, g, S, E);
    }
    STAMP(11); if (IN(11)) {
        const int ntile = __builtin_amdgcn_readfirstlane(seg[32]);
        PairOrder11 S; S.tileb = tileb; S.cnt = F.ctl + CW_HIDCNT; S.tmo = F.ctl + CW_BAR + XB_TMO; S.init(ntile * 4, F.G, F.vcu);
        pg8::Gemm g{HID, ws + WS_WD, 4, 512, D, 0x7b7b7b7b, 0x7b7b7b7b};
        EpiFinal E{rowlist, mod + 5 * D, (const bf16*)args.out, args.out, args.in[19], (unsigned long long*)(ws + WS_XBUF), F.lds + 140288};
        pg8::gemm_phase<EpiFinal, PairOrder11, false, true, true, true>(F.lds + RING_OFF, g, S, E);
    }
    STAMP(12);
    STAMP(13);
#if defined(PROBE_LO)
    if (blockIdx.x == 0 && F.tid == 0) { const unsigned long long dt = (tsl[PROBE_HI] - tsl[PROBE_LO]) * PROBE_MULT, t0 = rt(); while (rt() - t0 < dt) __builtin_amdgcn_s_sleep(8); }
#endif
#undef IN
#undef BOTH
#undef GRID_BAR
#undef STAMP
#undef REFRESH
}

extern "C" void kernel_launch(void* const* d_in, const int* in_sizes, int n_in, void* d_out, int out_size, void* d_ws, size_t ws_size, hipStream_t stream) {
    static int grid = 0;
    if (grid == 0) {
        int dev = 0, cus = 0, per_cu = 0;
        if (hipGetDevice(&dev) != hipSuccess || hipDeviceGetAttribute(&cus, hipDeviceAttributeMultiprocessorCount, dev) != hipSuccess) { grid = -1; return; }
        if (hipFuncSetAttribute((const void*)skel_fwd, hipFuncAttributeMaxDynamicSharedMemorySize, LDS_BYTES) != hipSuccess) { grid = -1; return; }
        if (hipOccupancyMaxActiveBlocksPerMultiprocessor(&per_cu, (const void*)skel_fwd, NWAVES * 64, LDS_BYTES) != hipSuccess || per_cu < 1) per_cu = 1;
        (void)hipGetLastError();
        grid = cus;
        if (ws_size < WS_END) { fprintf(stderr, "kernel_launch: workspace too small (%zu < %zu)\n", ws_size, (size_t)WS_END); grid = -1; return; }
    }
    if (grid < 0) return;
    unsigned char* ws = (unsigned char*)d_ws; float* out = (float*)d_out;
    (void)hipMemsetAsync((char*)d_ws + WS_CTL, 0, CTL_ZERO_BYTES, stream);
    Args a{};
    for (int i = 0; i < 20; ++i) a.in[i] = (const float*)d_in[i];
    a.out = out; a.ws = ws;
    a.ph_lo = 0; a.ph_hi = 12; a.li = 0;
    hipLaunchKernelGGL(skel_fwd, dim3(grid), dim3(NWAVES * 64), LDS_BYTES, stream, a);
}
```
